# Optimizing an MI355X kernel written in HIP

```python
import math
import jax, jax.numpy as jnp
from jax import lax
import numpy as np

D_MODEL = 2048
BATCH = 2
SEQ = 8192
DEPTH = 4

D_MIX = D_MODEL
D_MLSTM = D_MIX // 2
D_HGRN = D_MIX - D_MLSTM
M_HEADS = 4
M_DV = D_MLSTM // M_HEADS
M_DQK = M_DV // 2
H_HEADS = 8
H_DH = D_HGRN // H_HEADS
CONV_W = 4
CHUNK = 64
D_FF = int(math.ceil(8 * D_MODEL / 3 / 256)) * 256
N_MOD = 6
EPS = 1e-5
DEEPNORM_ALPHA = (2 * DEPTH) ** 0.25
DEEPNORM_BETA = (8 * DEPTH) ** -0.25

IN_COLS = (2 * M_HEADS * M_DQK,
           D_MLSTM,
           D_MLSTM,
           M_HEADS,
           M_HEADS,
           D_HGRN,
           D_HGRN,
           D_HGRN,
           D_HGRN)
D_IN = sum(IN_COLS)
SPLIT_IDX = tuple(int(s) for s in np.cumsum(IN_COLS)[:-1])

kernel_name = "hymba_mlstm_hgrn2_deepnorm_adaln"


def layer_norm(x, g, b):
    xf = x.astype(jnp.float32)
    mu = xf.mean(-1, keepdims=True)
    var = jnp.square(xf - mu).mean(-1, keepdims=True)
    return ((xf - mu) * lax.rsqrt(var + EPS)).astype(x.dtype) * g + b


def head_norm(h, w, center):
    hf = h.astype(jnp.float32)
    if center:
        hf = hf - hf.mean(-1, keepdims=True)
    hf = hf * lax.rsqrt(jnp.square(hf).mean(-1, keepdims=True) + EPS)
    return hf.reshape(h.shape[0], h.shape[1], -1) * w


def causal_dwconv(x, w, b):
    T = x.shape[1]
    xp = jnp.pad(x, ((0, 0), (CONV_W - 1, 0), (0, 0)))
    return sum(w[j] * xp[:, j:j + T] for j in range(CONV_W)) + b


def to_chunks(a):
    B, T = a.shape[:2]
    a = a.reshape((B, T // CHUNK, CHUNK) + a.shape[2:])
    return jnp.moveaxis(a, (1, 3), (0, 2))


def from_chunks(a):
    a = jnp.moveaxis(a, (0, 2), (1, 3))
    return a.reshape((a.shape[0], -1) + a.shape[3:])


def mlstm_chunkwise(q, k, v, ig, fg):
    f32 = jnp.float32
    B, T, H, dk = q.shape
    dv = v.shape[-1]
    q = q.astype(f32) * dk ** -0.5
    k = k.astype(f32)
    v = v.astype(f32)
    log_f = jax.nn.log_sigmoid(fg.astype(f32))
    ig = ig.astype(f32)
    causal = jnp.tril(jnp.ones((CHUNK, CHUNK), dtype=bool))

    def step(carry, xs):
        C_prev, n_prev, m_prev = carry
        qc, kc, vc, ic, lfc = xs
        b = jnp.cumsum(lfc, axis=-1)
        logD = jnp.where(causal, b[..., :, None] - b[..., None, :] + ic[..., None, :], -jnp.inf)
        m_inter = b + m_prev[..., None]
        m_t = jnp.maximum(m_inter, logD.max(-1))
        Dw = jnp.exp(logD - m_t[..., None])
        w_inter = jnp.exp(m_inter - m_t)
        S = jnp.einsum('bhtd,bhsd->bhts', qc, kc) * Dw
        num = jnp.einsum('bhts,bhsv->bhtv', S, vc) + w_inter[..., None] * jnp.einsum('bhtd,bhdv->bhtv', qc, C_prev)
        den = S.sum(-1) + w_inter * jnp.einsum('bhtd,bhd->bht', qc, n_prev)
        h = num / jnp.maximum(jnp.abs(den), jnp.exp(-m_t))[..., None]
        b_last = b[..., -1]
        log_w_end = b_last[..., None] - b + ic
        m_new = jnp.maximum(b_last + m_prev, log_w_end.max(-1))
        w_end = jnp.exp(log_w_end - m_new[..., None])
        decay = jnp.exp(b_last + m_prev - m_new)
        C_new = decay[..., None, None] * C_prev + jnp.einsum('bhs,bhsd,bhsv->bhdv', w_end, kc, vc)
        n_new = decay[..., None] * n_prev + jnp.einsum('bhs,bhsd->bhd', w_end, kc)
        return (C_new, n_new, m_new), h

    init = (jnp.zeros((B, H, dk, dv), f32), jnp.zeros((B, H, dk), f32), jnp.zeros((B, H), f32))
    xs = (to_chunks(q), to_chunks(k), to_chunks(v), to_chunks(ig), to_chunks(log_f))
    _, hs = lax.scan(step, init, xs)
    return from_chunks(hs)


def hgrn2_chunkwise(q, f_pre, i, lb):
    f32 = jnp.float32
    B, T, H, dh = q.shape
    q = jax.nn.silu(q.astype(f32))
    f_pre = f_pre.astype(f32)
    log_f = jnp.logaddexp(jnp.log(lb), jnp.log1p(-lb) + jax.nn.log_sigmoid(f_pre))
    k = (1.0 - lb) * jax.nn.sigmoid(-f_pre)
    v = i.astype(f32)
    causal = jnp.tril(jnp.ones((CHUNK, CHUNK), dtype=bool))[:, :, None]

    def step(S_prev, xs):
        qc, kc, vc, lfc = xs
        b = jnp.cumsum(lfc, axis=2)
        rel = jnp.where(causal, b[:, :, :, None, :] - b[:, :, None, :, :], -jnp.inf)
        A = jnp.einsum('bhtd,bhsd,bhtsd->bhts', qc, kc, jnp.exp(rel))
        o = jnp.einsum('bhts,bhsv->bhtv', A, vc) + jnp.einsum('bhtd,bhdv->bhtv', qc * jnp.exp(b), S_prev)
        b_last = b[:, :, -1:, :]
        S_new = jnp.exp(b_last[:, :, 0, :])[..., None] * S_prev + jnp.einsum('bhsd,bhsv->bhdv', kc * jnp.exp(b_last - b), vc)
        return S_new, o

    init = jnp.zeros((B, H, dh, dh), f32)
    xs = (to_chunks(q), to_chunks(k), to_chunks(v), to_chunks(log_f))
    _, os_ = lax.scan(step, init, xs)
    return from_chunks(os_)


def token_mixer(u, w_in, conv_w, conv_b, b_ig, b_fg, mnorm_w, hnorm_w, lb, w_out):
    B, T, _ = u.shape
    proj = u @ w_in
    qk_m, v_m, o_m, ig, fg, q_h, f_h, i_h, g_h = jnp.split(proj, SPLIT_IDX, axis=-1)
    qk_m = jax.nn.silu(causal_dwconv(qk_m, conv_w, conv_b))
    q_m, k_m = jnp.split(qk_m, 2, axis=-1)
    h_m = mlstm_chunkwise(q_m.reshape(B, T, M_HEADS, M_DQK), k_m.reshape(B, T, M_HEADS, M_DQK),
                          v_m.reshape(B, T, M_HEADS, M_DV), ig + b_ig, fg + b_fg)
    y_m = head_norm(h_m, mnorm_w, True) * jax.nn.sigmoid(o_m.astype(jnp.float32))
    shp = (B, T, H_HEADS, H_DH)
    h_h = hgrn2_chunkwise(q_h.reshape(shp), f_h.reshape(shp), i_h.reshape(shp), lb.reshape(H_HEADS, H_DH))
    y_h = head_norm(h_h, hnorm_w, False) * jax.nn.silu(g_h.astype(jnp.float32))
    y = jnp.concatenate([y_m, y_h], axis=-1).astype(u.dtype)
    return y @ w_out


def swiglu(u, w_gate, w_up, w_down):
    return (jax.nn.silu(u @ w_gate) * (u @ w_up)) @ w_down


def setup_inputs(seed: int = 0) -> dict:
    key = jax.random.key(seed)
    ks = jax.random.split(key, 24)
    n = jax.random.normal
    D = D_MODEL
    return {
        "x": n(ks[0], (BATCH, SEQ, D), jnp.float32),
        "c": n(ks[1], (BATCH, D), jnp.float32),
        "w_mod": n(ks[2], (DEPTH, D, N_MOD * D), jnp.float32) * (0.5 * D ** -0.5),
        "b_mod": 0.01 * n(ks[3], (DEPTH, N_MOD * D), jnp.float32),
        "w_in": n(ks[4], (DEPTH, D, D_IN), jnp.float32) * D ** -0.5,
        "conv_w": n(ks[5], (DEPTH, CONV_W, 2 * M_HEADS * M_DQK), jnp.float32) * CONV_W ** -0.5,
        "conv_b": 0.01 * n(ks[6], (DEPTH, 2 * M_HEADS * M_DQK), jnp.float32),
        "b_igate": 0.1 * n(ks[7], (DEPTH, M_HEADS), jnp.float32),
        "b_fgate": jnp.linspace(3.0, 6.0, M_HEADS, dtype=jnp.float32) + 0.1 * n(ks[8], (DEPTH, M_HEADS), jnp.float32),
        "mlstm_norm_w": 1.0 + 0.02 * n(ks[9], (DEPTH, D_MLSTM), jnp.float32),
        "hgrn_norm_w": 1.0 + 0.02 * n(ks[10], (DEPTH, D_HGRN), jnp.float32),
        "lb_logits": 0.1 * n(ks[11], (DEPTH, D_HGRN), jnp.float32),
        "w_out": n(ks[12], (DEPTH, D_MIX, D), jnp.float32) * (D_MIX ** -0.5 * DEEPNORM_BETA),
        "ln1_g": 1.0 + 0.02 * n(ks[13], (DEPTH, D), jnp.float32),
        "ln1_b": 0.01 * n(ks[14], (DEPTH, D), jnp.float32),
        "w_gate": n(ks[15], (DEPTH, D, D_FF), jnp.float32) * D ** -0.5,
        "w_up": n(ks[16], (DEPTH, D, D_FF), jnp.float32) * D ** -0.5,
        "w_down": n(ks[17], (DEPTH, D_FF, D), jnp.float32) * (D_FF ** -0.5 * DEEPNORM_BETA),
        "ln2_g": 1.0 + 0.02 * n(ks[18], (DEPTH, D), jnp.float32),
        "ln2_b": 0.01 * n(ks[19], (DEPTH, D), jnp.float32),
    }


def reference(x, c, w_mod, b_mod, w_in, conv_w, conv_b, b_igate, b_fgate, mlstm_norm_w, hgrn_norm_w,
              lb_logits, w_out, ln1_g, ln1_b, w_gate, w_up, w_down, ln2_g, ln2_b):
    p = jax.nn.softmax(lb_logits.astype(jnp.float32), axis=0)
    cs = jnp.cumsum(p, axis=0)
    lb_all = cs - cs[0:1]
    c_act = jax.nn.silu(c)
    for l in range(DEPTH):
        mod = c_act @ w_mod[l] + b_mod[l]
        sh1, sc1, g1, sh2, sc2, g2 = jnp.split(mod[:, None, :], N_MOD, axis=-1)
        u = x * (1.0 + sc1) + sh1
        y = token_mixer(u, w_in[l], conv_w[l], conv_b[l], b_igate[l], b_fgate[l],
                        mlstm_norm_w[l], hgrn_norm_w[l], lb_all[l], w_out[l])
        x = layer_norm(DEEPNORM_ALPHA * x + (1.0 + g1) * y, ln1_g[l], ln1_b[l])
        u = x * (1.0 + sc2) + sh2
        y = swiglu(u, w_gate[l], w_up[l], w_down[l])
        x = layer_norm(DEEPNORM_ALPHA * x + (1.0 + g2) * y, ln2_g[l], ln2_b[l])
    return x
```

```cpp
#include <hip/hip_runtime.h>
#include <cstdio>
#include <cstdint>
#ifndef MK_ONE_LAUNCH
#define MK_ONE_LAUNCH 0
#endif
namespace pg8 {
#define PG8_LAS __attribute__((address_space(3)))
typedef unsigned short bf16_t;
typedef short bf16x8 __attribute__((ext_vector_type(8)));
typedef float f32x4 __attribute__((ext_vector_type(4)));
typedef unsigned u32x4 __attribute__((ext_vector_type(4)));
constexpr int BM = 256, BK = 64, HALF = 128, HTB = HALF * BK * 2  , STAGE_BYTES = 8 * HTB, NXCD = 8, WGM = 8;

__host__ __device__ __forceinline__ int lds_byte(int r, int c) { const int st = (r >> 4) * 2 + (c >> 5), rr = r & 15, cc = c & 31, ob = rr * 64 + cc * 2; return st * 1024 + (ob ^ (((ob >> 9) & 1) << 5)); }
__host__ __device__ __forceinline__ void stage_rc(int b, int& R, int& C) { const int st = b / 1024, sb = b % 1024, swz = sb ^ (((sb >> 9) & 1) << 5); R = (st >> 1) * 16 + swz / 64; C = (st & 1) * 32 + (swz % 64) / 2; }
__host__ __device__ __forceinline__ int perm32(int rho) { const int n = rho >> 4, i = rho & 15; return 8 * (i >> 2) + 4 * n + (i & 3); }

struct Unit { int pm, pn; };
struct Gemm { const bf16_t* A; const bf16_t* Bt; int M, N, K; };

struct StaticOrder {
    int nM, nN, nwg, G, c;
    __host__ __device__ void init(int M, int N, int G_, int c_) { nM = M / BM; nN = N / BM; nwg = nM * nN; G = G_; c = c_; }
    __host__ __device__ bool next(int i, Unit& u) const {
        const long L = (long)i * G + c; if (L >= nwg) return false;
        int wgid = (int)L; { const int q = nwg / NXCD, r = nwg % NXCD, xcd = wgid % NXCD, off = wgid / NXCD; wgid = (xcd < r ? xcd * (q + 1) : r * (q + 1) + (xcd - r) * q) + off; }
        const int nig = WGM * nN, gid = wgid / nig, fm = gid * WGM, gsz = (nM - fm) < WGM ? (nM - fm) : WGM;
        u.pm = fm + ((wgid % nig) % gsz); u.pn = (wgid % nig) / gsz; return true;
    }
    __device__ __forceinline__ void a_ready(const Unit&) const {}
    __device__ __forceinline__ void done(const Unit&) const {}
};

__device__ __forceinline__ unsigned cvt_pk_bf16(float lo, float hi) { unsigned r; asm volatile("v_cvt_pk_bf16_f32 %0, %1, %2" : "=v"(r) : "v"(lo), "v"(hi)); return r; }
typedef float f32x2 __attribute__((ext_vector_type(2)));
__device__ __forceinline__ float fast_silu(float x) { return x * __builtin_amdgcn_rcpf(1.0f + __expf(-x)); }
struct EpiProj {
    static constexpr bool PERM = true, AFTER_DRAIN = false;
    bf16_t* O; int ldc;
    __device__ __forceinline__ void operator()(const f32x4 (&acc)[2][2][4][2], const Unit& u, int wr, int wc, int fr, int fq) const {
        const int row0 = u.pm * BM + wr * 64 + fr, col0 = u.pn * BM + wc * 32 + 8 * fq;
#pragma unroll
        for (int ai = 0; ai < 2; ++ai)
#pragma unroll
            for (int m = 0; m < 4; ++m) { bf16_t* rowp = O + (size_t)(row0 + ai * HALF + m * 16) * ldc + col0;
#pragma unroll
                for (int bj = 0; bj < 2; ++bj) { const f32x4 v0 = acc[ai][bj][m][0], v1 = acc[ai][bj][m][1];
                    u32x4 w; w.x = cvt_pk_bf16(v0[0], v0[1]); w.y = cvt_pk_bf16(v0[2], v0[3]); w.z = cvt_pk_bf16(v1[0], v1[1]); w.w = cvt_pk_bf16(v1[2], v1[3]);
                    *(u32x4*)(rowp + bj * HALF) = w; } }
    }
};
struct EpiResid {
    static constexpr bool PERM = false, AFTER_DRAIN = false;
    float* X; int ldc; const float* g0; const float* g1; float alpha;
    __device__ __forceinline__ void operator()(const f32x4 (&acc)[2][2][4][2], const Unit& u, int wr, int wc, int fr, int fq) const {
        const int row0 = u.pm * BM + wr * 64 + fr, col0 = u.pn * BM + wc * 32 + 4 * fq;
        const float* g = (u.pm >= 32) ? g1 : g0;
        f32x4 gv[2][2];
#pragma unroll
        for (int bj = 0; bj < 2; ++bj)
#pragma unroll
            for (int n = 0; n < 2; ++n) gv[bj][n] = *(const f32x4*)(g + col0 + bj * HALF + n * 16) + 1.0f;
#pragma unroll
        for (int ai = 0; ai < 2; ++ai)
#pragma unroll
            for (int m = 0; m < 4; ++m) { float* rowp = X + (size_t)(row0 + ai * HALF + m * 16) * ldc + col0;
#pragma unroll
                for (int bj = 0; bj < 2; ++bj)
#pragma unroll
                    for (int n = 0; n < 2; ++n) { const f32x4 xo = *(const f32x4*)(rowp + bj * HALF + n * 16); *(f32x4*)(rowp + bj * HALF + n * 16) = xo * alpha + gv[bj][n] * acc[ai][bj][m][n]; }
                asm volatile("" ::: "memory"); }
    }
};
struct EpiSwiGLU {
    static constexpr bool PERM = true, AFTER_DRAIN = false;
    bf16_t* O; int ldc;
    __device__ __forceinline__ void operator()(const f32x4 (&acc)[2][2][4][2], const Unit& u, int wr, int wc, int fr, int fq) const {
        const int row0 = u.pm * BM + wr * 64 + fr, col0 = u.pn * HALF + wc * 32 + 8 * fq;
#pragma unroll
        for (int ai = 0; ai < 2; ++ai)
#pragma unroll
            for (int m = 0; m < 4; ++m) { bf16_t* rowp = O + (size_t)(row0 + ai * HALF + m * 16) * ldc + col0;
                const f32x4 g0 = acc[ai][0][m][0], g1 = acc[ai][0][m][1], u0 = acc[ai][1][m][0], u1 = acc[ai][1][m][1];
                f32x4 h0, h1;
#pragma unroll
                for (int j = 0; j < 4; ++j) { h0[j] = fast_silu(g0[j]) * u0[j]; h1[j] = fast_silu(g1[j]) * u1[j]; }
                u32x4 w; w.x = cvt_pk_bf16(h0[0], h0[1]); w.y = cvt_pk_bf16(h0[2], h0[3]); w.z = cvt_pk_bf16(h1[0], h1[1]); w.w = cvt_pk_bf16(h1[2], h1[3]);
                *(u32x4*)rowp = w; }
    }
};
template <class Epi, class Sched, bool ALIGN_EPI = false, bool SP2 = false>
__device__ __forceinline__ void gemm_phase(PG8_LAS unsigned char* lds, const Gemm g, const Sched& S, const Epi& E) {
    int tid_ = threadIdx.x; asm volatile("" : "+v"(tid_));
    const int tid = tid_, wid = __builtin_amdgcn_readfirstlane(tid >> 6), lane = tid & 63, wr = wid >> 2, wc = wid & 3, fr = lane & 15, fq = lane >> 4;
    const int K = g.K, nt = K / BK;
    unsigned voffA[2], voffB[2];
#pragma unroll
    for (int i = 0; i < 2; ++i) { int R, C; stage_rc(tid * 16 + i * 8192, R, C); const int Rb = Epi::PERM ? ((R & ~31) + perm32(R & 31)) : R;
        voffA[i] = (unsigned)(R * K + C) * 2u; voffB[i] = (unsigned)(Rb * K + C) * 2u; }
    const size_t kstep = (size_t)(BK * 2);
    const size_t hstep = (size_t)HALF * K * 2;
    const size_t tstep = 2 * hstep;
    const unsigned ldsw = (unsigned)wid * 1024u;
    const int aoff = lds_byte(wr * 64 + fr, fq * 8), boff = lds_byte(wc * 32 + fr, fq * 8);
#define PG8_SA(b, h) (((b) * 2 + (h)) * HTB)
#define PG8_SB(b, h) ((4 + (b) * 2 + (h)) * HTB)
#define PG8_STAGE(bufoff, gbase, voff) do { _Pragma("unroll") for (int _i = 0; _i < 2; ++_i) \
        __builtin_amdgcn_global_load_lds((const unsigned*)((const char*)(gbase) + (voff)[_i]), (PG8_LAS unsigned*)(lds + (bufoff) + ldsw + _i * 8192), 16, 0, 0); } while (0)
#define PG8_LDA(dst, b, h) do { _Pragma("unroll") for (int m = 0; m < 4; ++m) _Pragma("unroll") for (int k = 0; k < 2; ++k) dst[m][k] = *(const PG8_LAS bf16x8*)(lds + PG8_SA(b, h) + aoff + m * 2048 + k * 1024); } while (0)
#define PG8_LDB(dst, b, h) do { _Pragma("unroll") for (int n = 0; n < 2; ++n) _Pragma("unroll") for (int k = 0; k < 2; ++k) dst[n][k] = *(const PG8_LAS bf16x8*)(lds + PG8_SB(b, h) + boff + n * 2048 + k * 1024); } while (0)
#define PG8_MMA(ai, bj, At, Bt) do { __builtin_amdgcn_s_setprio(1); _Pragma("unroll") for (int m = 0; m < 4; ++m) _Pragma("unroll") for (int n = 0; n < 2; ++n) _Pragma("unroll") for (int k = 0; k < 2; ++k) \
        acc[ai][bj][m][n] = __builtin_amdgcn_mfma_f32_16x16x32_bf16(Bt[n][k], At[m][k], acc[ai][bj][m][n], 0, 0, 0); __builtin_amdgcn_s_setprio(0); } while (0)
#define PG8_WAIT_V(n) asm volatile("s_waitcnt vmcnt(" #n ")" ::: "memory")
#define PG8_WAIT_L(n) asm volatile("s_waitcnt lgkmcnt(" #n ")" ::: "memory")
#define PG8_BAR __builtin_amdgcn_s_barrier()
#define PG8_SCHED __builtin_amdgcn_sched_barrier(0)
    Unit cur, nxt; int ui = 0;
    if (!S.next(0, cur)) return;
    f32x4 acc[2][2][4][2];
#pragma unroll
    for (int a = 0; a < 2; ++a)
#pragma unroll
        for (int b = 0; b < 2; ++b)
#pragma unroll
            for (int m = 0; m < 4; ++m)
#pragma unroll
                for (int n = 0; n < 2; ++n) acc[a][b][m][n] = (f32x4){0.f, 0.f, 0.f, 0.f};
    bf16x8 At[4][2], B0[2][2], B1[2][2];
    const char* cA = (const char*)g.A + (size_t)cur.pm * tstep; const char* cB = (const char*)g.Bt + (size_t)cur.pn * tstep;
    S.a_ready(cur);
    if constexpr (SP2) {
        PG8_STAGE(PG8_SB(0, 0), cB, voffB); PG8_STAGE(PG8_SB(0, 1), cB + hstep, voffB); PG8_STAGE(PG8_SA(0, 0), cA, voffA); PG8_STAGE(PG8_SA(0, 1), cA + hstep, voffA);
        if (wr == 1) PG8_BAR;
        PG8_WAIT_V(2); PG8_BAR;
        PG8_STAGE(PG8_SB(1, 0), cB + kstep, voffB); PG8_STAGE(PG8_SA(1, 0), cA + kstep, voffA); PG8_STAGE(PG8_SB(1, 1), cB + hstep + kstep, voffB);
        PG8_WAIT_V(6); PG8_BAR;
    } else {
        PG8_STAGE(PG8_SB(0, 0), cB, voffB); PG8_STAGE(PG8_SA(0, 0), cA, voffA); PG8_STAGE(PG8_SB(0, 1), cB + hstep, voffB); PG8_STAGE(PG8_SA(0, 1), cA + hstep, voffA);
        if (wr == 1) PG8_BAR;
        PG8_WAIT_V(4); PG8_BAR;
        PG8_STAGE(PG8_SB(1, 0), cB + kstep, voffB); PG8_STAGE(PG8_SA(1, 0), cA + kstep, voffA); PG8_STAGE(PG8_SB(1, 1), cB + hstep + kstep, voffB);
        PG8_WAIT_V(6); PG8_BAR;
    }
    for (;;) {
        const bool has_next = S.next(ui + 1, nxt);
        const char* nA = has_next ? (const char*)g.A + (size_t)nxt.pm * tstep : cA; const char* nB = has_next ? (const char*)g.Bt + (size_t)nxt.pn * tstep : cB;
        for (int t = 0; t < nt; t += 2) {
            const bool last = (t == nt - 2);
            const char* a1 = cA + (size_t)(t + 1) * kstep;
            const char* a2 = last ? nA : cA + (size_t)(t + 2) * kstep; const char* b2 = last ? nB : cB + (size_t)(t + 2) * kstep;
            const char* a3 = a2 + kstep; const char* b3 = b2 + kstep;
            if (last && has_next) S.a_ready(nxt);
            if constexpr (SP2) {
            PG8_LDB(B0, 0, 0); PG8_LDB(B1, 0, 1); PG8_SCHED; PG8_LDA(At, 0, 0); PG8_STAGE(PG8_SA(1, 1), a1 + hstep, voffA);
            PG8_WAIT_V(8); PG8_WAIT_L(0); PG8_BAR; PG8_MMA(0, 0, At, B0); PG8_MMA(0, 1, At, B1); PG8_BAR; PG8_SCHED;
            PG8_LDA(At, 0, 1); PG8_STAGE(PG8_SB(0, 0), b2, voffB); PG8_STAGE(PG8_SB(0, 1), b2 + hstep, voffB); PG8_STAGE(PG8_SA(0, 0), a2, voffA);
            PG8_WAIT_V(8); PG8_WAIT_L(0); PG8_BAR; PG8_MMA(1, 0, At, B0); PG8_MMA(1, 1, At, B1); PG8_BAR; PG8_SCHED;
            PG8_LDB(B0, 1, 0); PG8_LDB(B1, 1, 1); PG8_SCHED; PG8_LDA(At, 1, 0); PG8_STAGE(PG8_SA(0, 1), a2 + hstep, voffA);
            PG8_WAIT_V(8); PG8_WAIT_L(0); PG8_BAR; PG8_MMA(0, 0, At, B0); PG8_MMA(0, 1, At, B1); PG8_BAR; PG8_SCHED;
            PG8_LDA(At, 1, 1); PG8_STAGE(PG8_SB(1, 0), b3, voffB); PG8_STAGE(PG8_SB(1, 1), b3 + hstep, voffB); PG8_STAGE(PG8_SA(1, 0), a3, voffA);
            PG8_WAIT_V(8); PG8_WAIT_L(0); PG8_BAR; PG8_MMA(1, 0, At, B0); PG8_MMA(1, 1, At, B1); PG8_BAR; PG8_SCHED;
            } else {
            PG8_LDB(B0, 0, 0); PG8_SCHED; PG8_LDA(At, 0, 0); PG8_STAGE(PG8_SA(1, 1), a1 + hstep, voffA);
            PG8_WAIT_L(8); PG8_BAR; PG8_WAIT_L(0); PG8_MMA(0, 0, At, B0); PG8_BAR; PG8_SCHED;
            PG8_LDB(B1, 0, 1); PG8_STAGE(PG8_SB(0, 0), b2, voffB);
            PG8_BAR; PG8_WAIT_L(0); PG8_MMA(0, 1, At, B1); PG8_BAR;
            PG8_LDA(At, 0, 1); PG8_STAGE(PG8_SA(0, 0), a2, voffA);
            PG8_BAR; PG8_WAIT_L(0); PG8_MMA(1, 0, At, B0); PG8_BAR; PG8_SCHED;
            PG8_STAGE(PG8_SB(0, 1), b2 + hstep, voffB);
            PG8_WAIT_V(6); PG8_BAR; PG8_MMA(1, 1, At, B1); PG8_BAR;
            PG8_LDB(B0, 1, 0); PG8_SCHED; PG8_LDA(At, 1, 0); PG8_STAGE(PG8_SA(0, 1), a2 + hstep, voffA);
            PG8_WAIT_L(8); PG8_BAR; PG8_WAIT_L(0); PG8_MMA(0, 0, At, B0); PG8_BAR; PG8_SCHED;
            PG8_LDB(B1, 1, 1); PG8_STAGE(PG8_SB(1, 0), b3, voffB);
            PG8_BAR; PG8_WAIT_L(0); PG8_MMA(0, 1, At, B1); PG8_BAR;
            PG8_LDA(At, 1, 1); PG8_STAGE(PG8_SA(1, 0), a3, voffA);
            PG8_BAR; PG8_WAIT_L(0); PG8_MMA(1, 0, At, B0); PG8_BAR; PG8_SCHED;
            PG8_STAGE(PG8_SB(1, 1), b3 + hstep, voffB);
            PG8_WAIT_V(6); PG8_BAR; PG8_MMA(1, 1, At, B1); PG8_BAR;
            }
        }
        if constexpr (ALIGN_EPI) { if (wr == 0) PG8_BAR; }
        if constexpr (!Epi::AFTER_DRAIN) { E(acc, cur, wr, wc, fr, fq); S.done(cur); }
        if (!has_next) break;
#pragma unroll
        for (int a = 0; a < 2; ++a)
#pragma unroll
            for (int b = 0; b < 2; ++b)
#pragma unroll
                for (int m = 0; m < 4; ++m)
#pragma unroll
                    for (int n = 0; n < 2; ++n) acc[a][b][m][n] = (f32x4){0.f, 0.f, 0.f, 0.f};
        cur = nxt; cA = nA; cB = nB; ++ui;
        if constexpr (ALIGN_EPI) { if (wr == 1) PG8_BAR; }
    }
    PG8_WAIT_V(0);
    if constexpr (!ALIGN_EPI) { if (wr == 0) PG8_BAR; }
    PG8_BAR;
    if constexpr (Epi::AFTER_DRAIN) { E.fused(acc, cur, wr, wc, fr, fq, lds, wid, lane); S.done(cur); }
#undef PG8_SA
#undef PG8_SB
#undef PG8_STAGE
#undef PG8_LDA
#undef PG8_LDB
#undef PG8_MMA
#undef PG8_WAIT_V
#undef PG8_WAIT_L
#undef PG8_BAR
#undef PG8_SCHED
}
}
constexpr int NWAVES = 8, NTHR = 512;
constexpr int D = 2048, BATCH = 2, T = 8192, DEPTH = 4, M = BATCH * T;
constexpr int NPROJ = 7168, DIN = 7176, FF = 5632, NGU = 2 * FF, NMODC = 6 * D;
constexpr float LN_EPS = 1e-5f, DN_ALPHA = 1.6817928305074292f, QSCALE = 0.08838834764831845f;
constexpr int PC_QK = 0, PC_V = 1024, PC_O = 2048, PC_QH = 3072, PC_FH = 4096, PC_IH = 5120, PC_GH = 6144;
constexpr size_t MiB = 1u << 20;
constexpr size_t WS_CTL = 0, CTL_ZERO_BYTES = 1 * MiB;
constexpr size_t WS_MOD = 1 * MiB;
constexpr size_t WS_LB = WS_MOD + 512 * 1024;
constexpr size_t WS_GW = WS_LB + 64 * 1024;
constexpr size_t WS_GATES = 2 * MiB;
constexpr size_t WS_DEN = 3 * MiB;
constexpr size_t WS_WIN = 4 * MiB;
constexpr size_t WS_WOUT = WS_WIN + 112 * MiB;
constexpr size_t WS_WGU = WS_WOUT + 32 * MiB;
constexpr size_t WS_WDN = WS_WGU + 176 * MiB;
constexpr size_t WS_X = WS_WDN + 88 * MiB;
constexpr size_t WS_U = WS_X + 128 * MiB;
constexpr size_t WS_YMIX = WS_U + 64 * MiB;
constexpr size_t WS_PROJ = WS_YMIX + 64 * MiB;
constexpr size_t WS_HRAW = WS_PROJ + 224 * MiB;
constexpr size_t WS_END = WS_HRAW + 128 * MiB;
constexpr int CW_BAR = 4096;
constexpr int RING_BYTES = 131072, MISC_OFF = RING_BYTES + 256, LDS_BYTES = 147456;
#define GAS __attribute__((address_space(1)))
#define LAS __attribute__((address_space(3)))
typedef unsigned short bf16;
typedef unsigned v4u __attribute__((ext_vector_type(4)));
typedef unsigned v2u __attribute__((ext_vector_type(2)));
typedef float f32x4 __attribute__((ext_vector_type(4)));
typedef float f32x2 __attribute__((ext_vector_type(2)));
#define LDS_WAIT() asm volatile("s_waitcnt lgkmcnt(0)" ::: "memory")
#define VM_WAIT() asm volatile("s_waitcnt vmcnt(0)" ::: "memory")
__device__ __forceinline__ unsigned f2bf(float f) { unsigned u = __builtin_bit_cast(unsigned, f); return (u + 0x7fffu + ((u >> 16) & 1u)) >> 16; }
__device__ __forceinline__ unsigned pk2(float lo, float hi) { return f2bf(lo) | (f2bf(hi) << 16); }
__device__ __forceinline__ float bf2f(unsigned short b) { return __builtin_bit_cast(float, (unsigned)b << 16); }
__device__ __forceinline__ float bflo(unsigned w) { return __builtin_bit_cast(float, w << 16); }
__device__ __forceinline__ float bfhi(unsigned w) { return __builtin_bit_cast(float, w & 0xffff0000u); }
__device__ __forceinline__ float sigmoid_f(float x) { return 1.0f / (1.0f + __expf(-x)); }
__device__ __forceinline__ float silu_f(float x) { return x / (1.0f + __expf(-x)); }
__device__ __forceinline__ float logsigmoid_f(float x) { return x < 0.f ? x - log1pf(expf(x)) : -log1pf(expf(-x)); }
__device__ __forceinline__ float wave_sum(float v) {
#pragma unroll
    for (int o = 1; o < 64; o <<= 1) v += __shfl_xor(v, o);
    return v;
}
#define XB_TMO      128
#define XB_XCNT(j)  (256  + 64 * (j))
#define XB_XSUB(j)  (1280 + 64 * (j))
#define XB_XGEN(j)  (2304 + 64 * (j))
#define XB_TOP      3328
#define XB_TOPGEN   3392
#define XCD_BAR_WORDS 3456
#define XB_SPIN_CAP (1u << 18)

__device__ __forceinline__ unsigned xb_ld(unsigned* p)              { return __hip_atomic_load(p, __ATOMIC_RELAXED, __HIP_MEMORY_SCOPE_AGENT); }
__device__ __forceinline__ unsigned xb_add(unsigned* p, unsigned v) { return __hip_atomic_fetch_add(p, v, __ATOMIC_RELAXED, __HIP_MEMORY_SCOPE_AGENT); }
__device__ __forceinline__ unsigned xb_xcc_id() { return (unsigned)__builtin_amdgcn_s_getreg((3 << 11) | 20) & 0xFu; }
#define XB_SPIN(cond, bar) do { unsigned _sp = 0; while (cond) { __builtin_amdgcn_s_sleep(1); \
    if ((++_sp & 255u) == 0u) { if (xb_ld(&(bar)[XB_TMO])) break; if (_sp > XB_SPIN_CAP) { atomicAdd(&(bar)[XB_TMO], 1u); break; } } } } while (0)

struct XcdBarrier {
    unsigned* bar; unsigned x;
    volatile LAS unsigned* st;
};

__device__ __forceinline__ XcdBarrier xcd_barrier_post(unsigned* bar, volatile LAS unsigned* st) {
    XcdBarrier b; b.bar = bar; b.x = xb_xcc_id(); b.st = st;
    if (threadIdx.x == 0) (void)xb_add(&bar[XB_XCNT(b.x)], 1u);
    return b;
}
__device__ __forceinline__ void xcd_barrier_complete(unsigned* bar, unsigned x, unsigned& nloc, unsigned& nx) {
    const unsigned G = gridDim.x * gridDim.y * gridDim.z;
    unsigned sum, cnt, mine, sp = 0u;
    for (;;) {
        sum = 0u; cnt = 0u; mine = 0u;
#pragma unroll
        for (unsigned j = 0; j < 16; ++j) { const unsigned c = xb_ld(&bar[XB_XCNT(j)]); sum += c; cnt += (c > 0u) ? 1u : 0u; mine = (j == x) ? c : mine; }
        if (sum == G) break;
        __builtin_amdgcn_s_sleep(1);
        if ((++sp & 255u) == 0u) { if (xb_ld(&bar[XB_TMO])) break; if (sp > XB_SPIN_CAP) { atomicAdd(&bar[XB_TMO], 1u); break; } }
    }
    nloc = mine > 0u ? mine : 1u; nx = cnt > 0u ? cnt : 1u;
}

__device__ __forceinline__ void xcd_barrier(const XcdBarrier& b) {
    asm volatile("s_waitcnt vmcnt(0)" ::: "memory");
    __syncthreads();
    if (threadIdx.x == 0) {
        unsigned* bar = b.bar;
        __builtin_amdgcn_s_waitcnt(0);
        unsigned nloc = b.st[0], nx = b.st[1];
        if (nloc == 0u) { xcd_barrier_complete(bar, b.x, nloc, nx); b.st[0] = nloc; b.st[1] = nx; }
        const unsigned old = xb_add(&bar[XB_XSUB(b.x)], 1u);
        const unsigned gen = old / nloc;
        if (old + 1u == (gen + 1u) * nloc) {
            __builtin_amdgcn_fence(__ATOMIC_RELEASE, "agent");
            asm volatile("s_waitcnt vmcnt(0)" ::: "memory");
            const unsigned og = xb_add(&bar[XB_TOP], 1u);
            const unsigned tg = og / nx;
            if (og + 1u == (tg + 1u) * nx) xb_add(&bar[XB_TOPGEN], 1u);
            else XB_SPIN(xb_ld(&bar[XB_TOPGEN]) == tg, bar);
            __builtin_amdgcn_fence(__ATOMIC_ACQUIRE, "agent");
            xb_add(&bar[XB_XGEN(b.x)], 1u);
            asm volatile("s_waitcnt vmcnt(0)" ::: "memory");
        } else {
            XB_SPIN(xb_ld(&bar[XB_XGEN(b.x)]) == gen, bar);
            __builtin_amdgcn_fence(__ATOMIC_ACQUIRE, "agent");
            asm volatile("s_waitcnt vmcnt(0)" ::: "memory");
        }
    }
    __syncthreads();
}
__device__ __forceinline__ void transpose_item(const float* W, int Nsrc, int ns0, int k0, bf16* WT, int Kdim, int nd0, LAS float* scr, int lane) {
#pragma unroll 8
    for (int i = 0; i < 32; ++i) { const int kk = 2 * i + (lane >> 5); scr[kk * 33 + (lane & 31)] = W[(size_t)(k0 + kk) * Nsrc + ns0 + (lane & 31)]; }
    LDS_WAIT(); asm volatile("" ::: "memory");
    const int c = lane & 7;
#pragma unroll
    for (int j = 0; j < 4; ++j) { const int n = (lane >> 3) + 8 * j; const LAS float* s = scr + (8 * c) * 33 + n;
        v4u o; o.x = pk2(s[0 * 33], s[1 * 33]); o.y = pk2(s[2 * 33], s[3 * 33]); o.z = pk2(s[4 * 33], s[5 * 33]); o.w = pk2(s[6 * 33], s[7 * 33]);
        *(GAS v4u*)(WT + (size_t)(nd0 + n) * Kdim + k0 + 8 * c) = o; }
    LDS_WAIT(); asm volatile("" ::: "memory");
}
struct Ptrs {
    const float *x, *c, *w_mod, *b_mod, *w_in, *conv_w, *conv_b, *b_ig, *b_fg, *mnorm_w, *hnorm_w, *lb_logits, *w_out, *ln1_g, *ln1_b, *w_gate, *w_up, *w_down, *ln2_g, *ln2_b;
    float* out; unsigned char* ws;
};
constexpr int IT_IN = 32 * 224, IT_OUT = 32 * 64, IT_GU = 32 * 352, IT_DN = 88 * 64, IT_LAYER = IT_IN + IT_OUT + IT_GU + IT_DN, IT_ALL = DEPTH * IT_LAYER;
__device__ __forceinline__ void do_transpose(const Ptrs& P, int it, LAS float* scr, int lane) {
    const int l = it / IT_LAYER; int r = it % IT_LAYER;
    if (r < IT_IN) { const int kb = r / 224, nb = r % 224, n0 = 32 * nb;
        transpose_item(P.w_in + (size_t)l * D * DIN, DIN, n0 + (n0 >= 3072 ? 8 : 0), 64 * kb, (bf16*)(P.ws + WS_WIN) + (size_t)l * NPROJ * D, D, n0, scr, lane); return; }
    r -= IT_IN;
    if (r < IT_OUT) { const int kb = r / 64, nb = r % 64, n0 = 32 * nb;
        transpose_item(P.w_out + (size_t)l * D * D, D, n0, 64 * kb, (bf16*)(P.ws + WS_WOUT) + (size_t)l * D * D, D, n0, scr, lane); return; }
    r -= IT_OUT;
    if (r < IT_GU) { const int kb = r / 352, nb = r % 352, n0 = 32 * nb, pn = n0 >> 8, wi = n0 & 255, bj = wi >> 7, jc = wi & 127;
        transpose_item((bj ? P.w_up : P.w_gate) + (size_t)l * D * FF, FF, 128 * pn + jc, 64 * kb, (bf16*)(P.ws + WS_WGU) + (size_t)l * NGU * D, D, n0, scr, lane); return; }
    r -= IT_GU;
    { const int kb = r / 64, nb = r % 64, n0 = 32 * nb;
        transpose_item(P.w_down + (size_t)l * FF * D, D, n0, 64 * kb, (bf16*)(P.ws + WS_WDN) + (size_t)l * D * FF, FF, n0, scr, lane); }
}
__device__ __forceinline__ void phase_prologue(const Ptrs& P, LAS unsigned char* lds, int tid, int lane, int wave, int G) {
    LAS float* ca = (LAS float*)(lds + 8 * 8704);
    for (int i = tid; i < 2 * D; i += NTHR) ca[i] = silu_f(P.c[i]);
    __syncthreads();
    const int gw = wave * G + (int)blockIdx.x, NGW = G * NWAVES;
    float* MOD = (float*)(P.ws + WS_MOD);
    for (int item = gw; item < DEPTH * 192; item += NGW) {
        const int l = item / 192, j = (item % 192) * 64 + lane;
        const float* w = P.w_mod + (size_t)l * D * NMODC + j;
        float a0 = 0.f, a1 = 0.f;
        for (int k = 0; k < D; k += 16) { float wv[16];
#pragma unroll
            for (int i = 0; i < 16; ++i) wv[i] = w[(size_t)(k + i) * NMODC];
#pragma unroll
            for (int i = 0; i < 16; ++i) { a0 += ca[k + i] * wv[i]; a1 += ca[D + k + i] * wv[i]; } }
        const float bm = P.b_mod[l * NMODC + j];
        MOD[(l * 2 + 0) * NMODC + j] = a0 + bm; MOD[(l * 2 + 1) * NMODC + j] = a1 + bm;
    }
    const int gid = (int)blockIdx.x * NTHR + tid;
    if (gid < DEPTH * 8 * D) { const int l = gid >> 14, jg = (gid >> 11) & 7, k = gid & 2047; ((float*)(P.ws + WS_GW))[gid] = P.w_in[((size_t)l * D + k) * DIN + 3072 + jg]; }
    if (gid < 1024) { const float g0 = P.lb_logits[gid], g1 = P.lb_logits[1024 + gid], g2 = P.lb_logits[2048 + gid], g3 = P.lb_logits[3072 + gid];
        const float mx = fmaxf(fmaxf(g0, g1), fmaxf(g2, g3)), e0 = expf(g0 - mx), e1 = expf(g1 - mx), e2 = expf(g2 - mx), e3 = expf(g3 - mx), inv = 1.0f / (e0 + e1 + e2 + e3);
        float* LB = (float*)(P.ws + WS_LB); LB[gid] = 0.f; LB[1024 + gid] = e1 * inv; LB[2048 + gid] = (e1 + e2) * inv; LB[3072 + gid] = (e1 + e2 + e3) * inv; }
    LAS float* scr = (LAS float*)(lds + wave * 8704);
    const int nmodw = DEPTH * 192 < NGW ? DEPTH * 192 : NGW;
    const int rest = NGW - nmodw;
    int r1, r2;
    if (rest > 0) { r2 = (IT_ALL + 50 * nmodw + NGW - 1) / NGW; r1 = r2 - 50; if (r1 < 0) r1 = 0; while ((long)r1 * nmodw + (long)r2 * rest < IT_ALL) ++r2; } else { r1 = (IT_ALL + NGW - 1) / NGW; r2 = r1; }
    int lo, hi;
    if (gw < nmodw) { lo = gw * r1; hi = lo + r1; } else { lo = nmodw * r1 + (gw - nmodw) * r2; hi = lo + r2; }
    if (hi > IT_ALL) hi = IT_ALL;
    for (int it = lo; it < hi; ++it) do_transpose(P, it, scr, lane);
}
template <bool DO_LN, bool MAKE_U, bool GATES>
__device__ __forceinline__ void phase_rows(LAS unsigned char* lds, int tid, int lane, int wave, int G, const float* src, float* dst, const float* lng, const float* lnb,
                                           bf16* U, const float* sc, const float* sh, const float* gwl, const float* b_ig, const float* b_fg, float* GT) {
    LAS float* wg = (LAS float*)lds;
    if (GATES) { for (int i = tid; i < 8 * D; i += NTHR) wg[i] = gwl[i]; __syncthreads(); }
    const int gw = (int)blockIdx.x * NWAVES + wave, NGW = G * NWAVES;
    for (int m = gw; m < M; m += NGW) {
        const int b = m >> 13;
        const float* xr = src + (size_t)m * D + 4 * lane;
        f32x4 v[8];
#pragma unroll
        for (int j = 0; j < 8; ++j) v[j] = *(const f32x4*)(xr + 256 * j);
        if (DO_LN) {
            float s = 0.f;
#pragma unroll
            for (int j = 0; j < 8; ++j) s += (v[j].x + v[j].y) + (v[j].z + v[j].w);
            const float mean = wave_sum(s) * (1.f / D); float s2 = 0.f;
#pragma unroll
            for (int j = 0; j < 8; ++j) { v[j] = v[j] - mean; s2 += (v[j].x * v[j].x + v[j].y * v[j].y) + (v[j].z * v[j].z + v[j].w * v[j].w); }
            const float rstd = 1.f / sqrtf(wave_sum(s2) * (1.f / D) + LN_EPS);
#pragma unroll
            for (int j = 0; j < 8; ++j) { const f32x4 g = *(const f32x4*)(lng + 4 * lane + 256 * j), bb = *(const f32x4*)(lnb + 4 * lane + 256 * j); v[j] = v[j] * rstd * g + bb; }
        }
        if (dst) {
            float* xo = dst + (size_t)m * D + 4 * lane;
#pragma unroll
            for (int j = 0; j < 8; ++j) *(f32x4*)(xo + 256 * j) = v[j];
        }
        if (MAKE_U) {
            const float* scb = sc + (size_t)b * NMODC + 4 * lane; const float* shb = sh + (size_t)b * NMODC + 4 * lane;
            bf16* uo = U + (size_t)m * D + 4 * lane;
#pragma unroll
            for (int j = 0; j < 8; ++j) { const f32x4 a = *(const f32x4*)(scb + 256 * j), c = *(const f32x4*)(shb + 256 * j); v[j] = v[j] * (a + 1.0f) + c;
                v2u w; w.x = pk2(v[j].x, v[j].y); w.y = pk2(v[j].z, v[j].w); *(v2u*)(uo + 256 * j) = w; }
            if (GATES) {
                float mine = 0.f;
#pragma unroll 1
                for (int jg = 0; jg < 8; ++jg) { float p = 0.f;
#pragma unroll
                    for (int j = 0; j < 8; ++j) { const f32x4 w = *(const LAS f32x4*)(wg + jg * D + 4 * lane + 256 * j); p += (v[j].x * w.x + v[j].y * w.y) + (v[j].z * w.z + v[j].w * w.w); }
                    p = wave_sum(p); if (lane == jg) mine = p; }
                if (lane < 8) GT[(size_t)m * 8 + lane] = mine + (lane < 4 ? b_ig[lane] : b_fg[lane - 4]);
            }
        }
    }
}
constexpr int TS = 16;
__device__ __forceinline__ void naive_mlstm(LAS unsigned char* lds, int bh, int tid, const bf16* PROJ, const float* GT, const float* convw, const float* convb, float* HRAW, float* DEN) {
    const int b = bh >> 2, h = bh & 3;
    LAS float* qs = (LAS float*)lds; LAS float* ks = qs + TS * 128; LAS float* vs = ks + TS * 128; LAS float* gs = vs + TS * 256;
    float C[128];
#pragma unroll
    for (int d = 0; d < 128; ++d) C[d] = 0.f;
    float mrun = 0.f;
    const bool isv = tid < 256, isn = tid == 256;
    for (int t0 = 0; t0 < T; t0 += TS) {
        __syncthreads();
        for (int i = tid; i < TS * 256; i += NTHR) {
            const int tt = i >> 8, c = i & 255, ch = (c < 128) ? (h * 128 + c) : (512 + h * 128 + (c - 128)), t = t0 + tt;
            float a = convb[ch];
#pragma unroll
            for (int j = 0; j < 4; ++j) { const int ts = t - 3 + j; if (ts >= 0) a += convw[j * 1024 + ch] * bf2f(PROJ[(size_t)(b * T + ts) * NPROJ + PC_QK + ch]); }
            a = silu_f(a);
            if (c < 128) qs[tt * 128 + c] = a * QSCALE; else ks[tt * 128 + (c - 128)] = a;
        }
        for (int i = tid; i < TS * 256; i += NTHR) { const int tt = i >> 8, v = i & 255; vs[i] = bf2f(PROJ[(size_t)(b * T + t0 + tt) * NPROJ + PC_V + h * 256 + v]); }
        if (tid < TS) { const float* g = GT + (size_t)(b * T + t0 + tid) * 8; gs[tid * 2] = logsigmoid_f(g[4 + h]); gs[tid * 2 + 1] = g[h]; }
        __syncthreads();
        if (isv || isn) {
            for (int tt = 0; tt < TS; ++tt) {
                const float lf = gs[tt * 2], ig = gs[tt * 2 + 1];
                const float mnew = fmaxf(lf + mrun, ig), fdec = __expf(lf + mrun - mnew), iw = __expf(ig - mnew);
                mrun = mnew;
                const float a = iw * (isn ? 1.0f : vs[tt * 256 + (tid & 255)]);
                float n0 = 0.f, n1 = 0.f, n2 = 0.f, n3 = 0.f;
#pragma unroll
                for (int d = 0; d < 128; d += 4) {
                    const f32x4 kv = *(const LAS f32x4*)(ks + tt * 128 + d), qv = *(const LAS f32x4*)(qs + tt * 128 + d);
                    C[d] = fdec * C[d] + a * kv.x; n0 += qv.x * C[d];
                    C[d + 1] = fdec * C[d + 1] + a * kv.y; n1 += qv.y * C[d + 1];
                    C[d + 2] = fdec * C[d + 2] + a * kv.z; n2 += qv.z * C[d + 2];
                    C[d + 3] = fdec * C[d + 3] + a * kv.w; n3 += qv.w * C[d + 3];
                }
                const float num = (n0 + n1) + (n2 + n3);
                const size_t m = (size_t)(b * T + t0 + tt);
                if (isn) DEN[m * 4 + h] = fmaxf(fabsf(num), __expf(-mnew)); else HRAW[m * 2048 + h * 256 + tid] = num;
            }
        }
    }
}
__device__ __forceinline__ void naive_hgrn(LAS unsigned char* lds, int bh, int tid, const bf16* PROJ, const float* lbl, float* HRAW) {
    const int b = bh >> 3, h = bh & 7;
    LAS float* qs = (LAS float*)lds; LAS float* fs = qs + TS * 128; LAS float* ks = fs + TS * 128; LAS float* vs = ks + TS * 128;
    float S[128];
#pragma unroll
    for (int d = 0; d < 128; ++d) S[d] = 0.f;
    for (int t0 = 0; t0 < T; t0 += TS) {
        __syncthreads();
        for (int i = tid; i < TS * 128; i += NTHR) {
            const int tt = i >> 7, d = i & 127; const bf16* pr = PROJ + (size_t)(b * T + t0 + tt) * NPROJ + h * 128 + d;
            const float qr = bf2f(pr[PC_QH]), fp = bf2f(pr[PC_FH]), iv = bf2f(pr[PC_IH]), lbv = lbl[h * 128 + d];
            const float sg = 1.0f / (1.0f + __expf(-fp)), sn = 1.0f / (1.0f + __expf(fp));
            qs[i] = silu_f(qr); fs[i] = lbv + (1.0f - lbv) * sg; ks[i] = (1.0f - lbv) * sn; vs[i] = iv;
        }
        __syncthreads();
        if (tid < 128) {
            for (int tt = 0; tt < TS; ++tt) {
                const float vt = vs[tt * 128 + tid];
                float n0 = 0.f, n1 = 0.f, n2 = 0.f, n3 = 0.f;
#pragma unroll
                for (int d = 0; d < 128; d += 4) {
                    const f32x4 fv = *(const LAS f32x4*)(fs + tt * 128 + d), kv = *(const LAS f32x4*)(ks + tt * 128 + d), qv = *(const LAS f32x4*)(qs + tt * 128 + d);
                    S[d] = fv.x * S[d] + kv.x * vt; n0 += qv.x * S[d];
                    S[d + 1] = fv.y * S[d + 1] + kv.y * vt; n1 += qv.y * S[d + 1];
                    S[d + 2] = fv.z * S[d + 2] + kv.z * vt; n2 += qv.z * S[d + 2];
                    S[d + 3] = fv.w * S[d + 3] + kv.w * vt; n3 += qv.w * S[d + 3];
                }
                HRAW[(size_t)(b * T + t0 + tt) * 2048 + 1024 + h * 128 + tid] = (n0 + n1) + (n2 + n3);
            }
        }
    }
}
__device__ __forceinline__ void phase_fin(int lane, int wave, int G, const float* HRAW, const float* DEN, const bf16* PROJ, const float* mnw, const float* hnw, bf16* YMIX) {
    const int gw = (int)blockIdx.x * NWAVES + wave, NGW = G * NWAVES;
    for (int m = gw; m < M; m += NGW) {
        const float* hr = HRAW + (size_t)m * 2048; const bf16* pr = PROJ + (size_t)m * NPROJ; bf16* y = YMIX + (size_t)m * 2048;
#pragma unroll
        for (int h = 0; h < 4; ++h) {
            f32x4 v = *(const f32x4*)(hr + h * 256 + 4 * lane); const float dn = DEN[(size_t)m * 4 + h];
            v = v / dn;
            const float mean = wave_sum((v.x + v.y) + (v.z + v.w)) * (1.f / 256.f); v = v - mean;
            const float var = wave_sum((v.x * v.x + v.y * v.y) + (v.z * v.z + v.w * v.w)) * (1.f / 256.f), r = 1.f / sqrtf(var + LN_EPS);
            const f32x4 w = *(const f32x4*)(mnw + h * 256 + 4 * lane); const v2u o = *(const v2u*)(pr + PC_O + h * 256 + 4 * lane);
            const float o0 = v.x * r * w.x * sigmoid_f(bflo(o.x)), o1 = v.y * r * w.y * sigmoid_f(bfhi(o.x)), o2 = v.z * r * w.z * sigmoid_f(bflo(o.y)), o3 = v.w * r * w.w * sigmoid_f(bfhi(o.y));
            v2u q; q.x = pk2(o0, o1); q.y = pk2(o2, o3); *(v2u*)(y + h * 256 + 4 * lane) = q;
        }
#pragma unroll
        for (int h = 0; h < 8; ++h) {
            const f32x2 v = *(const f32x2*)(hr + 1024 + h * 128 + 2 * lane);
            const float ms = wave_sum(v.x * v.x + v.y * v.y) * (1.f / 128.f), r = 1.f / sqrtf(ms + LN_EPS);
            const f32x2 w = *(const f32x2*)(hnw + h * 128 + 2 * lane); const unsigned g = *(const unsigned*)(pr + PC_GH + h * 128 + 2 * lane);
            *(unsigned*)(y + 1024 + h * 128 + 2 * lane) = pk2(v.x * r * w.x * silu_f(bflo(g)), v.y * r * w.y * silu_f(bfhi(g)));
        }
    }
}
constexpr int NPH = 2 + 8 * DEPTH;
struct Args { const float* in[20]; float* out; unsigned char* ws; int ph_lo, ph_hi; };
__global__ void __launch_bounds__(NTHR, 2) fwd(Args args) {
    extern __shared__ __attribute__((aligned(16))) unsigned char lds_raw[];
    LAS unsigned char* lds = (LAS unsigned char*)lds_raw;
    const int tid0 = threadIdx.x, G = gridDim.x;
#define PHASE_IDS() int tid = threadIdx.x; asm volatile("" : "+v"(tid)); const int lane = tid & 63, wave = __builtin_amdgcn_readfirstlane(tid >> 6); (void)lane; (void)wave
    Ptrs P;
    P.x = args.in[0]; P.c = args.in[1]; P.w_mod = args.in[2]; P.b_mod = args.in[3]; P.w_in = args.in[4]; P.conv_w = args.in[5]; P.conv_b = args.in[6]; P.b_ig = args.in[7]; P.b_fg = args.in[8];
    P.mnorm_w = args.in[9]; P.hnorm_w = args.in[10]; P.lb_logits = args.in[11]; P.w_out = args.in[12]; P.ln1_g = args.in[13]; P.ln1_b = args.in[14]; P.w_gate = args.in[15]; P.w_up = args.in[16];
    P.w_down = args.in[17]; P.ln2_g = args.in[18]; P.ln2_b = args.in[19]; P.out = args.out; P.ws = args.ws;
    volatile LAS unsigned* MISC = (volatile LAS unsigned*)(lds + MISC_OFF);
    if (tid0 < 32) MISC[tid0] = 0u;
    __syncthreads();
#if MK_ONE_LAUNCH
    XcdBarrier bar = xcd_barrier_post((unsigned*)(P.ws + WS_CTL) + CW_BAR, MISC + 8);
#define SEAM() xcd_barrier(bar)
#else
#define SEAM() do { } while (0)
#endif
    const int lo = args.ph_lo, hi = args.ph_hi;
#define IN(k) (lo <= (k) && (k) < hi)
#define SEAM_AFTER(k) do { if ((k) + 1 < hi) { SEAM(); } } while (0)
    float* MOD = (float*)(P.ws + WS_MOD); float* X = (float*)(P.ws + WS_X); bf16* U = (bf16*)(P.ws + WS_U); bf16* YMIX = (bf16*)(P.ws + WS_YMIX); bf16* PROJ = (bf16*)(P.ws + WS_PROJ); bf16* HB = (bf16*)(P.ws + WS_PROJ);
    float* HRAW = (float*)(P.ws + WS_HRAW); float* GT = (float*)(P.ws + WS_GATES); float* DEN = (float*)(P.ws + WS_DEN);

#ifndef SKIP_PRO
    if (IN(0)) { PHASE_IDS(); phase_prologue(P, lds, tid, lane, wave, G); SEAM_AFTER(0); }
#endif

    for (int l = 0; l < DEPTH; ++l) {
        const int base = 1 + 8 * l;
        if (base + 8 <= lo || base >= hi) continue;
        const float* modl = MOD + (size_t)l * 2 * NMODC;
#ifndef SKIP_P0
        if (IN(base + 0)) {
            PHASE_IDS();
            const float* gwl = (const float*)(P.ws + WS_GW) + (size_t)l * 8 * D;
            if (l == 0) phase_rows<false, true, true>(lds, tid, lane, wave, G, P.x, X, nullptr, nullptr, U, modl + 1 * D, modl + 0 * D, gwl, P.b_ig + l * 4, P.b_fg + l * 4, GT);
            else        phase_rows<true, true, true>(lds, tid, lane, wave, G, X, X, P.ln2_g + (l - 1) * D, P.ln2_b + (l - 1) * D, U, modl + 1 * D, modl + 0 * D, gwl, P.b_ig + l * 4, P.b_fg + l * 4, GT);
            SEAM_AFTER(base + 0);
        }
#endif
#ifndef SKIP_P1
        if (IN(base + 1)) {
            PHASE_IDS();
            pg8::Gemm g{U, (const bf16*)(P.ws + WS_WIN) + (size_t)l * NPROJ * D, M, NPROJ, D}; pg8::StaticOrder S; S.init(M, NPROJ, G, (int)blockIdx.x);
            pg8::EpiProj E{PROJ, NPROJ};
            pg8::gemm_phase<pg8::EpiProj, pg8::StaticOrder, true, true>(lds, g, S, E);
            SEAM_AFTER(base + 1);
        }
#endif
#ifndef SKIP_P2
        if (IN(base + 2)) {
            PHASE_IDS();
            const int bx = (int)blockIdx.x;
#ifndef SKIP_NAIVE
            if (bx < 8) naive_mlstm(lds, bx, tid, PROJ, GT, P.conv_w + (size_t)l * 4 * 1024, P.conv_b + (size_t)l * 1024, HRAW, DEN);
            else if (bx < 24) naive_hgrn(lds, bx - 8, tid, PROJ, (const float*)(P.ws + WS_LB) + l * 1024, HRAW);
#endif
            SEAM_AFTER(base + 2);
        }
#endif
#ifndef SKIP_P3
        if (IN(base + 3)) {
            PHASE_IDS();
            phase_fin(lane, wave, G, HRAW, DEN, PROJ, P.mnorm_w + l * 1024, P.hnorm_w + l * 1024, YMIX);
            SEAM_AFTER(base + 3);
        }
#endif
#ifndef SKIP_P4
        if (IN(base + 4)) {
            PHASE_IDS();
            pg8::Gemm g{YMIX, (const bf16*)(P.ws + WS_WOUT) + (size_t)l * D * D, M, D, D}; pg8::StaticOrder S; S.init(M, D, G, (int)blockIdx.x);
            pg8::EpiResid E{X, D, modl + 2 * D, modl + NMODC + 2 * D, DN_ALPHA};
            pg8::gemm_phase<pg8::EpiResid, pg8::StaticOrder, true, true>(lds, g, S, E);
            SEAM_AFTER(base + 4);
        }
#endif
#ifndef SKIP_P5
        if (IN(base + 5)) {
            PHASE_IDS();
            phase_rows<true, true, false>(lds, tid, lane, wave, G, X, X, P.ln1_g + l * D, P.ln1_b + l * D, U, modl + 4 * D, modl + 3 * D, nullptr, nullptr, nullptr, nullptr);
            SEAM_AFTER(base + 5);
        }
#endif
#ifndef SKIP_P6
        if (IN(base + 6)) {
            PHASE_IDS();
            pg8::Gemm g{U, (const bf16*)(P.ws + WS_WGU) + (size_t)l * NGU * D, M, NGU, D}; pg8::StaticOrder S; S.init(M, NGU, G, (int)blockIdx.x);
            pg8::EpiSwiGLU E{HB, FF};
            pg8::gemm_phase<pg8::EpiSwiGLU, pg8::StaticOrder, true, true>(lds, g, S, E);
            SEAM_AFTER(base + 6);
        }
#endif
#ifndef SKIP_P7
        if (IN(base + 7)) {
            PHASE_IDS();
            pg8::Gemm g{HB, (const bf16*)(P.ws + WS_WDN) + (size_t)l * D * FF, M, D, FF}; pg8::StaticOrder S; S.init(M, D, G, (int)blockIdx.x);
            pg8::EpiResid E{X, D, modl + 5 * D, modl + NMODC + 5 * D, DN_ALPHA};
            pg8::gemm_phase<pg8::EpiResid, pg8::StaticOrder, true, true>(lds, g, S, E);
            SEAM_AFTER(base + 7);
        }
#endif
    }
    if (IN(NPH - 1)) { PHASE_IDS(); phase_rows<true, false, false>(lds, tid, lane, wave, G, X, P.out, P.ln2_g + (DEPTH - 1) * D, P.ln2_b + (DEPTH - 1) * D, nullptr, nullptr, nullptr, nullptr, nullptr, nullptr, nullptr); }
#undef IN
#undef SEAM_AFTER
#undef SEAM
}
extern "C" void kernel_launch(void* const* d_in, const int* in_sizes, int n_in, void* d_out, int out_size, void* d_ws, size_t ws_size, hipStream_t stream) {
    static int grid = 0;
    if (grid == 0) {
        if (n_in != 20 || out_size != M * D || ws_size < WS_END) { fprintf(stderr, "kernel_launch: unexpected problem (n_in %d, out %d, ws %zu < %zu)\n", n_in, out_size, ws_size, (size_t)WS_END); grid = -1; return; }
        int dev = 0, cus = 0;
        if (hipGetDevice(&dev) != hipSuccess || hipDeviceGetAttribute(&cus, hipDeviceAttributeMultiprocessorCount, dev) != hipSuccess) { grid = -1; return; }
        if (hipFuncSetAttribute((const void*)fwd, hipFuncAttributeMaxDynamicSharedMemorySize, LDS_BYTES) != hipSuccess) { fprintf(stderr, "kernel_launch: hipFuncSetAttribute failed\n"); grid = -1; return; }
        int per_cu = 0; (void)hipOccupancyMaxActiveBlocksPerMultiprocessor(&per_cu, (const void*)fwd, NTHR, LDS_BYTES); (void)hipGetLastError();
        if (per_cu < 1) fprintf(stderr, "kernel_launch: occupancy query reports %d workgroups per CU\n", per_cu);
        grid = cus;
    }
    if (grid < 0) return;
    (void)hipMemsetAsync((char*)d_ws + WS_CTL, 0, CTL_ZERO_BYTES, stream);
    Args a{};
    for (int i = 0; i < 20; ++i) a.in[i] = (const float*)d_in[i];
    a.out = (float*)d_out; a.ws = (unsigned char*)d_ws;
#if MK_ONE_LAUNCH
    a.ph_lo = 0; a.ph_hi = NPH;
    hipLaunchKernelGGL(fwd, dim3(grid), dim3(NTHR), LDS_BYTES, stream, a);
#else
    for (int p = 0; p < NPH; ++p) { a.ph_lo = p; a.ph_hi = p + 1; hipLaunchKernelGGL(fwd, dim3(grid), dim3(NTHR), LDS_BYTES, stream, a); }
#endif
}
```

```cpp
#include <hip/hip_runtime.h>
#include <cstdio>
#include <cstdint>
#ifndef MK_ONE_LAUNCH
#define MK_ONE_LAUNCH 1
#endif
namespace pg8 {
#define PG8_LAS __attribute__((address_space(3)))
typedef unsigned short bf16_t;
typedef short bf16x8 __attribute__((ext_vector_type(8)));
typedef float f32x4 __attribute__((ext_vector_type(4)));
typedef unsigned u32x4 __attribute__((ext_vector_type(4)));
constexpr int BM = 256, BK = 64, HALF = 128, HTB = HALF * BK * 2  , STAGE_BYTES = 8 * HTB, NXCD = 8, WGM = 8;

__host__ __device__ __forceinline__ int lds_byte(int r, int c) { const int st = (r >> 4) * 2 + (c >> 5), rr = r & 15, cc = c & 31, ob = rr * 64 + cc * 2; return st * 1024 + (ob ^ (((ob >> 9) & 1) << 5)); }
__host__ __device__ __forceinline__ void stage_rc(int b, int& R, int& C) { const int st = b / 1024, sb = b % 1024, swz = sb ^ (((sb >> 9) & 1) << 5); R = (st >> 1) * 16 + swz / 64; C = (st & 1) * 32 + (swz % 64) / 2; }
__host__ __device__ __forceinline__ int perm32(int rho) { const int n = rho >> 4, i = rho & 15; return 8 * (i >> 2) + 4 * n + (i & 3); }

struct Unit { int pm, pn; };
struct Gemm { const bf16_t* A; const bf16_t* Bt; int M, N, K; };

struct StaticOrder {
    int nM, nN, nwg, G, c;
    __host__ __device__ void init(int M, int N, int G_, int c_) { nM = M / BM; nN = N / BM; nwg = nM * nN; G = G_; c = c_; }
    __host__ __device__ bool next(int i, Unit& u) const {
        const long L = (long)i * G + c; if (L >= nwg) return false;
        int wgid = (int)L; { const int q = nwg / NXCD, r = nwg % NXCD, xcd = wgid % NXCD, off = wgid / NXCD; wgid = (xcd < r ? xcd * (q + 1) : r * (q + 1) + (xcd - r) * q) + off; }
        const int nig = WGM * nN, gid = wgid / nig, fm = gid * WGM, gsz = (nM - fm) < WGM ? (nM - fm) : WGM;
        u.pm = fm + ((wgid % nig) % gsz); u.pn = (wgid % nig) / gsz; return true;
    }
    __device__ __forceinline__ void a_ready(const Unit&) const {}
    __device__ __forceinline__ void done(const Unit&) const {}
};

__device__ __forceinline__ unsigned cvt_pk_bf16(float lo, float hi) { unsigned r; asm volatile("v_cvt_pk_bf16_f32 %0, %1, %2" : "=v"(r) : "v"(lo), "v"(hi)); return r; }
typedef float f32x2 __attribute__((ext_vector_type(2)));
__device__ __forceinline__ float fast_silu(float x) { return x * __builtin_amdgcn_rcpf(1.0f + __expf(-x)); }
struct EpiProj {
    static constexpr bool PERM = true, AFTER_DRAIN = false;
    bf16_t* O; int ldc;
    __device__ __forceinline__ void operator()(const f32x4 (&acc)[2][2][4][2], const Unit& u, int wr, int wc, int fr, int fq) const {
        const int row0 = u.pm * BM + wr * 64 + fr, col0 = u.pn * BM + wc * 32 + 8 * fq;
#pragma unroll
        for (int ai = 0; ai < 2; ++ai)
#pragma unroll
            for (int m = 0; m < 4; ++m) { bf16_t* rowp = O + (size_t)(row0 + ai * HALF + m * 16) * ldc + col0;
#pragma unroll
                for (int bj = 0; bj < 2; ++bj) { const f32x4 v0 = acc[ai][bj][m][0], v1 = acc[ai][bj][m][1];
                    u32x4 w; w.x = cvt_pk_bf16(v0[0], v0[1]); w.y = cvt_pk_bf16(v0[2], v0[3]); w.z = cvt_pk_bf16(v1[0], v1[1]); w.w = cvt_pk_bf16(v1[2], v1[3]);
                    *(u32x4*)(rowp + bj * HALF) = w; } }
    }
};
struct EpiResid {
    static constexpr bool PERM = false, AFTER_DRAIN = false;
    float* X; int ldc; const float* g0; const float* g1; float alpha;
    __device__ __forceinline__ void operator()(const f32x4 (&acc)[2][2][4][2], const Unit& u, int wr, int wc, int fr, int fq) const {
        const int row0 = u.pm * BM + wr * 64 + fr, col0 = u.pn * BM + wc * 32 + 4 * fq;
        const float* g = (u.pm >= 32) ? g1 : g0;
        f32x4 gv[2][2];
#pragma unroll
        for (int bj = 0; bj < 2; ++bj)
#pragma unroll
            for (int n = 0; n < 2; ++n) gv[bj][n] = *(const f32x4*)(g + col0 + bj * HALF + n * 16) + 1.0f;
#pragma unroll
        for (int ai = 0; ai < 2; ++ai)
#pragma unroll
            for (int m = 0; m < 4; ++m) { float* rowp = X + (size_t)(row0 + ai * HALF + m * 16) * ldc + col0;
#pragma unroll
                for (int bj = 0; bj < 2; ++bj)
#pragma unroll
                    for (int n = 0; n < 2; ++n) { const f32x4 xo = *(const f32x4*)(rowp + bj * HALF + n * 16); *(f32x4*)(rowp + bj * HALF + n * 16) = xo * alpha + gv[bj][n] * acc[ai][bj][m][n]; }
                asm volatile("" ::: "memory"); }
    }
};
struct EpiSwiGLU {
    static constexpr bool PERM = true, AFTER_DRAIN = false;
    bf16_t* O; int ldc;
    __device__ __forceinline__ void operator()(const f32x4 (&acc)[2][2][4][2], const Unit& u, int wr, int wc, int fr, int fq) const {
        const int row0 = u.pm * BM + wr * 64 + fr, col0 = u.pn * HALF + wc * 32 + 8 * fq;
#pragma unroll
        for (int ai = 0; ai < 2; ++ai)
#pragma unroll
            for (int m = 0; m < 4; ++m) { bf16_t* rowp = O + (size_t)(row0 + ai * HALF + m * 16) * ldc + col0;
                const f32x4 g0 = acc[ai][0][m][0], g1 = acc[ai][0][m][1], u0 = acc[ai][1][m][0], u1 = acc[ai][1][m][1];
                f32x4 h0, h1;
#pragma unroll
                for (int j = 0; j < 4; ++j) { h0[j] = fast_silu(g0[j]) * u0[j]; h1[j] = fast_silu(g1[j]) * u1[j]; }
                u32x4 w; w.x = cvt_pk_bf16(h0[0], h0[1]); w.y = cvt_pk_bf16(h0[2], h0[3]); w.z = cvt_pk_bf16(h1[0], h1[1]); w.w = cvt_pk_bf16(h1[2], h1[3]);
                *(u32x4*)rowp = w; }
    }
};
template <class Epi, class Sched, bool ALIGN_EPI = false, bool SP2 = false>
__device__ __forceinline__ void gemm_phase(PG8_LAS unsigned char* lds, const Gemm g, const Sched& S, const Epi& E) {
    int tid_ = threadIdx.x; asm volatile("" : "+v"(tid_));
    const int tid = tid_, wid = __builtin_amdgcn_readfirstlane(tid >> 6), lane = tid & 63, wr = wid >> 2, wc = wid & 3, fr = lane & 15, fq = lane >> 4;
    const int K = g.K, nt = K / BK;
    unsigned voffA[2], voffB[2];
#pragma unroll
    for (int i = 0; i < 2; ++i) { int R, C; stage_rc(tid * 16 + i * 8192, R, C); const int Rb = Epi::PERM ? ((R & ~31) + perm32(R & 31)) : R;
        voffA[i] = (unsigned)(R * K + C) * 2u; voffB[i] = (unsigned)(Rb * K + C) * 2u; }
    const size_t kstep = (size_t)(BK * 2);
    const size_t hstep = (size_t)HALF * K * 2;
    const size_t tstep = 2 * hstep;
    const unsigned ldsw = (unsigned)wid * 1024u;
    const int aoff = lds_byte(wr * 64 + fr, fq * 8), boff = lds_byte(wc * 32 + fr, fq * 8);
#define PG8_SA(b, h) (((b) * 2 + (h)) * HTB)
#define PG8_SB(b, h) ((4 + (b) * 2 + (h)) * HTB)
#define PG8_STAGE(bufoff, gbase, voff) do { _Pragma("unroll") for (int _i = 0; _i < 2; ++_i) \
        __builtin_amdgcn_global_load_lds((const unsigned*)((const char*)(gbase) + (voff)[_i]), (PG8_LAS unsigned*)(lds + (bufoff) + ldsw + _i * 8192), 16, 0, 0); } while (0)
#define PG8_LDA(dst, b, h) do { _Pragma("unroll") for (int m = 0; m < 4; ++m) _Pragma("unroll") for (int k = 0; k < 2; ++k) dst[m][k] = *(const PG8_LAS bf16x8*)(lds + PG8_SA(b, h) + aoff + m * 2048 + k * 1024); } while (0)
#define PG8_LDB(dst, b, h) do { _Pragma("unroll") for (int n = 0; n < 2; ++n) _Pragma("unroll") for (int k = 0; k < 2; ++k) dst[n][k] = *(const PG8_LAS bf16x8*)(lds + PG8_SB(b, h) + boff + n * 2048 + k * 1024); } while (0)
#define PG8_MMA(ai, bj, At, Bt) do { __builtin_amdgcn_s_setprio(1); _Pragma("unroll") for (int m = 0; m < 4; ++m) _Pragma("unroll") for (int n = 0; n < 2; ++n) _Pragma("unroll") for (int k = 0; k < 2; ++k) \
        acc[ai][bj][m][n] = __builtin_amdgcn_mfma_f32_16x16x32_bf16(Bt[n][k], At[m][k], acc[ai][bj][m][n], 0, 0, 0); __builtin_amdgcn_s_setprio(0); } while (0)
#define PG8_WAIT_V(n) asm volatile("s_waitcnt vmcnt(" #n ")" ::: "memory")
#define PG8_WAIT_L(n) asm volatile("s_waitcnt lgkmcnt(" #n ")" ::: "memory")
#define PG8_BAR __builtin_amdgcn_s_barrier()
#define PG8_SCHED __builtin_amdgcn_sched_barrier(0)
    Unit cur, nxt; int ui = 0;
    if (!S.next(0, cur)) return;
    f32x4 acc[2][2][4][2];
#pragma unroll
    for (int a = 0; a < 2; ++a)
#pragma unroll
        for (int b = 0; b < 2; ++b)
#pragma unroll
            for (int m = 0; m < 4; ++m)
#pragma unroll
                for (int n = 0; n < 2; ++n) acc[a][b][m][n] = (f32x4){0.f, 0.f, 0.f, 0.f};
    bf16x8 At[4][2], B0[2][2], B1[2][2];
    const char* cA = (const char*)g.A + (size_t)cur.pm * tstep; const char* cB = (const char*)g.Bt + (size_t)cur.pn * tstep;
    S.a_ready(cur);
    if constexpr (SP2) {
        PG8_STAGE(PG8_SB(0, 0), cB, voffB); PG8_STAGE(PG8_SB(0, 1), cB + hstep, voffB); PG8_STAGE(PG8_SA(0, 0), cA, voffA); PG8_STAGE(PG8_SA(0, 1), cA + hstep, voffA);
        if (wr == 1) PG8_BAR;
        PG8_WAIT_V(2); PG8_BAR;
        PG8_STAGE(PG8_SB(1, 0), cB + kstep, voffB); PG8_STAGE(PG8_SA(1, 0), cA + kstep, voffA); PG8_STAGE(PG8_SB(1, 1), cB + hstep + kstep, voffB);
        PG8_WAIT_V(6); PG8_BAR;
    } else {
        PG8_STAGE(PG8_SB(0, 0), cB, voffB); PG8_STAGE(PG8_SA(0, 0), cA, voffA); PG8_STAGE(PG8_SB(0, 1), cB + hstep, voffB); PG8_STAGE(PG8_SA(0, 1), cA + hstep, voffA);
        if (wr == 1) PG8_BAR;
        PG8_WAIT_V(4); PG8_BAR;
        PG8_STAGE(PG8_SB(1, 0), cB + kstep, voffB); PG8_STAGE(PG8_SA(1, 0), cA + kstep, voffA); PG8_STAGE(PG8_SB(1, 1), cB + hstep + kstep, voffB);
        PG8_WAIT_V(6); PG8_BAR;
    }
    for (;;) {
        const bool has_next = S.next(ui + 1, nxt);
        const char* nA = has_next ? (const char*)g.A + (size_t)nxt.pm * tstep : cA; const char* nB = has_next ? (const char*)g.Bt + (size_t)nxt.pn * tstep : cB;
        for (int t = 0; t < nt; t += 2) {
            const bool last = (t == nt - 2);
            const char* a1 = cA + (size_t)(t + 1) * kstep;
            const char* a2 = last ? nA : cA + (size_t)(t + 2) * kstep; const char* b2 = last ? nB : cB + (size_t)(t + 2) * kstep;
            const char* a3 = a2 + kstep; const char* b3 = b2 + kstep;
            if (last && has_next) S.a_ready(nxt);
            if constexpr (SP2) {
            PG8_LDB(B0, 0, 0); PG8_LDB(B1, 0, 1); PG8_SCHED; PG8_LDA(At, 0, 0); PG8_STAGE(PG8_SA(1, 1), a1 + hstep, voffA);
            PG8_WAIT_V(8); PG8_WAIT_L(0); PG8_BAR; PG8_MMA(0, 0, At, B0); PG8_MMA(0, 1, At, B1); PG8_BAR; PG8_SCHED;
            PG8_LDA(At, 0, 1); PG8_STAGE(PG8_SB(0, 0), b2, voffB); PG8_STAGE(PG8_SB(0, 1), b2 + hstep, voffB); PG8_STAGE(PG8_SA(0, 0), a2, voffA);
            PG8_WAIT_V(8); PG8_WAIT_L(0); PG8_BAR; PG8_MMA(1, 0, At, B0); PG8_MMA(1, 1, At, B1); PG8_BAR; PG8_SCHED;
            PG8_LDB(B0, 1, 0); PG8_LDB(B1, 1, 1); PG8_SCHED; PG8_LDA(At, 1, 0); PG8_STAGE(PG8_SA(0, 1), a2 + hstep, voffA);
            PG8_WAIT_V(8); PG8_WAIT_L(0); PG8_BAR; PG8_MMA(0, 0, At, B0); PG8_MMA(0, 1, At, B1); PG8_BAR; PG8_SCHED;
            PG8_LDA(At, 1, 1); PG8_STAGE(PG8_SB(1, 0), b3, voffB); PG8_STAGE(PG8_SB(1, 1), b3 + hstep, voffB); PG8_STAGE(PG8_SA(1, 0), a3, voffA);
            PG8_WAIT_V(8); PG8_WAIT_L(0); PG8_BAR; PG8_MMA(1, 0, At, B0); PG8_MMA(1, 1, At, B1); PG8_BAR; PG8_SCHED;
            } else {
            PG8_LDB(B0, 0, 0); PG8_SCHED; PG8_LDA(At, 0, 0); PG8_STAGE(PG8_SA(1, 1), a1 + hstep, voffA);
            PG8_WAIT_L(8); PG8_BAR; PG8_WAIT_L(0); PG8_MMA(0, 0, At, B0); PG8_BAR; PG8_SCHED;
            PG8_LDB(B1, 0, 1); PG8_STAGE(PG8_SB(0, 0), b2, voffB);
            PG8_BAR; PG8_WAIT_L(0); PG8_MMA(0, 1, At, B1); PG8_BAR;
            PG8_LDA(At, 0, 1); PG8_STAGE(PG8_SA(0, 0), a2, voffA);
            PG8_BAR; PG8_WAIT_L(0); PG8_MMA(1, 0, At, B0); PG8_BAR; PG8_SCHED;
            PG8_STAGE(PG8_SB(0, 1), b2 + hstep, voffB);
            PG8_WAIT_V(6); PG8_BAR; PG8_MMA(1, 1, At, B1); PG8_BAR;
            PG8_LDB(B0, 1, 0); PG8_SCHED; PG8_LDA(At, 1, 0); PG8_STAGE(PG8_SA(0, 1), a2 + hstep, voffA);
            PG8_WAIT_L(8); PG8_BAR; PG8_WAIT_L(0); PG8_MMA(0, 0, At, B0); PG8_BAR; PG8_SCHED;
            PG8_LDB(B1, 1, 1); PG8_STAGE(PG8_SB(1, 0), b3, voffB);
            PG8_BAR; PG8_WAIT_L(0); PG8_MMA(0, 1, At, B1); PG8_BAR;
            PG8_LDA(At, 1, 1); PG8_STAGE(PG8_SA(1, 0), a3, voffA);
            PG8_BAR; PG8_WAIT_L(0); PG8_MMA(1, 0, At, B0); PG8_BAR; PG8_SCHED;
            PG8_STAGE(PG8_SB(1, 1), b3 + hstep, voffB);
            PG8_WAIT_V(6); PG8_BAR; PG8_MMA(1, 1, At, B1); PG8_BAR;
            }
        }
        if constexpr (ALIGN_EPI) { if (wr == 0) PG8_BAR; }
        if constexpr (!Epi::AFTER_DRAIN) { E(acc, cur, wr, wc, fr, fq); S.done(cur); }
        if (!has_next) break;
#pragma unroll
        for (int a = 0; a < 2; ++a)
#pragma unroll
            for (int b = 0; b < 2; ++b)
#pragma unroll
                for (int m = 0; m < 4; ++m)
#pragma unroll
                    for (int n = 0; n < 2; ++n) acc[a][b][m][n] = (f32x4){0.f, 0.f, 0.f, 0.f};
        cur = nxt; cA = nA; cB = nB; ++ui;
        if constexpr (ALIGN_EPI) { if (wr == 1) PG8_BAR; }
    }
    PG8_WAIT_V(0);
    if constexpr (!ALIGN_EPI) { if (wr == 0) PG8_BAR; }
    PG8_BAR;
    if constexpr (Epi::AFTER_DRAIN) { E.fused(acc, cur, wr, wc, fr, fq, lds, wid, lane); S.done(cur); }
#undef PG8_SA
#undef PG8_SB
#undef PG8_STAGE
#undef PG8_LDA
#undef PG8_LDB
#undef PG8_MMA
#undef PG8_WAIT_V
#undef PG8_WAIT_L
#undef PG8_BAR
#undef PG8_SCHED
}
}
constexpr int NWAVES = 8, NTHR = 512;
constexpr int D = 2048, BATCH = 2, T = 8192, DEPTH = 4, M = BATCH * T;
constexpr int NPROJ = 7168, DIN = 7176, FF = 5632, NGU = 2 * FF, NMODC = 6 * D;
constexpr float LN_EPS = 1e-5f, DN_ALPHA = 1.6817928305074292f, QSCALE = 0.08838834764831845f;
constexpr int PC_QK = 0, PC_V = 1024, PC_O = 2048, PC_QH = 3072, PC_FH = 4096, PC_IH = 5120, PC_GH = 6144;
constexpr size_t MiB = 1u << 20;
constexpr size_t WS_CTL = 0, CTL_ZERO_BYTES = 1 * MiB;
constexpr size_t WS_MOD = 1 * MiB;
constexpr size_t WS_LB = WS_MOD + 512 * 1024;
constexpr size_t WS_GW = WS_LB + 64 * 1024;
constexpr size_t WS_GATES = 2 * MiB;
constexpr size_t WS_DEN = 3 * MiB;
constexpr size_t WS_WIN = 4 * MiB;
constexpr size_t WS_WOUT = WS_WIN + 112 * MiB;
constexpr size_t WS_WGU = WS_WOUT + 32 * MiB;
constexpr size_t WS_WDN = WS_WGU + 176 * MiB;
constexpr size_t WS_X = WS_WDN + 88 * MiB;
constexpr size_t WS_U = WS_X + 128 * MiB;
constexpr size_t WS_YMIX = WS_U + 64 * MiB;
constexpr size_t WS_PROJ = WS_YMIX + 64 * MiB;
constexpr size_t WS_HRAW = WS_PROJ + 224 * MiB;
constexpr size_t WS_END = WS_HRAW + 128 * MiB;
constexpr int CW_BAR = 4096;
constexpr int RING_BYTES = 131072, MISC_OFF = RING_BYTES + 256, LDS_BYTES = 147456;
#define GAS __attribute__((address_space(1)))
#define LAS __attribute__((address_space(3)))
typedef unsigned short bf16;
typedef unsigned v4u __attribute__((ext_vector_type(4)));
typedef unsigned v2u __attribute__((ext_vector_type(2)));
typedef float f32x4 __attribute__((ext_vector_type(4)));
typedef float f32x2 __attribute__((ext_vector_type(2)));
#define LDS_WAIT() asm volatile("s_waitcnt lgkmcnt(0)" ::: "memory")
#define VM_WAIT() asm volatile("s_waitcnt vmcnt(0)" ::: "memory")
__device__ __forceinline__ unsigned f2bf(float f) { unsigned u = __builtin_bit_cast(unsigned, f); return (u + 0x7fffu + ((u >> 16) & 1u)) >> 16; }
__device__ __forceinline__ unsigned pk2(float lo, float hi) { return f2bf(lo) | (f2bf(hi) << 16); }
__device__ __forceinline__ float bf2f(unsigned short b) { return __builtin_bit_cast(float, (unsigned)b << 16); }
__device__ __forceinline__ float bflo(unsigned w) { return __builtin_bit_cast(float, w << 16); }
__device__ __forceinline__ float bfhi(unsigned w) { return __builtin_bit_cast(float, w & 0xffff0000u); }
__device__ __forceinline__ float sigmoid_f(float x) { return 1.0f / (1.0f + __expf(-x)); }
__device__ __forceinline__ float silu_f(float x) { return x / (1.0f + __expf(-x)); }
__device__ __forceinline__ float logsigmoid_f(float x) { return x < 0.f ? x - log1pf(expf(x)) : -log1pf(expf(-x)); }
__device__ __forceinline__ float wave_sum(float v) {
#pragma unroll
    for (int o = 1; o < 64; o <<= 1) v += __shfl_xor(v, o);
    return v;
}
#define XB_TMO      128
#define XB_XCNT(j)  (256  + 64 * (j))
#define XB_XSUB(j)  (1280 + 64 * (j))
#define XB_XGEN(j)  (2304 + 64 * (j))
#define XB_TOP      3328
#define XB_TOPGEN   3392
#define XCD_BAR_WORDS 3456
#define XB_SPIN_CAP (1u << 18)

__device__ __forceinline__ unsigned xb_ld(unsigned* p)              { return __hip_atomic_load(p, __ATOMIC_RELAXED, __HIP_MEMORY_SCOPE_AGENT); }
__device__ __forceinline__ unsigned xb_add(unsigned* p, unsigned v) { return __hip_atomic_fetch_add(p, v, __ATOMIC_RELAXED, __HIP_MEMORY_SCOPE_AGENT); }
__device__ __forceinline__ unsigned xb_xcc_id() { return (unsigned)__builtin_amdgcn_s_getreg((3 << 11) | 20) & 0xFu; }
#define XB_SPIN(cond, bar) do { unsigned _sp = 0; while (cond) { __builtin_amdgcn_s_sleep(1); \
    if ((++_sp & 255u) == 0u) { if (xb_ld(&(bar)[XB_TMO])) break; if (_sp > XB_SPIN_CAP) { atomicAdd(&(bar)[XB_TMO], 1u); break; } } } } while (0)

struct XcdBarrier {
    unsigned* bar; unsigned x;
    volatile LAS unsigned* st;
};

__device__ __forceinline__ XcdBarrier xcd_barrier_post(unsigned* bar, volatile LAS unsigned* st) {
    XcdBarrier b; b.bar = bar; b.x = xb_xcc_id(); b.st = st;
    if (threadIdx.x == 0) (void)xb_add(&bar[XB_XCNT(b.x)], 1u);
    return b;
}
__device__ __forceinline__ void xcd_barrier_complete(unsigned* bar, unsigned x, unsigned& nloc, unsigned& nx) {
    const unsigned G = gridDim.x * gridDim.y * gridDim.z;
    unsigned sum, cnt, mine, sp = 0u;
    for (;;) {
        sum = 0u; cnt = 0u; mine = 0u;
#pragma unroll
        for (unsigned j = 0; j < 16; ++j) { const unsigned c = xb_ld(&bar[XB_XCNT(j)]); sum += c; cnt += (c > 0u) ? 1u : 0u; mine = (j == x) ? c : mine; }
        if (sum == G) break;
        __builtin_amdgcn_s_sleep(1);
        if ((++sp & 255u) == 0u) { if (xb_ld(&bar[XB_TMO])) break; if (sp > XB_SPIN_CAP) { atomicAdd(&bar[XB_TMO], 1u); break; } }
    }
    nloc = mine > 0u ? mine : 1u; nx = cnt > 0u ? cnt : 1u;
}

__device__ __forceinline__ void xcd_barrier(const XcdBarrier& b) {
    asm volatile("s_waitcnt vmcnt(0)" ::: "memory");
    __syncthreads();
    if (threadIdx.x == 0) {
        unsigned* bar = b.bar;
        __builtin_amdgcn_s_waitcnt(0);
        unsigned nloc = b.st[0], nx = b.st[1];
        if (nloc == 0u) { xcd_barrier_complete(bar, b.x, nloc, nx); b.st[0] = nloc; b.st[1] = nx; }
        const unsigned old = xb_add(&bar[XB_XSUB(b.x)], 1u);
        const unsigned gen = old / nloc;
        if (old + 1u == (gen + 1u) * nloc) {
            __builtin_amdgcn_fence(__ATOMIC_RELEASE, "agent");
            asm volatile("s_waitcnt vmcnt(0)" ::: "memory");
            const unsigned og = xb_add(&bar[XB_TOP], 1u);
            const unsigned tg = og / nx;
            if (og + 1u == (tg + 1u) * nx) xb_add(&bar[XB_TOPGEN], 1u);
            else XB_SPIN(xb_ld(&bar[XB_TOPGEN]) == tg, bar);
            __builtin_amdgcn_fence(__ATOMIC_ACQUIRE, "agent");
            xb_add(&bar[XB_XGEN(b.x)], 1u);
            asm volatile("s_waitcnt vmcnt(0)" ::: "memory");
        } else {
            XB_SPIN(xb_ld(&bar[XB_XGEN(b.x)]) == gen, bar);
            __builtin_amdgcn_fence(__ATOMIC_ACQUIRE, "agent");
            asm volatile("s_waitcnt vmcnt(0)" ::: "memory");
        }
    }
    __syncthreads();
}
__device__ __forceinline__ void transpose_item(const float* W, int Nsrc, int ns0, int k0, bf16* WT, int Kdim, int nd0, LAS float* scr, int lane) {
#pragma unroll 8
    for (int i = 0; i < 32; ++i) { const int kk = 2 * i + (lane >> 5); scr[kk * 33 + (lane & 31)] = W[(size_t)(k0 + kk) * Nsrc + ns0 + (lane & 31)]; }
    LDS_WAIT(); asm volatile("" ::: "memory");
    const int c = lane & 7;
#pragma unroll
    for (int j = 0; j < 4; ++j) { const int n = (lane >> 3) + 8 * j; const LAS float* s = scr + (8 * c) * 33 + n;
        v4u o; o.x = pk2(s[0 * 33], s[1 * 33]); o.y = pk2(s[2 * 33], s[3 * 33]); o.z = pk2(s[4 * 33], s[5 * 33]); o.w = pk2(s[6 * 33], s[7 * 33]);
        *(GAS v4u*)(WT + (size_t)(nd0 + n) * Kdim + k0 + 8 * c) = o; }
    LDS_WAIT(); asm volatile("" ::: "memory");
}
struct Ptrs {
    const float *x, *c, *w_mod, *b_mod, *w_in, *conv_w, *conv_b, *b_ig, *b_fg, *mnorm_w, *hnorm_w, *lb_logits, *w_out, *ln1_g, *ln1_b, *w_gate, *w_up, *w_down, *ln2_g, *ln2_b;
    float* out; unsigned char* ws;
};
constexpr int IT_IN = 32 * 224, IT_OUT = 32 * 64, IT_GU = 32 * 352, IT_DN = 88 * 64, IT_LAYER = IT_IN + IT_OUT + IT_GU + IT_DN, IT_ALL = DEPTH * IT_LAYER;
__device__ __forceinline__ void do_transpose(const Ptrs& P, int it, LAS float* scr, int lane) {
    const int l = it / IT_LAYER; int r = it % IT_LAYER;
    if (r < IT_IN) { const int kb = r / 224, nb = r % 224, n0 = 32 * nb;
        transpose_item(P.w_in + (size_t)l * D * DIN, DIN, n0 + (n0 >= 3072 ? 8 : 0), 64 * kb, (bf16*)(P.ws + WS_WIN) + (size_t)l * NPROJ * D, D, n0, scr, lane); return; }
    r -= IT_IN;
    if (r < IT_OUT) { const int kb = r / 64, nb = r % 64, n0 = 32 * nb;
        transpose_item(P.w_out + (size_t)l * D * D, D, n0, 64 * kb, (bf16*)(P.ws + WS_WOUT) + (size_t)l * D * D, D, n0, scr, lane); return; }
    r -= IT_OUT;
    if (r < IT_GU) { const int kb = r / 352, nb = r % 352, n0 = 32 * nb, pn = n0 >> 8, wi = n0 & 255, bj = wi >> 7, jc = wi & 127;
        transpose_item((bj ? P.w_up : P.w_gate) + (size_t)l * D * FF, FF, 128 * pn + jc, 64 * kb, (bf16*)(P.ws + WS_WGU) + (size_t)l * NGU * D, D, n0, scr, lane); return; }
    r -= IT_GU;
    { const int kb = r / 64, nb = r % 64, n0 = 32 * nb;
        transpose_item(P.w_down + (size_t)l * FF * D, D, n0, 64 * kb, (bf16*)(P.ws + WS_WDN) + (size_t)l * D * FF, FF, n0, scr, lane); }
}
__device__ __forceinline__ void phase_prologue(const Ptrs& P, LAS unsigned char* lds, int tid, int lane, int wave, int G) {
    LAS float* ca = (LAS float*)(lds + 8 * 8704);
    for (int i = tid; i < 2 * D; i += NTHR) ca[i] = silu_f(P.c[i]);
    __syncthreads();
    const int gw = wave * G + (int)blockIdx.x, NGW = G * NWAVES;
    float* MOD = (float*)(P.ws + WS_MOD);
    for (int item = gw; item < DEPTH * 192; item += NGW) {
        const int l = item / 192, j = (item % 192) * 64 + lane;
        const float* w = P.w_mod + (size_t)l * D * NMODC + j;
        float a0 = 0.f, a1 = 0.f;
        for (int k = 0; k < D; k += 16) { float wv[16];
#pragma unroll
            for (int i = 0; i < 16; ++i) wv[i] = w[(size_t)(k + i) * NMODC];
#pragma unroll
            for (int i = 0; i < 16; ++i) { a0 += ca[k + i] * wv[i]; a1 += ca[D + k + i] * wv[i]; } }
        const float bm = P.b_mod[l * NMODC + j];
        MOD[(l * 2 + 0) * NMODC + j] = a0 + bm; MOD[(l * 2 + 1) * NMODC + j] = a1 + bm;
    }
    const int gid = (int)blockIdx.x * NTHR + tid;
    if (gid < DEPTH * 8 * D) { const int l = gid >> 14, jg = (gid >> 11) & 7, k = gid & 2047; ((float*)(P.ws + WS_GW))[gid] = P.w_in[((size_t)l * D + k) * DIN + 3072 + jg]; }
    if (gid < 1024) { const float g0 = P.lb_logits[gid], g1 = P.lb_logits[1024 + gid], g2 = P.lb_logits[2048 + gid], g3 = P.lb_logits[3072 + gid];
        const float mx = fmaxf(fmaxf(g0, g1), fmaxf(g2, g3)), e0 = expf(g0 - mx), e1 = expf(g1 - mx), e2 = expf(g2 - mx), e3 = expf(g3 - mx), inv = 1.0f / (e0 + e1 + e2 + e3);
        float* LB = (float*)(P.ws + WS_LB); LB[gid] = 0.f; LB[1024 + gid] = e1 * inv; LB[2048 + gid] = (e1 + e2) * inv; LB[3072 + gid] = (e1 + e2 + e3) * inv; }
    LAS float* scr = (LAS float*)(lds + wave * 8704);
    const int nmodw = DEPTH * 192 < NGW ? DEPTH * 192 : NGW;
    const int rest = NGW - nmodw;
    int r1, r2;
    if (rest > 0) { r2 = (IT_ALL + 50 * nmodw + NGW - 1) / NGW; r1 = r2 - 50; if (r1 < 0) r1 = 0; while ((long)r1 * nmodw + (long)r2 * rest < IT_ALL) ++r2; } else { r1 = (IT_ALL + NGW - 1) / NGW; r2 = r1; }
    int lo, hi;
    if (gw < nmodw) { lo = gw * r1; hi = lo + r1; } else { lo = nmodw * r1 + (gw - nmodw) * r2; hi = lo + r2; }
    if (hi > IT_ALL) hi = IT_ALL;
    for (int it = lo; it < hi; ++it) do_transpose(P, it, scr, lane);
}
template <bool DO_LN, bool MAKE_U, bool GATES>
__device__ __forceinline__ void phase_rows(LAS unsigned char* lds, int tid, int lane, int wave, int G, const float* src, float* dst, const float* lng, const float* lnb,
                                           bf16* U, const float* sc, const float* sh, const float* gwl, const float* b_ig, const float* b_fg, float* GT) {
    LAS float* wg = (LAS float*)lds;
    if (GATES) { for (int i = tid; i < 8 * D; i += NTHR) wg[i] = gwl[i]; __syncthreads(); }
    const int gw = (int)blockIdx.x * NWAVES + wave, NGW = G * NWAVES;
    for (int m = gw; m < M; m += NGW) {
        const int b = m >> 13;
        const float* xr = src + (size_t)m * D + 4 * lane;
        f32x4 v[8];
#pragma unroll
        for (int j = 0; j < 8; ++j) v[j] = *(const f32x4*)(xr + 256 * j);
        if (DO_LN) {
            float s = 0.f;
#pragma unroll
            for (int j = 0; j < 8; ++j) s += (v[j].x + v[j].y) + (v[j].z + v[j].w);
            const float mean = wave_sum(s) * (1.f / D); float s2 = 0.f;
#pragma unroll
            for (int j = 0; j < 8; ++j) { v[j] = v[j] - mean; s2 += (v[j].x * v[j].x + v[j].y * v[j].y) + (v[j].z * v[j].z + v[j].w * v[j].w); }
            const float rstd = 1.f / sqrtf(wave_sum(s2) * (1.f / D) + LN_EPS);
#pragma unroll
            for (int j = 0; j < 8; ++j) { const f32x4 g = *(const f32x4*)(lng + 4 * lane + 256 * j), bb = *(const f32x4*)(lnb + 4 * lane + 256 * j); v[j] = v[j] * rstd * g + bb; }
        }
        if (dst) {
            float* xo = dst + (size_t)m * D + 4 * lane;
#pragma unroll
            for (int j = 0; j < 8; ++j) *(f32x4*)(xo + 256 * j) = v[j];
        }
        if (MAKE_U) {
            const float* scb = sc + (size_t)b * NMODC + 4 * lane; const float* shb = sh + (size_t)b * NMODC + 4 * lane;
            bf16* uo = U + (size_t)m * D + 4 * lane;
#pragma unroll
            for (int j = 0; j < 8; ++j) { const f32x4 a = *(const f32x4*)(scb + 256 * j), c = *(const f32x4*)(shb + 256 * j); v[j] = v[j] * (a + 1.0f) + c;
                v2u w; w.x = pk2(v[j].x, v[j].y); w.y = pk2(v[j].z, v[j].w); *(v2u*)(uo + 256 * j) = w; }
            if (GATES) {
                float mine = 0.f;
#pragma unroll 1
                for (int jg = 0; jg < 8; ++jg) { float p = 0.f;
#pragma unroll
                    for (int j = 0; j < 8; ++j) { const f32x4 w = *(const LAS f32x4*)(wg + jg * D + 4 * lane + 256 * j); p += (v[j].x * w.x + v[j].y * w.y) + (v[j].z * w.z + v[j].w * w.w); }
                    p = wave_sum(p); if (lane == jg) mine = p; }
                if (lane < 8) GT[(size_t)m * 8 + lane] = mine + (lane < 4 ? b_ig[lane] : b_fg[lane - 4]);
            }
        }
    }
}
constexpr int TS = 16;
__device__ __forceinline__ void naive_mlstm(LAS unsigned char* lds, int bh, int tid, const bf16* PROJ, const float* GT, const float* convw, const float* convb, float* HRAW, float* DEN) {
    const int b = bh >> 2, h = bh & 3;
    LAS float* qs = (LAS float*)lds; LAS float* ks = qs + TS * 128; LAS float* vs = ks + TS * 128; LAS float* gs = vs + TS * 256;
    float C[128];
#pragma unroll
    for (int d = 0; d < 128; ++d) C[d] = 0.f;
    float mrun = 0.f;
    const bool isv = tid < 256, isn = tid == 256;
    for (int t0 = 0; t0 < T; t0 += TS) {
        __syncthreads();
        for (int i = tid; i < TS * 256; i += NTHR) {
            const int tt = i >> 8, c = i & 255, ch = (c < 128) ? (h * 128 + c) : (512 + h * 128 + (c - 128)), t = t0 + tt;
            float a = convb[ch];
#pragma unroll
            for (int j = 0; j < 4; ++j) { const int ts = t - 3 + j; if (ts >= 0) a += convw[j * 1024 + ch] * bf2f(PROJ[(size_t)(b * T + ts) * NPROJ + PC_QK + ch]); }
            a = silu_f(a);
            if (c < 128) qs[tt * 128 + c] = a * QSCALE; else ks[tt * 128 + (c - 128)] = a;
        }
        for (int i = tid; i < TS * 256; i += NTHR) { const int tt = i >> 8, v = i & 255; vs[i] = bf2f(PROJ[(size_t)(b * T + t0 + tt) * NPROJ + PC_V + h * 256 + v]); }
        if (tid < TS) { const float* g = GT + (size_t)(b * T + t0 + tid) * 8; gs[tid * 2] = logsigmoid_f(g[4 + h]); gs[tid * 2 + 1] = g[h]; }
        __syncthreads();
        if (isv || isn) {
            for (int tt = 0; tt < TS; ++tt) {
                const float lf = gs[tt * 2], ig = gs[tt * 2 + 1];
                const float mnew = fmaxf(lf + mrun, ig), fdec = __expf(lf + mrun - mnew), iw = __expf(ig - mnew);
                mrun = mnew;
                const float a = iw * (isn ? 1.0f : vs[tt * 256 + (tid & 255)]);
                float n0 = 0.f, n1 = 0.f, n2 = 0.f, n3 = 0.f;
#pragma unroll
                for (int d = 0; d < 128; d += 4) {
                    const f32x4 kv = *(const LAS f32x4*)(ks + tt * 128 + d), qv = *(const LAS f32x4*)(qs + tt * 128 + d);
                    C[d] = fdec * C[d] + a * kv.x; n0 += qv.x * C[d];
                    C[d + 1] = fdec * C[d + 1] + a * kv.y; n1 += qv.y * C[d + 1];
                    C[d + 2] = fdec * C[d + 2] + a * kv.z; n2 += qv.z * C[d + 2];
                    C[d + 3] = fdec * C[d + 3] + a * kv.w; n3 += qv.w * C[d + 3];
                }
                const float num = (n0 + n1) + (n2 + n3);
                const size_t m = (size_t)(b * T + t0 + tt);
                if (isn) DEN[m * 4 + h] = fmaxf(fabsf(num), __expf(-mnew)); else HRAW[m * 2048 + h * 256 + tid] = num;
            }
        }
    }
}
__device__ __forceinline__ void naive_hgrn(LAS unsigned char* lds, int bh, int tid, const bf16* PROJ, const float* lbl, float* HRAW) {
    const int b = bh >> 3, h = bh & 7;
    LAS float* qs = (LAS float*)lds; LAS float* fs = qs + TS * 128; LAS float* ks = fs + TS * 128; LAS float* vs = ks + TS * 128;
    float S[128];
#pragma unroll
    for (int d = 0; d < 128; ++d) S[d] = 0.f;
    for (int t0 = 0; t0 < T; t0 += TS) {
        __syncthreads();
        for (int i = tid; i < TS * 128; i += NTHR) {
            const int tt = i >> 7, d = i & 127; const bf16* pr = PROJ + (size_t)(b * T + t0 + tt) * NPROJ + h * 128 + d;
            const float qr = bf2f(pr[PC_QH]), fp = bf2f(pr[PC_FH]), iv = bf2f(pr[PC_IH]), lbv = lbl[h * 128 + d];
            const float sg = 1.0f / (1.0f + __expf(-fp)), sn = 1.0f / (1.0f + __expf(fp));
            qs[i] = silu_f(qr); fs[i] = lbv + (1.0f - lbv) * sg; ks[i] = (1.0f - lbv) * sn; vs[i] = iv;
        }
        __syncthreads();
        if (tid < 128) {
            for (int tt = 0; tt < TS; ++tt) {
                const float vt = vs[tt * 128 + tid];
                float n0 = 0.f, n1 = 0.f, n2 = 0.f, n3 = 0.f;
#pragma unroll
                for (int d = 0; d < 128; d += 4) {
                    const f32x4 fv = *(const LAS f32x4*)(fs + tt * 128 + d), kv = *(const LAS f32x4*)(ks + tt * 128 + d), qv = *(const LAS f32x4*)(qs + tt * 128 + d);
                    S[d] = fv.x * S[d] + kv.x * vt; n0 += qv.x * S[d];
                    S[d + 1] = fv.y * S[d + 1] + kv.y * vt; n1 += qv.y * S[d + 1];
                    S[d + 2] = fv.z * S[d + 2] + kv.z * vt; n2 += qv.z * S[d + 2];
                    S[d + 3] = fv.w * S[d + 3] + kv.w * vt; n3 += qv.w * S[d + 3];
                }
                HRAW[(size_t)(b * T + t0 + tt) * 2048 + 1024 + h * 128 + tid] = (n0 + n1) + (n2 + n3);
            }
        }
    }
}
__device__ __forceinline__ void phase_fin(int lane, int wave, int G, const float* HRAW, const float* DEN, const bf16* PROJ, const float* mnw, const float* hnw, bf16* YMIX) {
    const int gw = (int)blockIdx.x * NWAVES + wave, NGW = G * NWAVES;
    for (int m = gw; m < M; m += NGW) {
        const float* hr = HRAW + (size_t)m * 2048; const bf16* pr = PROJ + (size_t)m * NPROJ; bf16* y = YMIX + (size_t)m * 2048;
#pragma unroll
        for (int h = 0; h < 4; ++h) {
            f32x4 v = *(const f32x4*)(hr + h * 256 + 4 * lane); const float dn = DEN[(size_t)m * 4 + h];
            v = v / dn;
            const float mean = wave_sum((v.x + v.y) + (v.z + v.w)) * (1.f / 256.f); v = v - mean;
            const float var = wave_sum((v.x * v.x + v.y * v.y) + (v.z * v.z + v.w * v.w)) * (1.f / 256.f), r = 1.f / sqrtf(var + LN_EPS);
            const f32x4 w = *(const f32x4*)(mnw + h * 256 + 4 * lane); const v2u o = *(const v2u*)(pr + PC_O + h * 256 + 4 * lane);
            const float o0 = v.x * r * w.x * sigmoid_f(bflo(o.x)), o1 = v.y * r * w.y * sigmoid_f(bfhi(o.x)), o2 = v.z * r * w.z * sigmoid_f(bflo(o.y)), o3 = v.w * r * w.w * sigmoid_f(bfhi(o.y));
            v2u q; q.x = pk2(o0, o1); q.y = pk2(o2, o3); *(v2u*)(y + h * 256 + 4 * lane) = q;
        }
#pragma unroll
        for (int h = 0; h < 8; ++h) {
            const f32x2 v = *(const f32x2*)(hr + 1024 + h * 128 + 2 * lane);
            const float ms = wave_sum(v.x * v.x + v.y * v.y) * (1.f / 128.f), r = 1.f / sqrtf(ms + LN_EPS);
            const f32x2 w = *(const f32x2*)(hnw + h * 128 + 2 * lane); const unsigned g = *(const unsigned*)(pr + PC_GH + h * 128 + 2 * lane);
            *(unsigned*)(y + 1024 + h * 128 + 2 * lane) = pk2(v.x * r * w.x * silu_f(bflo(g)), v.y * r * w.y * silu_f(bfhi(g)));
        }
    }
}
constexpr int NPH = 2 + 8 * DEPTH;
struct Args { const float* in[20]; float* out; unsigned char* ws; int ph_lo, ph_hi; };
__global__ void __launch_bounds__(NTHR, 2) fwd(Args args) {
    extern __shared__ __attribute__((aligned(16))) unsigned char lds_raw[];
    LAS unsigned char* lds = (LAS unsigned char*)lds_raw;
    const int tid0 = threadIdx.x, G = gridDim.x;
#define PHASE_IDS() int tid = threadIdx.x; asm volatile("" : "+v"(tid)); const int lane = tid & 63, wave = __builtin_amdgcn_readfirstlane(tid >> 6); (void)lane; (void)wave
    Ptrs P;
    P.x = args.in[0]; P.c = args.in[1]; P.w_mod = args.in[2]; P.b_mod = args.in[3]; P.w_in = args.in[4]; P.conv_w = args.in[5]; P.conv_b = args.in[6]; P.b_ig = args.in[7]; P.b_fg = args.in[8];
    P.mnorm_w = args.in[9]; P.hnorm_w = args.in[10]; P.lb_logits = args.in[11]; P.w_out = args.in[12]; P.ln1_g = args.in[13]; P.ln1_b = args.in[14]; P.w_gate = args.in[15]; P.w_up = args.in[16];
    P.w_down = args.in[17]; P.ln2_g = args.in[18]; P.ln2_b = args.in[19]; P.out = args.out; P.ws = args.ws;
    volatile LAS unsigned* MISC = (volatile LAS unsigned*)(lds + MISC_OFF);
    if (tid0 < 32) MISC[tid0] = 0u;
    __syncthreads();
#if MK_ONE_LAUNCH
    XcdBarrier bar = xcd_barrier_post((unsigned*)(P.ws + WS_CTL) + CW_BAR, MISC + 8);
#define SEAM() xcd_barrier(bar)
#else
#define SEAM() do { } while (0)
#endif
    const int lo = args.ph_lo, hi = args.ph_hi;
#define IN(k) (lo <= (k) && (k) < hi)
#define SEAM_AFTER(k) do { if ((k) + 1 < hi) { SEAM(); } } while (0)
    float* MOD = (float*)(P.ws + WS_MOD); float* X = (float*)(P.ws + WS_X); bf16* U = (bf16*)(P.ws + WS_U); bf16* YMIX = (bf16*)(P.ws + WS_YMIX); bf16* PROJ = (bf16*)(P.ws + WS_PROJ); bf16* HB = (bf16*)(P.ws + WS_PROJ);
    float* HRAW = (float*)(P.ws + WS_HRAW); float* GT = (float*)(P.ws + WS_GATES); float* DEN = (float*)(P.ws + WS_DEN);

#ifndef SKIP_PRO
    if (IN(0)) { PHASE_IDS(); phase_prologue(P, lds, tid, lane, wave, G); SEAM_AFTER(0); }
#endif

    for (int l = 0; l < DEPTH; ++l) {
        const int base = 1 + 8 * l;
        if (base + 8 <= lo || base >= hi) continue;
        const float* modl = MOD + (size_t)l * 2 * NMODC;
#ifndef SKIP_P0
        if (IN(base + 0)) {
            PHASE_IDS();
            const float* gwl = (const float*)(P.ws + WS_GW) + (size_t)l * 8 * D;
            if (l == 0) phase_rows<false, true, true>(lds, tid, lane, wave, G, P.x, X, nullptr, nullptr, U, modl + 1 * D, modl + 0 * D, gwl, P.b_ig + l * 4, P.b_fg + l * 4, GT);
            else        phase_rows<true, true, true>(lds, tid, lane, wave, G, X, X, P.ln2_g + (l - 1) * D, P.ln2_b + (l - 1) * D, U, modl + 1 * D, modl + 0 * D, gwl, P.b_ig + l * 4, P.b_fg + l * 4, GT);
            SEAM_AFTER(base + 0);
        }
#endif
#ifndef SKIP_P1
        if (IN(base + 1)) {
            PHASE_IDS();
            pg8::Gemm g{U, (const bf16*)(P.ws + WS_WIN) + (size_t)l * NPROJ * D, M, NPROJ, D}; pg8::StaticOrder S; S.init(M, NPROJ, G, (int)blockIdx.x);
            pg8::EpiProj E{PROJ, NPROJ};
            pg8::gemm_phase<pg8::EpiProj, pg8::StaticOrder, true, true>(lds, g, S, E);
            SEAM_AFTER(base + 1);
        }
#endif
#ifndef SKIP_P2
        if (IN(base + 2)) {
            PHASE_IDS();
            const int bx = (int)blockIdx.x;
#ifndef SKIP_NAIVE
            if (bx < 8) naive_mlstm(lds, bx, tid, PROJ, GT, P.conv_w + (size_t)l * 4 * 1024, P.conv_b + (size_t)l * 1024, HRAW, DEN);
            else if (bx < 24) naive_hgrn(lds, bx - 8, tid, PROJ, (const float*)(P.ws + WS_LB) + l * 1024, HRAW);
#endif
            SEAM_AFTER(base + 2);
        }
#endif
#ifndef SKIP_P3
        if (IN(base + 3)) {
            PHASE_IDS();
            phase_fin(lane, wave, G, HRAW, DEN, PROJ, P.mnorm_w + l * 1024, P.hnorm_w + l * 1024, YMIX);
            SEAM_AFTER(base + 3);
        }
#endif
#ifndef SKIP_P4
        if (IN(base + 4)) {
            PHASE_IDS();
            pg8::Gemm g{YMIX, (const bf16*)(P.ws + WS_WOUT) + (size_t)l * D * D, M, D, D}; pg8::StaticOrder S; S.init(M, D, G, (int)blockIdx.x);
            pg8::EpiResid E{X, D, modl + 2 * D, modl + NMODC + 2 * D, DN_ALPHA};
            pg8::gemm_phase<pg8::EpiResid, pg8::StaticOrder, true, true>(lds, g, S, E);
            SEAM_AFTER(base + 4);
        }
#endif
#ifndef SKIP_P5
        if (IN(base + 5)) {
            PHASE_IDS();
            phase_rows<true, true, false>(lds, tid, lane, wave, G, X, X, P.ln1_g + l * D, P.ln1_b + l * D, U, modl + 4 * D, modl + 3 * D, nullptr, nullptr, nullptr, nullptr);
            SEAM_AFTER(base + 5);
        }
#endif
#ifndef SKIP_P6
        if (IN(base + 6)) {
            PHASE_IDS();
            pg8::Gemm g{U, (const bf16*)(P.ws + WS_WGU) + (size_t)l * NGU * D, M, NGU, D}; pg8::StaticOrder S; S.init(M, NGU, G, (int)blockIdx.x);
            pg8::EpiSwiGLU E{HB, FF};
            pg8::gemm_phase<pg8::EpiSwiGLU, pg8::StaticOrder, true, true>(lds, g, S, E);
            SEAM_AFTER(base + 6);
        }
#endif
#ifndef SKIP_P7
        if (IN(base + 7)) {
            PHASE_IDS();
            pg8::Gemm g{HB, (const bf16*)(P.ws + WS_WDN) + (size_t)l * D * FF, M, D, FF}; pg8::StaticOrder S; S.init(M, D, G, (int)blockIdx.x);
            pg8::EpiResid E{X, D, modl + 5 * D, modl + NMODC + 5 * D, DN_ALPHA};
            pg8::gemm_phase<pg8::EpiResid, pg8::StaticOrder, true, true>(lds, g, S, E);
            SEAM_AFTER(base + 7);
        }
#endif
    }
    if (IN(NPH - 1)) { PHASE_IDS(); phase_rows<true, false, false>(lds, tid, lane, wave, G, X, P.out, P.ln2_g + (DEPTH - 1) * D, P.ln2_b + (DEPTH - 1) * D, nullptr, nullptr, nullptr, nullptr, nullptr, nullptr, nullptr); }
#undef IN
#undef SEAM_AFTER
#undef SEAM
}
extern "C" void kernel_launch(void* const* d_in, const int* in_sizes, int n_in, void* d_out, int out_size, void* d_ws, size_t ws_size, hipStream_t stream) {
    static int grid = 0;
    if (grid == 0) {
        if (n_in != 20 || out_size != M * D || ws_size < WS_END) { fprintf(stderr, "kernel_launch: unexpected problem (n_in %d, out %d, ws %zu < %zu)\n", n_in, out_size, ws_size, (size_t)WS_END); grid = -1; return; }
        int dev = 0, cus = 0;
        if (hipGetDevice(&dev) != hipSuccess || hipDeviceGetAttribute(&cus, hipDeviceAttributeMultiprocessorCount, dev) != hipSuccess) { grid = -1; return; }
        if (hipFuncSetAttribute((const void*)fwd, hipFuncAttributeMaxDynamicSharedMemorySize, LDS_BYTES) != hipSuccess) { fprintf(stderr, "kernel_launch: hipFuncSetAttribute failed\n"); grid = -1; return; }
        int per_cu = 0; (void)hipOccupancyMaxActiveBlocksPerMultiprocessor(&per_cu, (const void*)fwd, NTHR, LDS_BYTES); (void)hipGetLastError();
        if (per_cu < 1) fprintf(stderr, "kernel_launch: occupancy query reports %d workgroups per CU\n", per_cu);
        grid = cus;
    }
    if (grid < 0) return;
    (void)hipMemsetAsync((char*)d_ws + WS_CTL, 0, CTL_ZERO_BYTES, stream);
    Args a{};
    for (int i = 0; i < 20; ++i) a.in[i] = (const float*)d_in[i];
    a.out = (float*)d_out; a.ws = (unsigned char*)d_ws;
#if MK_ONE_LAUNCH
    a.ph_lo = 0; a.ph_hi = NPH;
    hipLaunchKernelGGL(fwd, dim3(grid), dim3(NTHR), LDS_BYTES, stream, a);
#else
    for (int p = 0; p < NPH; ++p) { a.ph_lo = p; a.ph_hi = p + 1; hipLaunchKernelGGL(fwd, dim3(grid), dim3(NTHR), LDS_BYTES, stream, a); }
#endif
}
```

```cpp
#include <hip/hip_runtime.h>
#include <cstdio>
#include <cstdint>
#ifndef MK_ONE_LAUNCH
#define MK_ONE_LAUNCH 1
#endif
namespace pg8 {
#define PG8_LAS __attribute__((address_space(3)))
typedef unsigned short bf16_t;
typedef short bf16x8 __attribute__((ext_vector_type(8)));
typedef float f32x4 __attribute__((ext_vector_type(4)));
typedef unsigned u32x4 __attribute__((ext_vector_type(4)));
constexpr int BM = 256, BK = 64, HALF = 128, HTB = HALF * BK * 2  , STAGE_BYTES = 8 * HTB, NXCD = 8, WGM = 8;

__host__ __device__ __forceinline__ int lds_byte(int r, int c) { const int st = (r >> 4) * 2 + (c >> 5), rr = r & 15, cc = c & 31, ob = rr * 64 + cc * 2; return st * 1024 + (ob ^ (((ob >> 9) & 1) << 5)); }
__host__ __device__ __forceinline__ void stage_rc(int b, int& R, int& C) { const int st = b / 1024, sb = b % 1024, swz = sb ^ (((sb >> 9) & 1) << 5); R = (st >> 1) * 16 + swz / 64; C = (st & 1) * 32 + (swz % 64) / 2; }
__host__ __device__ __forceinline__ int perm32(int rho) { const int n = rho >> 4, i = rho & 15; return 8 * (i >> 2) + 4 * n + (i & 3); }

struct Unit { int pm, pn; };
struct Gemm { const bf16_t* A; const bf16_t* Bt; int M, N, K; };

struct StaticOrder {
    int nM, nN, nwg, G, c;
    __host__ __device__ void init(int M, int N, int G_, int c_) { nM = M / BM; nN = N / BM; nwg = nM * nN; G = G_; c = c_; }
    __host__ __device__ bool next(int i, Unit& u) const {
        const long L = (long)i * G + c; if (L >= nwg) return false;
        int wgid = (int)L; { const int q = nwg / NXCD, r = nwg % NXCD, xcd = wgid % NXCD, off = wgid / NXCD; wgid = (xcd < r ? xcd * (q + 1) : r * (q + 1) + (xcd - r) * q) + off; }
        const int nig = WGM * nN, gid = wgid / nig, fm = gid * WGM, gsz = (nM - fm) < WGM ? (nM - fm) : WGM;
        u.pm = fm + ((wgid % nig) % gsz); u.pn = (wgid % nig) / gsz; return true;
    }
    __device__ __forceinline__ void a_ready(const Unit&) const {}
    __device__ __forceinline__ void done(const Unit&) const {}
};

__device__ __forceinline__ unsigned cvt_pk_bf16(float lo, float hi) { unsigned r; asm volatile("v_cvt_pk_bf16_f32 %0, %1, %2" : "=v"(r) : "v"(lo), "v"(hi)); return r; }
typedef float f32x2 __attribute__((ext_vector_type(2)));
__device__ __forceinline__ float fast_silu(float x) { return x * __builtin_amdgcn_rcpf(1.0f + __expf(-x)); }
struct EpiProj {
    static constexpr bool PERM = true, AFTER_DRAIN = false;
    bf16_t* O; int ldc;
    __device__ __forceinline__ void operator()(const f32x4 (&acc)[2][2][4][2], const Unit& u, int wr, int wc, int fr, int fq) const {
        const int row0 = u.pm * BM + wr * 64 + fr, col0 = u.pn * BM + wc * 32 + 8 * fq;
#pragma unroll
        for (int ai = 0; ai < 2; ++ai)
#pragma unroll
            for (int m = 0; m < 4; ++m) { bf16_t* rowp = O + (size_t)(row0 + ai * HALF + m * 16) * ldc + col0;
#pragma unroll
                for (int bj = 0; bj < 2; ++bj) { const f32x4 v0 = acc[ai][bj][m][0], v1 = acc[ai][bj][m][1];
                    u32x4 w; w.x = cvt_pk_bf16(v0[0], v0[1]); w.y = cvt_pk_bf16(v0[2], v0[3]); w.z = cvt_pk_bf16(v1[0], v1[1]); w.w = cvt_pk_bf16(v1[2], v1[3]);
                    *(u32x4*)(rowp + bj * HALF) = w; } }
    }
};
struct EpiResid {
    static constexpr bool PERM = false, AFTER_DRAIN = false;
    float* X; int ldc; const float* g0; const float* g1; float alpha;
    __device__ __forceinline__ void operator()(const f32x4 (&acc)[2][2][4][2], const Unit& u, int wr, int wc, int fr, int fq) const {
        const int row0 = u.pm * BM + wr * 64 + fr, col0 = u.pn * BM + wc * 32 + 4 * fq;
        const float* g = (u.pm >= 32) ? g1 : g0;
        f32x4 gv[2][2];
#pragma unroll
        for (int bj = 0; bj < 2; ++bj)
#pragma unroll
            for (int n = 0; n < 2; ++n) gv[bj][n] = *(const f32x4*)(g + col0 + bj * HALF + n * 16) + 1.0f;
#pragma unroll
        for (int ai = 0; ai < 2; ++ai)
#pragma unroll
            for (int m = 0; m < 4; ++m) { float* rowp = X + (size_t)(row0 + ai * HALF + m * 16) * ldc + col0;
#pragma unroll
                for (int bj = 0; bj < 2; ++bj)
#pragma unroll
                    for (int n = 0; n < 2; ++n) { const f32x4 xo = *(const f32x4*)(rowp + bj * HALF + n * 16); *(f32x4*)(rowp + bj * HALF + n * 16) = xo * alpha + gv[bj][n] * acc[ai][bj][m][n]; }
                asm volatile("" ::: "memory"); }
    }
};
struct EpiSwiGLU {
    static constexpr bool PERM = true, AFTER_DRAIN = false;
    bf16_t* O; int ldc;
    __device__ __forceinline__ void operator()(const f32x4 (&acc)[2][2][4][2], const Unit& u, int wr, int wc, int fr, int fq) const {
        const int row0 = u.pm * BM + wr * 64 + fr, col0 = u.pn * HALF + wc * 32 + 8 * fq;
#pragma unroll
        for (int ai = 0; ai < 2; ++ai)
#pragma unroll
            for (int m = 0; m < 4; ++m) { bf16_t* rowp = O + (size_t)(row0 + ai * HALF + m * 16) * ldc + col0;
                const f32x4 g0 = acc[ai][0][m][0], g1 = acc[ai][0][m][1], u0 = acc[ai][1][m][0], u1 = acc[ai][1][m][1];
                f32x4 h0, h1;
#pragma unroll
                for (int j = 0; j < 4; ++j) { h0[j] = fast_silu(g0[j]) * u0[j]; h1[j] = fast_silu(g1[j]) * u1[j]; }
                u32x4 w; w.x = cvt_pk_bf16(h0[0], h0[1]); w.y = cvt_pk_bf16(h0[2], h0[3]); w.z = cvt_pk_bf16(h1[0], h1[1]); w.w = cvt_pk_bf16(h1[2], h1[3]);
                *(u32x4*)rowp = w; }
    }
};
template <class Epi, class Sched, bool ALIGN_EPI = false, bool SP2 = false>
__device__ __forceinline__ void gemm_phase(PG8_LAS unsigned char* lds, const Gemm g, const Sched& S, const Epi& E) {
    int tid_ = threadIdx.x; asm volatile("" : "+v"(tid_));
    const int tid = tid_, wid = __builtin_amdgcn_readfirstlane(tid >> 6), lane = tid & 63, wr = wid >> 2, wc = wid & 3, fr = lane & 15, fq = lane >> 4;
    const int K = g.K, nt = K / BK;
    unsigned voffA[2], voffB[2];
#pragma unroll
    for (int i = 0; i < 2; ++i) { int R, C; stage_rc(tid * 16 + i * 8192, R, C); const int Rb = Epi::PERM ? ((R & ~31) + perm32(R & 31)) : R;
        voffA[i] = (unsigned)(R * K + C) * 2u; voffB[i] = (unsigned)(Rb * K + C) * 2u; }
    const size_t kstep = (size_t)(BK * 2);
    const size_t hstep = (size_t)HALF * K * 2;
    const size_t tstep = 2 * hstep;
    const unsigned ldsw = (unsigned)wid * 1024u;
    const int aoff = lds_byte(wr * 64 + fr, fq * 8), boff = lds_byte(wc * 32 + fr, fq * 8);
#define PG8_SA(b, h) (((b) * 2 + (h)) * HTB)
#define PG8_SB(b, h) ((4 + (b) * 2 + (h)) * HTB)
#define PG8_STAGE(bufoff, gbase, voff) do { _Pragma("unroll") for (int _i = 0; _i < 2; ++_i) \
        __builtin_amdgcn_global_load_lds((const unsigned*)((const char*)(gbase) + (voff)[_i]), (PG8_LAS unsigned*)(lds + (bufoff) + ldsw + _i * 8192), 16, 0, 0); } while (0)
#define PG8_LDA(dst, b, h) do { _Pragma("unroll") for (int m = 0; m < 4; ++m) _Pragma("unroll") for (int k = 0; k < 2; ++k) dst[m][k] = *(const PG8_LAS bf16x8*)(lds + PG8_SA(b, h) + aoff + m * 2048 + k * 1024); } while (0)
#define PG8_LDB(dst, b, h) do { _Pragma("unroll") for (int n = 0; n < 2; ++n) _Pragma("unroll") for (int k = 0; k < 2; ++k) dst[n][k] = *(const PG8_LAS bf16x8*)(lds + PG8_SB(b, h) + boff + n * 2048 + k * 1024); } while (0)
#define PG8_MMA(ai, bj, At, Bt) do { __builtin_amdgcn_s_setprio(1); _Pragma("unroll") for (int m = 0; m < 4; ++m) _Pragma("unroll") for (int n = 0; n < 2; ++n) _Pragma("unroll") for (int k = 0; k < 2; ++k) \
        acc[ai][bj][m][n] = __builtin_amdgcn_mfma_f32_16x16x32_bf16(Bt[n][k], At[m][k], acc[ai][bj][m][n], 0, 0, 0); __builtin_amdgcn_s_setprio(0); } while (0)
#define PG8_WAIT_V(n) asm volatile("s_waitcnt vmcnt(" #n ")" ::: "memory")
#define PG8_WAIT_L(n) asm volatile("s_waitcnt lgkmcnt(" #n ")" ::: "memory")
#define PG8_BAR __builtin_amdgcn_s_barrier()
#define PG8_SCHED __builtin_amdgcn_sched_barrier(0)
    Unit cur, nxt; int ui = 0;
    if (!S.next(0, cur)) return;
    f32x4 acc[2][2][4][2];
#pragma unroll
    for (int a = 0; a < 2; ++a)
#pragma unroll
        for (int b = 0; b < 2; ++b)
#pragma unroll
            for (int m = 0; m < 4; ++m)
#pragma unroll
                for (int n = 0; n < 2; ++n) acc[a][b][m][n] = (f32x4){0.f, 0.f, 0.f, 0.f};
    bf16x8 At[4][2], B0[2][2], B1[2][2];
    const char* cA = (const char*)g.A + (size_t)cur.pm * tstep; const char* cB = (const char*)g.Bt + (size_t)cur.pn * tstep;
    S.a_ready(cur);
    if constexpr (SP2) {
        PG8_STAGE(PG8_SB(0, 0), cB, voffB); PG8_STAGE(PG8_SB(0, 1), cB + hstep, voffB); PG8_STAGE(PG8_SA(0, 0), cA, voffA); PG8_STAGE(PG8_SA(0, 1), cA + hstep, voffA);
        if (wr == 1) PG8_BAR;
        PG8_WAIT_V(2); PG8_BAR;
        PG8_STAGE(PG8_SB(1, 0), cB + kstep, voffB); PG8_STAGE(PG8_SA(1, 0), cA + kstep, voffA); PG8_STAGE(PG8_SB(1, 1), cB + hstep + kstep, voffB);
        PG8_WAIT_V(6); PG8_BAR;
    } else {
        PG8_STAGE(PG8_SB(0, 0), cB, voffB); PG8_STAGE(PG8_SA(0, 0), cA, voffA); PG8_STAGE(PG8_SB(0, 1), cB + hstep, voffB); PG8_STAGE(PG8_SA(0, 1), cA + hstep, voffA);
        if (wr == 1) PG8_BAR;
        PG8_WAIT_V(4); PG8_BAR;
        PG8_STAGE(PG8_SB(1, 0), cB + kstep, voffB); PG8_STAGE(PG8_SA(1, 0), cA + kstep, voffA); PG8_STAGE(PG8_SB(1, 1), cB + hstep + kstep, voffB);
        PG8_WAIT_V(6); PG8_BAR;
    }
    for (;;) {
        const bool has_next = S.next(ui + 1, nxt);
        const char* nA = has_next ? (const char*)g.A + (size_t)nxt.pm * tstep : cA; const char* nB = has_next ? (const char*)g.Bt + (size_t)nxt.pn * tstep : cB;
        for (int t = 0; t < nt; t += 2) {
            const bool last = (t == nt - 2);
            const char* a1 = cA + (size_t)(t + 1) * kstep;
            const char* a2 = last ? nA : cA + (size_t)(t + 2) * kstep; const char* b2 = last ? nB : cB + (size_t)(t + 2) * kstep;
            const char* a3 = a2 + kstep; const char* b3 = b2 + kstep;
            if (last && has_next) S.a_ready(nxt);
            if constexpr (SP2) {
            PG8_LDB(B0, 0, 0); PG8_LDB(B1, 0, 1); PG8_SCHED; PG8_LDA(At, 0, 0); PG8_STAGE(PG8_SA(1, 1), a1 + hstep, voffA);
            PG8_WAIT_V(8); PG8_WAIT_L(0); PG8_BAR; PG8_MMA(0, 0, At, B0); PG8_MMA(0, 1, At, B1); PG8_BAR; PG8_SCHED;
            PG8_LDA(At, 0, 1); PG8_STAGE(PG8_SB(0, 0), b2, voffB); PG8_STAGE(PG8_SB(0, 1), b2 + hstep, voffB); PG8_STAGE(PG8_SA(0, 0), a2, voffA);
            PG8_WAIT_V(8); PG8_WAIT_L(0); PG8_BAR; PG8_MMA(1, 0, At, B0); PG8_MMA(1, 1, At, B1); PG8_BAR; PG8_SCHED;
            PG8_LDB(B0, 1, 0); PG8_LDB(B1, 1, 1); PG8_SCHED; PG8_LDA(At, 1, 0); PG8_STAGE(PG8_SA(0, 1), a2 + hstep, voffA);
            PG8_WAIT_V(8); PG8_WAIT_L(0); PG8_BAR; PG8_MMA(0, 0, At, B0); PG8_MMA(0, 1, At, B1); PG8_BAR; PG8_SCHED;
            PG8_LDA(At, 1, 1); PG8_STAGE(PG8_SB(1, 0), b3, voffB); PG8_STAGE(PG8_SB(1, 1), b3 + hstep, voffB); PG8_STAGE(PG8_SA(1, 0), a3, voffA);
            PG8_WAIT_V(8); PG8_WAIT_L(0); PG8_BAR; PG8_MMA(1, 0, At, B0); PG8_MMA(1, 1, At, B1); PG8_BAR; PG8_SCHED;
            } else {
            PG8_LDB(B0, 0, 0); PG8_SCHED; PG8_LDA(At, 0, 0); PG8_STAGE(PG8_SA(1, 1), a1 + hstep, voffA);
            PG8_WAIT_L(8); PG8_BAR; PG8_WAIT_L(0); PG8_MMA(0, 0, At, B0); PG8_BAR; PG8_SCHED;
            PG8_LDB(B1, 0, 1); PG8_STAGE(PG8_SB(0, 0), b2, voffB);
            PG8_BAR; PG8_WAIT_L(0); PG8_MMA(0, 1, At, B1); PG8_BAR;
            PG8_LDA(At, 0, 1); PG8_STAGE(PG8_SA(0, 0), a2, voffA);
            PG8_BAR; PG8_WAIT_L(0); PG8_MMA(1, 0, At, B0); PG8_BAR; PG8_SCHED;
            PG8_STAGE(PG8_SB(0, 1), b2 + hstep, voffB);
            PG8_WAIT_V(6); PG8_BAR; PG8_MMA(1, 1, At, B1); PG8_BAR;
            PG8_LDB(B0, 1, 0); PG8_SCHED; PG8_LDA(At, 1, 0); PG8_STAGE(PG8_SA(0, 1), a2 + hstep, voffA);
            PG8_WAIT_L(8); PG8_BAR; PG8_WAIT_L(0); PG8_MMA(0, 0, At, B0); PG8_BAR; PG8_SCHED;
            PG8_LDB(B1, 1, 1); PG8_STAGE(PG8_SB(1, 0), b3, voffB);
            PG8_BAR; PG8_WAIT_L(0); PG8_MMA(0, 1, At, B1); PG8_BAR;
            PG8_LDA(At, 1, 1); PG8_STAGE(PG8_SA(1, 0), a3, voffA);
            PG8_BAR; PG8_WAIT_L(0); PG8_MMA(1, 0, At, B0); PG8_BAR; PG8_SCHED;
            PG8_STAGE(PG8_SB(1, 1), b3 + hstep, voffB);
            PG8_WAIT_V(6); PG8_BAR; PG8_MMA(1, 1, At, B1); PG8_BAR;
            }
        }
        if constexpr (ALIGN_EPI) { if (wr == 0) PG8_BAR; }
        if constexpr (!Epi::AFTER_DRAIN) { E(acc, cur, wr, wc, fr, fq); S.done(cur); }
        if (!has_next) break;
#pragma unroll
        for (int a = 0; a < 2; ++a)
#pragma unroll
            for (int b = 0; b < 2; ++b)
#pragma unroll
                for (int m = 0; m < 4; ++m)
#pragma unroll
                    for (int n = 0; n < 2; ++n) acc[a][b][m][n] = (f32x4){0.f, 0.f, 0.f, 0.f};
        cur = nxt; cA = nA; cB = nB; ++ui;
        if constexpr (ALIGN_EPI) { if (wr == 1) PG8_BAR; }
    }
    PG8_WAIT_V(0);
    if constexpr (!ALIGN_EPI) { if (wr == 0) PG8_BAR; }
    PG8_BAR;
    if constexpr (Epi::AFTER_DRAIN) { E.fused(acc, cur, wr, wc, fr, fq, lds, wid, lane); S.done(cur); }
#undef PG8_SA
#undef PG8_SB
#undef PG8_STAGE
#undef PG8_LDA
#undef PG8_LDB
#undef PG8_MMA
#undef PG8_WAIT_V
#undef PG8_WAIT_L
#undef PG8_BAR
#undef PG8_SCHED
}
}
constexpr int NWAVES = 8, NTHR = 512;
constexpr int D = 2048, BATCH = 2, T = 8192, DEPTH = 4, M = BATCH * T;
constexpr int NPROJ = 7168, DIN = 7176, FF = 5632, NGU = 2 * FF, NMODC = 6 * D;
constexpr float LN_EPS = 1e-5f, DN_ALPHA = 1.6817928305074292f, QSCALE = 0.08838834764831845f;
constexpr int PC_QK = 0, PC_V = 1024, PC_O = 2048, PC_QH = 3072, PC_FH = 4096, PC_IH = 5120, PC_GH = 6144;
constexpr size_t MiB = 1u << 20;
constexpr size_t WS_CTL = 0, CTL_ZERO_BYTES = 1 * MiB;
constexpr size_t WS_MOD = 1 * MiB;
constexpr size_t WS_LB = WS_MOD + 512 * 1024;
constexpr size_t WS_GW = WS_LB + 64 * 1024;
constexpr size_t WS_GATES = 2 * MiB;
constexpr size_t WS_DEN = 3 * MiB;
constexpr size_t WS_WIN = 4 * MiB;
constexpr size_t WS_WOUT = WS_WIN + 112 * MiB;
constexpr size_t WS_WGU = WS_WOUT + 32 * MiB;
constexpr size_t WS_WDN = WS_WGU + 176 * MiB;
constexpr size_t WS_X = WS_WDN + 88 * MiB;
constexpr size_t WS_U = WS_X + 128 * MiB;
constexpr size_t WS_YMIX = WS_U + 64 * MiB;
constexpr size_t WS_PROJ = WS_YMIX + 64 * MiB;
constexpr size_t WS_HRAW = WS_PROJ + 224 * MiB;
constexpr size_t WS_GSM = WS_HRAW + 128 * MiB;
constexpr size_t WS_GSH = WS_GSM + 32 * MiB;
constexpr size_t WS_GSN = WS_GSH + 32 * MiB;
constexpr size_t WS_GSS = WS_GSN + 128 * 1024;
constexpr size_t WS_GHD = WS_GSS + 4 * 1024;
constexpr size_t WS_END = WS_GHD + 256 * 1024 + 124 * 1024;
constexpr int CW_BAR = 4096;
constexpr int RING_BYTES = 131072, MISC_OFF = 150528, LDS_BYTES = 151552;
#define GAS __attribute__((address_space(1)))
#define LAS __attribute__((address_space(3)))
typedef unsigned short bf16;
typedef unsigned v4u __attribute__((ext_vector_type(4)));
typedef unsigned v2u __attribute__((ext_vector_type(2)));
typedef float f32x4 __attribute__((ext_vector_type(4)));
typedef float f32x2 __attribute__((ext_vector_type(2)));
#define LDS_WAIT() asm volatile("s_waitcnt lgkmcnt(0)" ::: "memory")
#define VM_WAIT() asm volatile("s_waitcnt vmcnt(0)" ::: "memory")
__device__ __forceinline__ unsigned f2bf(float f) { unsigned u = __builtin_bit_cast(unsigned, f); return (u + 0x7fffu + ((u >> 16) & 1u)) >> 16; }
__device__ __forceinline__ unsigned pk2(float lo, float hi) { return f2bf(lo) | (f2bf(hi) << 16); }
__device__ __forceinline__ float bf2f(unsigned short b) { return __builtin_bit_cast(float, (unsigned)b << 16); }
__device__ __forceinline__ float bflo(unsigned w) { return __builtin_bit_cast(float, w << 16); }
__device__ __forceinline__ float bfhi(unsigned w) { return __builtin_bit_cast(float, w & 0xffff0000u); }
__device__ __forceinline__ float sigmoid_f(float x) { return 1.0f / (1.0f + __expf(-x)); }
__device__ __forceinline__ float silu_f(float x) { return x / (1.0f + __expf(-x)); }
__device__ __forceinline__ float logsigmoid_f(float x) { return x < 0.f ? x - log1pf(expf(x)) : -log1pf(expf(-x)); }
__device__ __forceinline__ float wave_sum(float v) {
#pragma unroll
    for (int o = 1; o < 64; o <<= 1) v += __shfl_xor(v, o);
    return v;
}
#define XB_TMO      128
#define XB_XCNT(j)  (256  + 64 * (j))
#define XB_XSUB(j)  (1280 + 64 * (j))
#define XB_XGEN(j)  (2304 + 64 * (j))
#define XB_TOP      3328
#define XB_TOPGEN   3392
#define XCD_BAR_WORDS 3456
#define XB_SPIN_CAP (1u << 18)

__device__ __forceinline__ unsigned xb_ld(unsigned* p)              { return __hip_atomic_load(p, __ATOMIC_RELAXED, __HIP_MEMORY_SCOPE_AGENT); }
__device__ __forceinline__ unsigned xb_add(unsigned* p, unsigned v) { return __hip_atomic_fetch_add(p, v, __ATOMIC_RELAXED, __HIP_MEMORY_SCOPE_AGENT); }
__device__ __forceinline__ unsigned xb_xcc_id() { return (unsigned)__builtin_amdgcn_s_getreg((3 << 11) | 20) & 0xFu; }
#define XB_SPIN(cond, bar) do { unsigned _sp = 0; while (cond) { __builtin_amdgcn_s_sleep(1); \
    if ((++_sp & 255u) == 0u) { if (xb_ld(&(bar)[XB_TMO])) break; if (_sp > XB_SPIN_CAP) { atomicAdd(&(bar)[XB_TMO], 1u); break; } } } } while (0)

struct XcdBarrier {
    unsigned* bar; unsigned x;
    volatile LAS unsigned* st;
};

__device__ __forceinline__ XcdBarrier xcd_barrier_post(unsigned* bar, volatile LAS unsigned* st) {
    XcdBarrier b; b.bar = bar; b.x = xb_xcc_id(); b.st = st;
    if (threadIdx.x == 0) (void)xb_add(&bar[XB_XCNT(b.x)], 1u);
    return b;
}
__device__ __forceinline__ void xcd_barrier_complete(unsigned* bar, unsigned x, unsigned& nloc, unsigned& nx) {
    const unsigned G = gridDim.x * gridDim.y * gridDim.z;
    unsigned sum, cnt, mine, sp = 0u;
    for (;;) {
        sum = 0u; cnt = 0u; mine = 0u;
#pragma unroll
        for (unsigned j = 0; j < 16; ++j) { const unsigned c = xb_ld(&bar[XB_XCNT(j)]); sum += c; cnt += (c > 0u) ? 1u : 0u; mine = (j == x) ? c : mine; }
        if (sum == G) break;
        __builtin_amdgcn_s_sleep(1);
        if ((++sp & 255u) == 0u) { if (xb_ld(&bar[XB_TMO])) break; if (sp > XB_SPIN_CAP) { atomicAdd(&bar[XB_TMO], 1u); break; } }
    }
    nloc = mine > 0u ? mine : 1u; nx = cnt > 0u ? cnt : 1u;
}

__device__ __forceinline__ void xcd_barrier(const XcdBarrier& b) {
    asm volatile("s_waitcnt vmcnt(0)" ::: "memory");
    __syncthreads();
    if (threadIdx.x == 0) {
        unsigned* bar = b.bar;
        __builtin_amdgcn_s_waitcnt(0);
        unsigned nloc = b.st[0], nx = b.st[1];
        if (nloc == 0u) { xcd_barrier_complete(bar, b.x, nloc, nx); b.st[0] = nloc; b.st[1] = nx; }
        const unsigned old = xb_add(&bar[XB_XSUB(b.x)], 1u);
        const unsigned gen = old / nloc;
        if (old + 1u == (gen + 1u) * nloc) {
            __builtin_amdgcn_fence(__ATOMIC_RELEASE, "agent");
            asm volatile("s_waitcnt vmcnt(0)" ::: "memory");
            const unsigned og = xb_add(&bar[XB_TOP], 1u);
            const unsigned tg = og / nx;
            if (og + 1u == (tg + 1u) * nx) xb_add(&bar[XB_TOPGEN], 1u);
            else XB_SPIN(xb_ld(&bar[XB_TOPGEN]) == tg, bar);
            __builtin_amdgcn_fence(__ATOMIC_ACQUIRE, "agent");
            xb_add(&bar[XB_XGEN(b.x)], 1u);
            asm volatile("s_waitcnt vmcnt(0)" ::: "memory");
        } else {
            XB_SPIN(xb_ld(&bar[XB_XGEN(b.x)]) == gen, bar);
            __builtin_amdgcn_fence(__ATOMIC_ACQUIRE, "agent");
            asm volatile("s_waitcnt vmcnt(0)" ::: "memory");
        }
    }
    __syncthreads();
}
__device__ __forceinline__ void transpose_item(const float* W, int Nsrc, int ns0, int k0, bf16* WT, int Kdim, int nd0, LAS float* scr, int lane) {
#pragma unroll 8
    for (int i = 0; i < 32; ++i) { const int kk = 2 * i + (lane >> 5); scr[kk * 33 + (lane & 31)] = W[(size_t)(k0 + kk) * Nsrc + ns0 + (lane & 31)]; }
    LDS_WAIT(); asm volatile("" ::: "memory");
    const int c = lane & 7;
#pragma unroll
    for (int j = 0; j < 4; ++j) { const int n = (lane >> 3) + 8 * j; const LAS float* s = scr + (8 * c) * 33 + n;
        v4u o; o.x = pk2(s[0 * 33], s[1 * 33]); o.y = pk2(s[2 * 33], s[3 * 33]); o.z = pk2(s[4 * 33], s[5 * 33]); o.w = pk2(s[6 * 33], s[7 * 33]);
        *(GAS v4u*)(WT + (size_t)(nd0 + n) * Kdim + k0 + 8 * c) = o; }
    LDS_WAIT(); asm volatile("" ::: "memory");
}
struct Ptrs {
    const float *x, *c, *w_mod, *b_mod, *w_in, *conv_w, *conv_b, *b_ig, *b_fg, *mnorm_w, *hnorm_w, *lb_logits, *w_out, *ln1_g, *ln1_b, *w_gate, *w_up, *w_down, *ln2_g, *ln2_b;
    float* out; unsigned char* ws;
};
constexpr int IT_IN = 32 * 224, IT_OUT = 32 * 64, IT_GU = 32 * 352, IT_DN = 88 * 64, IT_LAYER = IT_IN + IT_OUT + IT_GU + IT_DN, IT_ALL = DEPTH * IT_LAYER;
__device__ __forceinline__ void do_transpose(const Ptrs& P, int it, LAS float* scr, int lane) {
    const int l = it / IT_LAYER; int r = it % IT_LAYER;
    if (r < IT_IN) { const int kb = r / 224, nb = r % 224, n0 = 32 * nb;
        transpose_item(P.w_in + (size_t)l * D * DIN, DIN, n0 + (n0 >= 3072 ? 8 : 0), 64 * kb, (bf16*)(P.ws + WS_WIN) + (size_t)l * NPROJ * D, D, n0, scr, lane); return; }
    r -= IT_IN;
    if (r < IT_OUT) { const int kb = r / 64, nb = r % 64, n0 = 32 * nb;
        transpose_item(P.w_out + (size_t)l * D * D, D, n0, 64 * kb, (bf16*)(P.ws + WS_WOUT) + (size_t)l * D * D, D, n0, scr, lane); return; }
    r -= IT_OUT;
    if (r < IT_GU) { const int kb = r / 352, nb = r % 352, n0 = 32 * nb, pn = n0 >> 8, wi = n0 & 255, bj = wi >> 7, jc = wi & 127;
        transpose_item((bj ? P.w_up : P.w_gate) + (size_t)l * D * FF, FF, 128 * pn + jc, 64 * kb, (bf16*)(P.ws + WS_WGU) + (size_t)l * NGU * D, D, n0, scr, lane); return; }
    r -= IT_GU;
    { const int kb = r / 64, nb = r % 64, n0 = 32 * nb;
        transpose_item(P.w_down + (size_t)l * FF * D, D, n0, 64 * kb, (bf16*)(P.ws + WS_WDN) + (size_t)l * D * FF, FF, n0, scr, lane); }
}
__device__ __forceinline__ void phase_prologue(const Ptrs& P, LAS unsigned char* lds, int tid, int lane, int wave, int G) {
    LAS float* ca = (LAS float*)(lds + 8 * 8704);
    for (int i = tid; i < 2 * D; i += NTHR) ca[i] = silu_f(P.c[i]);
    __syncthreads();
    const int gw = wave * G + (int)blockIdx.x, NGW = G * NWAVES;
    float* MOD = (float*)(P.ws + WS_MOD);
    for (int item = gw; item < DEPTH * 192; item += NGW) {
        const int l = item / 192, j = (item % 192) * 64 + lane;
        const float* w = P.w_mod + (size_t)l * D * NMODC + j;
        float a0 = 0.f, a1 = 0.f;
        for (int k = 0; k < D; k += 16) { float wv[16];
#pragma unroll
            for (int i = 0; i < 16; ++i) wv[i] = w[(size_t)(k + i) * NMODC];
#pragma unroll
            for (int i = 0; i < 16; ++i) { a0 += ca[k + i] * wv[i]; a1 += ca[D + k + i] * wv[i]; } }
        const float bm = P.b_mod[l * NMODC + j];
        MOD[(l * 2 + 0) * NMODC + j] = a0 + bm; MOD[(l * 2 + 1) * NMODC + j] = a1 + bm;
    }
    const int gid = (int)blockIdx.x * NTHR + tid;
    if (gid < DEPTH * 8 * D) { const int l = gid >> 14, jg = (gid >> 11) & 7, k = gid & 2047; ((float*)(P.ws + WS_GW))[gid] = P.w_in[((size_t)l * D + k) * DIN + 3072 + jg]; }
    if (gid < 1024) { const float g0 = P.lb_logits[gid], g1 = P.lb_logits[1024 + gid], g2 = P.lb_logits[2048 + gid], g3 = P.lb_logits[3072 + gid];
        const float mx = fmaxf(fmaxf(g0, g1), fmaxf(g2, g3)), e0 = expf(g0 - mx), e1 = expf(g1 - mx), e2 = expf(g2 - mx), e3 = expf(g3 - mx), inv = 1.0f / (e0 + e1 + e2 + e3);
        float* LB = (float*)(P.ws + WS_LB); LB[gid] = 0.f; LB[1024 + gid] = e1 * inv; LB[2048 + gid] = (e1 + e2) * inv; LB[3072 + gid] = (e1 + e2 + e3) * inv; }
    LAS float* scr = (LAS float*)(lds + wave * 8704);
    const int nmodw = DEPTH * 192 < NGW ? DEPTH * 192 : NGW;
    const int rest = NGW - nmodw;
    int r1, r2;
    if (rest > 0) { r2 = (IT_ALL + 50 * nmodw + NGW - 1) / NGW; r1 = r2 - 50; if (r1 < 0) r1 = 0; while ((long)r1 * nmodw + (long)r2 * rest < IT_ALL) ++r2; } else { r1 = (IT_ALL + NGW - 1) / NGW; r2 = r1; }
    int lo, hi;
    if (gw < nmodw) { lo = gw * r1; hi = lo + r1; } else { lo = nmodw * r1 + (gw - nmodw) * r2; hi = lo + r2; }
    if (hi > IT_ALL) hi = IT_ALL;
    for (int it = lo; it < hi; ++it) do_transpose(P, it, scr, lane);
}
template <bool DO_LN, bool MAKE_U, bool GATES>
__device__ __forceinline__ void phase_rows(LAS unsigned char* lds, int tid, int lane, int wave, int G, const float* src, float* dst, const float* lng, const float* lnb,
                                           bf16* U, const float* sc, const float* sh, const float* gwl, const float* b_ig, const float* b_fg, float* GT) {
    LAS float* wg = (LAS float*)lds;
    if (GATES) { for (int i = tid; i < 8 * D; i += NTHR) wg[i] = gwl[i]; __syncthreads(); }
    const int gw = (int)blockIdx.x * NWAVES + wave, NGW = G * NWAVES;
    for (int m = gw; m < M; m += NGW) {
        const int b = m >> 13;
        const float* xr = src + (size_t)m * D + 4 * lane;
        f32x4 v[8];
#pragma unroll
        for (int j = 0; j < 8; ++j) v[j] = *(const f32x4*)(xr + 256 * j);
        if (DO_LN) {
            float s = 0.f;
#pragma unroll
            for (int j = 0; j < 8; ++j) s += (v[j].x + v[j].y) + (v[j].z + v[j].w);
            const float mean = wave_sum(s) * (1.f / D); float s2 = 0.f;
#pragma unroll
            for (int j = 0; j < 8; ++j) { v[j] = v[j] - mean; s2 += (v[j].x * v[j].x + v[j].y * v[j].y) + (v[j].z * v[j].z + v[j].w * v[j].w); }
            const float rstd = 1.f / sqrtf(wave_sum(s2) * (1.f / D) + LN_EPS);
#pragma unroll
            for (int j = 0; j < 8; ++j) { const f32x4 g = *(const f32x4*)(lng + 4 * lane + 256 * j), bb = *(const f32x4*)(lnb + 4 * lane + 256 * j); v[j] = v[j] * rstd * g + bb; }
        }
        if (dst) {
            float* xo = dst + (size_t)m * D + 4 * lane;
#pragma unroll
            for (int j = 0; j < 8; ++j) *(f32x4*)(xo + 256 * j) = v[j];
        }
        if (MAKE_U) {
            const float* scb = sc + (size_t)b * NMODC + 4 * lane; const float* shb = sh + (size_t)b * NMODC + 4 * lane;
            bf16* uo = U + (size_t)m * D + 4 * lane;
#pragma unroll
            for (int j = 0; j < 8; ++j) { const f32x4 a = *(const f32x4*)(scb + 256 * j), c = *(const f32x4*)(shb + 256 * j); v[j] = v[j] * (a + 1.0f) + c;
                v2u w; w.x = pk2(v[j].x, v[j].y); w.y = pk2(v[j].z, v[j].w); *(v2u*)(uo + 256 * j) = w; }
            if (GATES) {
                float mine = 0.f;
#pragma unroll 1
                for (int jg = 0; jg < 8; ++jg) { float p = 0.f;
#pragma unroll
                    for (int j = 0; j < 8; ++j) { const f32x4 w = *(const LAS f32x4*)(wg + jg * D + 4 * lane + 256 * j); p += (v[j].x * w.x + v[j].y * w.y) + (v[j].z * w.z + v[j].w * w.w); }
                    p = wave_sum(p); if (lane == jg) mine = p; }
                if (lane < 8) GT[(size_t)m * 8 + lane] = mine + (lane < 4 ? b_ig[lane] : b_fg[lane - 4]);
            }
        }
    }
}
constexpr int TS = 16;
__device__ __forceinline__ void naive_mlstm(LAS unsigned char* lds, int bh, int tid, const bf16* PROJ, const float* GT, const float* convw, const float* convb, float* HRAW, float* DEN) {
    const int b = bh >> 2, h = bh & 3;
    LAS float* qs = (LAS float*)lds; LAS float* ks = qs + TS * 128; LAS float* vs = ks + TS * 128; LAS float* gs = vs + TS * 256;
    float C[128];
#pragma unroll
    for (int d = 0; d < 128; ++d) C[d] = 0.f;
    float mrun = 0.f;
    const bool isv = tid < 256, isn = tid == 256;
    for (int t0 = 0; t0 < T; t0 += TS) {
        __syncthreads();
        for (int i = tid; i < TS * 256; i += NTHR) {
            const int tt = i >> 8, c = i & 255, ch = (c < 128) ? (h * 128 + c) : (512 + h * 128 + (c - 128)), t = t0 + tt;
            float a = convb[ch];
#pragma unroll
            for (int j = 0; j < 4; ++j) { const int ts = t - 3 + j; if (ts >= 0) a += convw[j * 1024 + ch] * bf2f(PROJ[(size_t)(b * T + ts) * NPROJ + PC_QK + ch]); }
            a = silu_f(a);
            if (c < 128) qs[tt * 128 + c] = a * QSCALE; else ks[tt * 128 + (c - 128)] = a;
        }
        for (int i = tid; i < TS * 256; i += NTHR) { const int tt = i >> 8, v = i & 255; vs[i] = bf2f(PROJ[(size_t)(b * T + t0 + tt) * NPROJ + PC_V + h * 256 + v]); }
        if (tid < TS) { const float* g = GT + (size_t)(b * T + t0 + tid) * 8; gs[tid * 2] = logsigmoid_f(g[4 + h]); gs[tid * 2 + 1] = g[h]; }
        __syncthreads();
        if (isv || isn) {
            for (int tt = 0; tt < TS; ++tt) {
                const float lf = gs[tt * 2], ig = gs[tt * 2 + 1];
                const float mnew = fmaxf(lf + mrun, ig), fdec = __expf(lf + mrun - mnew), iw = __expf(ig - mnew);
                mrun = mnew;
                const float a = iw * (isn ? 1.0f : vs[tt * 256 + (tid & 255)]);
                float n0 = 0.f, n1 = 0.f, n2 = 0.f, n3 = 0.f;
#pragma unroll
                for (int d = 0; d < 128; d += 4) {
                    const f32x4 kv = *(const LAS f32x4*)(ks + tt * 128 + d), qv = *(const LAS f32x4*)(qs + tt * 128 + d);
                    C[d] = fdec * C[d] + a * kv.x; n0 += qv.x * C[d];
                    C[d + 1] = fdec * C[d + 1] + a * kv.y; n1 += qv.y * C[d + 1];
                    C[d + 2] = fdec * C[d + 2] + a * kv.z; n2 += qv.z * C[d + 2];
                    C[d + 3] = fdec * C[d + 3] + a * kv.w; n3 += qv.w * C[d + 3];
                }
                const float num = (n0 + n1) + (n2 + n3);
                const size_t m = (size_t)(b * T + t0 + tt);
                if (isn) DEN[m * 4 + h] = fmaxf(fabsf(num), __expf(-mnew)); else HRAW[m * 2048 + h * 256 + tid] = num;
            }
        }
    }
}
__device__ __forceinline__ void naive_hgrn(LAS unsigned char* lds, int bh, int tid, const bf16* PROJ, const float* lbl, float* HRAW) {
    const int b = bh >> 3, h = bh & 7;
    LAS float* qs = (LAS float*)lds; LAS float* fs = qs + TS * 128; LAS float* ks = fs + TS * 128; LAS float* vs = ks + TS * 128;
    float S[128];
#pragma unroll
    for (int d = 0; d < 128; ++d) S[d] = 0.f;
    for (int t0 = 0; t0 < T; t0 += TS) {
        __syncthreads();
        for (int i = tid; i < TS * 128; i += NTHR) {
            const int tt = i >> 7, d = i & 127; const bf16* pr = PROJ + (size_t)(b * T + t0 + tt) * NPROJ + h * 128 + d;
            const float qr = bf2f(pr[PC_QH]), fp = bf2f(pr[PC_FH]), iv = bf2f(pr[PC_IH]), lbv = lbl[h * 128 + d];
            const float sg = 1.0f / (1.0f + __expf(-fp)), sn = 1.0f / (1.0f + __expf(fp));
            qs[i] = silu_f(qr); fs[i] = lbv + (1.0f - lbv) * sg; ks[i] = (1.0f - lbv) * sn; vs[i] = iv;
        }
        __syncthreads();
        if (tid < 128) {
            for (int tt = 0; tt < TS; ++tt) {
                const float vt = vs[tt * 128 + tid];
                float n0 = 0.f, n1 = 0.f, n2 = 0.f, n3 = 0.f;
#pragma unroll
                for (int d = 0; d < 128; d += 4) {
                    const f32x4 fv = *(const LAS f32x4*)(fs + tt * 128 + d), kv = *(const LAS f32x4*)(ks + tt * 128 + d), qv = *(const LAS f32x4*)(qs + tt * 128 + d);
                    S[d] = fv.x * S[d] + kv.x * vt; n0 += qv.x * S[d];
                    S[d + 1] = fv.y * S[d + 1] + kv.y * vt; n1 += qv.y * S[d + 1];
                    S[d + 2] = fv.z * S[d + 2] + kv.z * vt; n2 += qv.z * S[d + 2];
                    S[d + 3] = fv.w * S[d + 3] + kv.w * vt; n3 += qv.w * S[d + 3];
                }
                HRAW[(size_t)(b * T + t0 + tt) * 2048 + 1024 + h * 128 + tid] = (n0 + n1) + (n2 + n3);
            }
        }
    }
}
__device__ __forceinline__ void phase_fin(int lane, int wave, int G, const float* HRAW, const float* DEN, const bf16* PROJ, const float* mnw, const float* hnw, bf16* YMIX) {
    const int gw = (int)blockIdx.x * NWAVES + wave, NGW = G * NWAVES;
    for (int m = gw; m < M; m += NGW) {
        const float* hr = HRAW + (size_t)m * 2048; const bf16* pr = PROJ + (size_t)m * NPROJ; bf16* y = YMIX + (size_t)m * 2048;
#pragma unroll
        for (int h = 0; h < 4; ++h) {
            f32x4 v = *(const f32x4*)(hr + h * 256 + 4 * lane); const float dn = DEN[(size_t)m * 4 + h];
            v = v / dn;
            const float mean = wave_sum((v.x + v.y) + (v.z + v.w)) * (1.f / 256.f); v = v - mean;
            const float var = wave_sum((v.x * v.x + v.y * v.y) + (v.z * v.z + v.w * v.w)) * (1.f / 256.f), r = 1.f / sqrtf(var + LN_EPS);
            const f32x4 w = *(const f32x4*)(mnw + h * 256 + 4 * lane); const v2u o = *(const v2u*)(pr + PC_O + h * 256 + 4 * lane);
            const float o0 = v.x * r * w.x * sigmoid_f(bflo(o.x)), o1 = v.y * r * w.y * sigmoid_f(bfhi(o.x)), o2 = v.z * r * w.z * sigmoid_f(bflo(o.y)), o3 = v.w * r * w.w * sigmoid_f(bfhi(o.y));
            v2u q; q.x = pk2(o0, o1); q.y = pk2(o2, o3); *(v2u*)(y + h * 256 + 4 * lane) = q;
        }
#pragma unroll
        for (int h = 0; h < 8; ++h) {
            const f32x2 v = *(const f32x2*)(hr + 1024 + h * 128 + 2 * lane);
            const float ms = wave_sum(v.x * v.x + v.y * v.y) * (1.f / 128.f), r = 1.f / sqrtf(ms + LN_EPS);
            const f32x2 w = *(const f32x2*)(hnw + h * 128 + 2 * lane); const unsigned g = *(const unsigned*)(pr + PC_GH + h * 128 + 2 * lane);
            *(unsigned*)(y + 1024 + h * 128 + 2 * lane) = pk2(v.x * r * w.x * silu_f(bflo(g)), v.y * r * w.y * silu_f(bfhi(g)));
        }
    }
}
#define MIXDEV __device__ __forceinline__
#define MIX_SYNC() __syncthreads()
#define MFMA16(a, b, c) __builtin_amdgcn_mfma_f32_16x16x32_bf16((a), (b), (c), 0, 0, 0)
#define mix_shfl_up(v, o) __shfl_up((v), (o))
#define mix_shfl_xor(v, o) __shfl_xor((v), (o))
#define mix_shfl(v, l) __shfl((v), (l))
#define mix_cvt_pk(lo, hi) pg8::cvt_pk_bf16((lo), (hi))
#define MIX_CFENCE() asm volatile("" ::: "memory")
#define MIX_LAUNDER(x) asm volatile("" : "+v"(x))
constexpr int GC = 4, NGRP = T / (64 * GC);
constexpr int RS128 = 288, RS64 = 160;
constexpr float NEG_BIG = -1.0e30f;
typedef short bf16x8 __attribute__((ext_vector_type(8)));
struct MixBuf { float* GSM; float* GSN; float* GSS; float* GSH; float* GHD; };
MIXDEV int dpos(int d) { return (d & ~31) | ((d & 12) << 1) | ((d & 16) >> 2) | (d & 3); }
MIXDEV bf16x8 ldfrag(const LAS unsigned char* p) { return *(const LAS bf16x8*)p; }
MIXDEV bf16x8 pack_pair(const f32x4& x, const f32x4& y) { v4u p; p.x = mix_cvt_pk(x[0], x[1]); p.y = mix_cvt_pk(x[2], x[3]); p.z = mix_cvt_pk(y[0], y[1]); p.w = mix_cvt_pk(y[2], y[3]); return __builtin_bit_cast(bf16x8, p); }
MIXDEV void st_bf16(LAS unsigned char* p, float v) { *(LAS unsigned short*)p = (unsigned short)f2bf(v); }
MIXDEV float ld_bf16(const LAS unsigned char* p) { return bf2f(*(const LAS unsigned short*)p); }

constexpr int ML_Q = 0, ML_K = 18432, ML_KT = 36864, ML_VT = 57344, ML_SS = 98304, ML_TAB = 108544;
constexpr int MT_BCUM = 0, MT_GSV = 64, MT_MROW = 128, MT_WINT = 192, MT_WEND = 256, MT_RDEN = 320, MT_NP = 384, MT_SCAL = 512, MT_CW = 528, MT_HNP = 1808, MT_END = 2832;
template <int PASS>
MIXDEV void mlstm_unit(LAS unsigned char* lds, int tid, int lane, int w, int unit, const bf16* PROJ, const float* GT, const float* convw, const float* convb, const float* mnw, MixBuf MB, bf16* YMIX) {
    const int b = unit / (4 * NGRP), h = (unit / NGRP) & 3, grp = unit % NGRP;
    const int c = lane & 15, g = lane >> 4;
    LAS unsigned char* Qs = lds + ML_Q; LAS unsigned char* Ks = lds + ML_K; LAS unsigned char* Kwt = lds + ML_KT; LAS unsigned char* Vt = lds + ML_VT; LAS unsigned char* Ss = lds + ML_SS;
    LAS float* tab = (LAS float*)(lds + ML_TAB);
    f32x4 Cst[2][8];
    float m_run, btot = 0.f;
    MIX_SYNC();
    for (int i = tid; i < 5 * 256; i += NTHR) { const int j = i >> 8, cc = i & 255, ch = (cc < 128) ? (h * 128 + cc) : (512 + h * 128 + (cc - 128)); tab[MT_CW + i] = (j < 4) ? convw[j * 1024 + ch] : convb[ch]; }
    if (PASS == 0) {
#pragma unroll
        for (int vt = 0; vt < 2; ++vt)
#pragma unroll
            for (int dt = 0; dt < 8; ++dt) Cst[vt][dt] = (f32x4){0.f, 0.f, 0.f, 0.f};
        if (tid < 128) tab[MT_NP + tid] = 0.f;
        m_run = NEG_BIG;
    } else {
        const float* gs = MB.GSM + (size_t)unit * 32768;
#pragma unroll
        for (int vt = 0; vt < 2; ++vt)
#pragma unroll
            for (int dt = 0; dt < 8; ++dt) Cst[vt][dt] = *(const f32x4*)(gs + (size_t)(32 * w + 16 * vt + c) * 128 + 16 * dt + 4 * g);
        if (tid < 128) tab[MT_NP + dpos(tid)] = MB.GSN[(size_t)unit * 128 + tid];
        m_run = MB.GSS[unit * 4 + 2];
    }
    for (int j = 0; j < GC; ++j) {
        const int n = grp * GC + j; const size_t m0 = (size_t)b * T + 64 * n;
        MIX_SYNC();
        if (w == 0) {
            const float lf = logsigmoid_f(GT[(m0 + lane) * 8 + 4 + h]), ig = GT[(m0 + lane) * 8 + h];
            float bc = lf;
#pragma unroll
            for (int o = 1; o < 64; o <<= 1) { const float y = mix_shfl_up(bc, o); if (lane >= o) bc += y; }
            const float gsx = ig - bc; float pm = gsx;
#pragma unroll
            for (int o = 1; o < 64; o <<= 1) { const float y = mix_shfl_up(pm, o); if (lane >= o) pm = fmaxf(pm, y); }
            const float mr = fmaxf(m_run, pm);
            tab[MT_BCUM + lane] = bc; tab[MT_GSV + lane] = gsx; tab[MT_MROW + lane] = mr; tab[MT_WINT + lane] = __expf(m_run - mr);
            const float mr63 = mix_shfl(mr, 63), bc63 = mix_shfl(bc, 63);
            tab[MT_WEND + lane] = __expf(gsx - mr63);
            if (lane == 0) { tab[MT_SCAL + 0] = __expf(m_run - mr63); tab[MT_SCAL + 1] = bc63 + mr63; tab[MT_SCAL + 2] = bc63; }
        }
        MIX_SYNC();
        const float decay = tab[MT_SCAL + 0], m_new = tab[MT_SCAL + 1]; btot += tab[MT_SCAL + 2];
        int tid_s = tid; MIX_LAUNDER(tid_s);
        {
            constexpr int NIT = (PASS == 1) ? 4 : 2;
#pragma unroll 1
            for (int it = 0; it < NIT; ++it) {
                const int item = tid_s + NTHR * it;
                int s, c8; if (PASS == 1) { s = item >> 5; c8 = item & 31; } else { s = item >> 4; c8 = 16 + (item & 15); }
                const bool isk = c8 >= 16; const int cc0 = 8 * c8, ch0 = isk ? (512 + h * 128 + 8 * (c8 - 16)) : (h * 128 + 8 * c8);
                float a[8];
#pragma unroll
                for (int i = 0; i < 8; ++i) a[i] = tab[MT_CW + 4 * 256 + cc0 + i];
#pragma unroll
                for (int jt = 0; jt < 4; ++jt) { const int tg = 64 * n + s - 3 + jt;
                    if (tg >= 0) { const v4u raw = *(const v4u*)(PROJ + ((size_t)b * T + tg) * NPROJ + PC_QK + ch0);
                        const float x[8] = {bflo(raw.x), bfhi(raw.x), bflo(raw.y), bfhi(raw.y), bflo(raw.z), bfhi(raw.z), bflo(raw.w), bfhi(raw.w)};
#pragma unroll
                        for (int i = 0; i < 8; ++i) a[i] += tab[MT_CW + jt * 256 + cc0 + i] * x[i]; } }
#pragma unroll
                for (int i = 0; i < 8; ++i) a[i] = silu_f(a[i]);
                const int d0 = cc0 & 127;
                if (!isk) {
                    if (PASS == 1) { v2u lo, hi; lo.x = pk2(a[0] * QSCALE, a[1] * QSCALE); lo.y = pk2(a[2] * QSCALE, a[3] * QSCALE); hi.x = pk2(a[4] * QSCALE, a[5] * QSCALE); hi.y = pk2(a[6] * QSCALE, a[7] * QSCALE);
                        *(LAS v2u*)(Qs + s * RS128 + 2 * dpos(d0)) = lo; *(LAS v2u*)(Qs + s * RS128 + 2 * dpos(d0 + 4)) = hi; }
                } else {
                    if (PASS == 1) { v2u lo, hi; lo.x = pk2(a[0], a[1]); lo.y = pk2(a[2], a[3]); hi.x = pk2(a[4], a[5]); hi.y = pk2(a[6], a[7]);
                        *(LAS v2u*)(Ks + s * RS128 + 2 * dpos(d0)) = lo; *(LAS v2u*)(Ks + s * RS128 + 2 * dpos(d0 + 4)) = hi; }
                    const float we = tab[MT_WEND + s];
#pragma unroll
                    for (int i = 0; i < 8; ++i) st_bf16(Kwt + (d0 + i) * RS64 + 2 * s, a[i] * we);
                }
            }
        }
#pragma unroll 1
        for (int it = 0; it < 4; ++it) { const int item = tid_s + NTHR * it, s = item >> 5, c8 = item & 31;
            const v4u raw = *(const v4u*)(PROJ + (m0 + s) * NPROJ + PC_V + h * 256 + 8 * c8);
            const unsigned wv[4] = {raw.x, raw.y, raw.z, raw.w};
#pragma unroll
            for (int i = 0; i < 4; ++i) { *(LAS unsigned short*)(Vt + (8 * c8 + 2 * i) * RS64 + 2 * s) = (unsigned short)(wv[i] & 0xffffu); *(LAS unsigned short*)(Vt + (8 * c8 + 2 * i + 1) * RS64 + 2 * s) = (unsigned short)(wv[i] >> 16); } }
        MIX_SYNC();
        bf16x8 Av[2][2];
#pragma unroll
        for (int vt = 0; vt < 2; ++vt)
#pragma unroll
            for (int ks = 0; ks < 2; ++ks) Av[vt][ks] = ldfrag(Vt + (32 * w + 16 * vt + c) * RS64 + (32 * ks + 8 * g) * 2);
        if (PASS == 1) {
            {
                const int ti = w >> 1;
#pragma unroll
                for (int q2 = 0; q2 < 2; ++q2) { const int sj = 2 * (w & 1) + q2; f32x4 acc = (f32x4){0.f, 0.f, 0.f, 0.f};
                    if (sj <= ti) {
#pragma unroll
                        for (int ks = 0; ks < 4; ++ks) acc = MFMA16(ldfrag(Qs + (16 * ti + c) * RS128 + (32 * ks + 8 * g) * 2), ldfrag(Ks + (16 * sj + c) * RS128 + (32 * ks + 8 * g) * 2), acc);
                    }
                    const int s = 16 * sj + c; const float gsx = tab[MT_GSV + s];
#pragma unroll
                    for (int r = 0; r < 4; ++r) { const int t = 16 * ti + 4 * g + r; const float v = (s <= t) ? acc[r] * __expf(gsx - tab[MT_MROW + t]) : 0.f; st_bf16(Ss + t * RS64 + 2 * s, v); } }
            }
            MIX_SYNC();
            {
                const int t = tid >> 3, part = tid & 7; float p1 = 0.f, p2 = 0.f;
#pragma unroll
                for (int i = 0; i < 8; ++i) p1 += ld_bf16(Ss + t * RS64 + 2 * (8 * part + i));
#pragma unroll
                for (int i = 0; i < 16; ++i) p2 += ld_bf16(Qs + t * RS128 + 2 * (16 * part + i)) * tab[MT_NP + 16 * part + i];
                float den = p1 + tab[MT_WINT + t] * p2;
                den += mix_shfl_xor(den, 1); den += mix_shfl_xor(den, 2); den += mix_shfl_xor(den, 4);
                if (part == 0) tab[MT_RDEN + t] = 1.0f / fmaxf(fabsf(den), __expf(-(tab[MT_BCUM + t] + tab[MT_MROW + t])));
            }
            f32x4 acc1[2][4], acc2[2][4];
#pragma unroll
            for (int vt = 0; vt < 2; ++vt)
#pragma unroll
                for (int tt = 0; tt < 4; ++tt) { acc1[vt][tt] = (f32x4){0.f, 0.f, 0.f, 0.f}; acc2[vt][tt] = (f32x4){0.f, 0.f, 0.f, 0.f}; }
#pragma unroll
            for (int tt = 0; tt < 4; ++tt)
#pragma unroll
                for (int ks = 0; ks < 2; ++ks) { if (ks == 1 && tt < 2) continue;
                    const bf16x8 Bs = ldfrag(Ss + (16 * tt + c) * RS64 + (32 * ks + 8 * g) * 2);
                    acc1[0][tt] = MFMA16(Av[0][ks], Bs, acc1[0][tt]); acc1[1][tt] = MFMA16(Av[1][ks], Bs, acc1[1][tt]); MIX_CFENCE(); }
#pragma unroll
            for (int ks = 0; ks < 4; ++ks) { const bf16x8 A0 = pack_pair(Cst[0][2 * ks], Cst[0][2 * ks + 1]), A1 = pack_pair(Cst[1][2 * ks], Cst[1][2 * ks + 1]);
#pragma unroll
                for (int tt = 0; tt < 4; ++tt) { const bf16x8 Bq = ldfrag(Qs + (16 * tt + c) * RS128 + (32 * ks + 8 * g) * 2);
                    acc2[0][tt] = MFMA16(A0, Bq, acc2[0][tt]); acc2[1][tt] = MFMA16(A1, Bq, acc2[1][tt]); } MIX_CFENCE(); }
            MIX_SYNC();
            float s1[4], s2[4];
            int ce = c, ge = g; MIX_LAUNDER(ce); MIX_LAUNDER(ge);
#pragma unroll
            for (int tt = 0; tt < 4; ++tt) { const int t = 16 * tt + ce; const float wi = tab[MT_WINT + t], rd = tab[MT_RDEN + t]; s1[tt] = 0.f; s2[tt] = 0.f;
#pragma unroll
                for (int vt = 0; vt < 2; ++vt) { acc1[vt][tt] = (acc1[vt][tt] + acc2[vt][tt] * wi) * rd;
#pragma unroll
                    for (int r = 0; r < 4; ++r) { const float x = acc1[vt][tt][r]; s1[tt] += x; s2[tt] += x * x; } }
                s1[tt] += mix_shfl_xor(s1[tt], 16); s1[tt] += mix_shfl_xor(s1[tt], 32); s2[tt] += mix_shfl_xor(s2[tt], 16); s2[tt] += mix_shfl_xor(s2[tt], 32);
                if (ge == 0) { tab[MT_HNP + (w * 64 + t) * 2] = s1[tt]; tab[MT_HNP + (w * 64 + t) * 2 + 1] = s2[tt]; } }
            MIX_SYNC();
#pragma unroll
            for (int tt = 0; tt < 4; ++tt) { const int t = 16 * tt + ce; float a1 = 0.f, a2 = 0.f;
#pragma unroll
                for (int ww = 0; ww < 8; ++ww) { a1 += tab[MT_HNP + (ww * 64 + t) * 2]; a2 += tab[MT_HNP + (ww * 64 + t) * 2 + 1]; }
                const float mean = a1 * (1.f / 256.f), var = fmaxf(a2 * (1.f / 256.f) - mean * mean, 0.f), rstd = 1.f / sqrtf(var + LN_EPS);
#pragma unroll
                for (int vt = 0; vt < 2; ++vt) { const int v0 = 32 * w + 16 * vt + 4 * ge;
                    const v2u og = *(const v2u*)(PROJ + (m0 + t) * NPROJ + PC_O + h * 256 + v0); const f32x4 wn = *(const f32x4*)(mnw + h * 256 + v0);
                    const f32x4 x = acc1[vt][tt];
                    v2u o; o.x = pk2((x[0] - mean) * rstd * wn[0] * sigmoid_f(bflo(og.x)), (x[1] - mean) * rstd * wn[1] * sigmoid_f(bfhi(og.x)));
                    o.y = pk2((x[2] - mean) * rstd * wn[2] * sigmoid_f(bflo(og.y)), (x[3] - mean) * rstd * wn[3] * sigmoid_f(bfhi(og.y)));
                    *(v2u*)(YMIX + (m0 + t) * 2048 + h * 256 + v0) = o; } MIX_CFENCE(); }
        }
#pragma unroll
        for (int dt = 0; dt < 8; ++dt) {
            const bf16x8 K0 = ldfrag(Kwt + (16 * dt + c) * RS64 + (8 * g) * 2), K1 = ldfrag(Kwt + (16 * dt + c) * RS64 + (32 + 8 * g) * 2);
#pragma unroll
            for (int vt = 0; vt < 2; ++vt) { f32x4 a = Cst[vt][dt] * decay; a = MFMA16(K0, Av[vt][0], a); a = MFMA16(K1, Av[vt][1], a); Cst[vt][dt] = a; }
        }
        if (tid < 128) { float sum = 0.f;
#pragma unroll
            for (int i = 0; i < 64; ++i) sum += ld_bf16(Kwt + tid * RS64 + 2 * i);
            tab[MT_NP + dpos(tid)] = decay * tab[MT_NP + dpos(tid)] + sum; }
        m_run = m_new;
    }
    if (PASS == 0) {
        MIX_SYNC();
        float* gs = MB.GSM + (size_t)unit * 32768;
#pragma unroll
        for (int vt = 0; vt < 2; ++vt)
#pragma unroll
            for (int dt = 0; dt < 8; ++dt) *(f32x4*)(gs + (size_t)(32 * w + 16 * vt + c) * 128 + 16 * dt + 4 * g) = Cst[vt][dt];
        if (tid < 128) MB.GSN[(size_t)unit * 128 + tid] = tab[MT_NP + dpos(tid)];
        if (tid == 0) { MB.GSS[unit * 4 + 0] = m_run; MB.GSS[unit * 4 + 1] = btot; }
    }
}

constexpr int HG_QT = 0, HG_QH = 18432, HG_KTI = 36864, HG_KE = 82944, HG_VT = 103424, HG_AS = 123904, HG_TAB = 134144;
constexpr int HT_TOT = 0, HT_DEC = 512, HT_BTOT = 640, HT_HNP = 768, HT_END = 1280;
constexpr int HG_LDS_END = HG_TAB + HT_END * 4;
template <int PASS>
MIXDEV void hgrn_unit(LAS unsigned char* lds, int tid, int lane, int w, int unit, const bf16* PROJ, const float* lbl, const float* hnw, MixBuf MB, bf16* YMIX) {
    const int b = unit / (8 * NGRP), h = (unit / NGRP) & 7, grp = unit % NGRP;
    const int c = lane & 15, g = lane >> 4;
    LAS unsigned char* Qt = lds + HG_QT; LAS unsigned char* Qh = lds + HG_QH; LAS unsigned char* Kti = lds + HG_KTI; LAS unsigned char* Ke = lds + HG_KE; LAS unsigned char* Vt = lds + HG_VT; LAS unsigned char* As = lds + HG_AS;
    LAS float* tab = (LAS float*)(lds + HG_TAB);
    f32x4 Sst[8];
    const int tq = tid >> 7, d = tid & 127;
    const float lbv = lbl[h * 128 + d];
    MIX_SYNC();
    if (PASS == 0) {
#pragma unroll
        for (int dt = 0; dt < 8; ++dt) Sst[dt] = (f32x4){0.f, 0.f, 0.f, 0.f};
        if (tid < 128) tab[HT_BTOT + tid] = 0.f;
    } else {
        const float* gs = MB.GSH + (size_t)unit * 16384;
#pragma unroll
        for (int dt = 0; dt < 8; ++dt) Sst[dt] = *(const f32x4*)(gs + (size_t)(16 * w + c) * 128 + 16 * dt + 4 * g);
        for (int i = tid; i < 2 * 16 * 16; i += NTHR) { const int which = i >> 8, r = (i >> 4) & 15, cc = i & 15; *(LAS unsigned short*)(As + (32 * which + r) * RS64 + 2 * (32 * which + 16 + cc)) = 0; }
    }
    for (int j = 0; j < GC; ++j) {
        const int n = grp * GC + j; const size_t m0 = (size_t)b * T + 64 * n;
        MIX_SYNC();
        float loc[16], kk[16], qq[16];
        {
            float run = 0.f;
#pragma unroll
            for (int i = 0; i < 16; ++i) { const bf16* pr = PROJ + (m0 + 16 * tq + i) * NPROJ + h * 128 + d;
                const float fp = bf2f(pr[PC_FH]);
                const float sg = 1.0f / (1.0f + __expf(-fp)), sn = 1.0f / (1.0f + __expf(fp));
                const float f = lbv + (1.0f - lbv) * sg;
                run += logf(f); loc[i] = run; kk[i] = (1.0f - lbv) * sn;
                if (PASS == 1) qq[i] = silu_f(bf2f(pr[PC_QH])); else qq[i] = 0.f; }
            tab[HT_TOT + tq * 128 + d] = run;
        }
        int tid_s = tid; MIX_LAUNDER(tid_s);
#pragma unroll 1
        for (int it = 0; it < 2; ++it) { const int item = tid_s + NTHR * it, s = item >> 4, c8 = item & 15;
            const v4u raw = *(const v4u*)(PROJ + (m0 + s) * NPROJ + PC_IH + h * 128 + 8 * c8);
            const unsigned wv[4] = {raw.x, raw.y, raw.z, raw.w};
#pragma unroll
            for (int i = 0; i < 4; ++i) { *(LAS unsigned short*)(Vt + (8 * c8 + 2 * i) * RS64 + 2 * s) = (unsigned short)(wv[i] & 0xffffu); *(LAS unsigned short*)(Vt + (8 * c8 + 2 * i + 1) * RS64 + 2 * s) = (unsigned short)(wv[i] >> 16); } }
        MIX_SYNC();
        {
            float R[5]; R[0] = 0.f;
#pragma unroll
            for (int q = 0; q < 4; ++q) R[q + 1] = R[q] + tab[HT_TOT + q * 128 + d];
            float Rq = 0.f;
#pragma unroll
            for (int q = 0; q < 4; ++q) if (q == tq) Rq = R[q];
            const int pd = dpos(d);
            if (tq == 0) { tab[HT_DEC + d] = __expf(R[4]); if (PASS == 0) tab[HT_BTOT + d] += R[4]; }
#pragma unroll
            for (int i = 0; i < 16; ++i) { const int s = 16 * tq + i;
                if (PASS == 1) { st_bf16(Qt + s * RS128 + 2 * pd, qq[i] * __expf(loc[i])); st_bf16(Qh + s * RS128 + 2 * pd, qq[i] * __expf(Rq + loc[i]));
#pragma unroll
                    for (int ti = 0; ti < 4; ++ti) if (ti >= tq) { const float e = fminf((R[ti] - Rq) - loc[i], 80.f); st_bf16(Kti + ((ti * (ti + 1) / 2 + tq) * 16 + i) * RS128 + 2 * pd, kk[i] * __expf(e)); } }
                st_bf16(Ke + d * RS64 + 2 * s, kk[i] * __expf((R[4] - Rq) - loc[i])); }
        }
        MIX_SYNC();
        bf16x8 Av[2];
#pragma unroll
        for (int ks = 0; ks < 2; ++ks) Av[ks] = ldfrag(Vt + (16 * w + c) * RS64 + (32 * ks + 8 * g) * 2);
        if (PASS == 1) {
#pragma unroll 1
            for (int tile = w; tile < 10; tile += 8) {
                const int ti = (tile >= 6) ? 3 : (tile >= 3) ? 2 : (tile >= 1) ? 1 : 0, si = tile - ti * (ti + 1) / 2;
                f32x4 acc = (f32x4){0.f, 0.f, 0.f, 0.f};
#pragma unroll
                for (int ks = 0; ks < 4; ++ks) acc = MFMA16(ldfrag(Qt + (16 * ti + c) * RS128 + (32 * ks + 8 * g) * 2), ldfrag(Kti + (tile * 16 + c) * RS128 + (32 * ks + 8 * g) * 2), acc);
#pragma unroll
                for (int r = 0; r < 4; ++r) { const float v = (ti != si || c <= 4 * g + r) ? acc[r] : 0.f; st_bf16(As + (16 * ti + 4 * g + r) * RS64 + 2 * (16 * si + c), v); }
            }
            MIX_SYNC();
            f32x4 acc[4];
#pragma unroll
            for (int tt = 0; tt < 4; ++tt) acc[tt] = (f32x4){0.f, 0.f, 0.f, 0.f};
#pragma unroll
            for (int tt = 0; tt < 4; ++tt)
#pragma unroll
                for (int ks = 0; ks < 2; ++ks) { if (ks == 1 && tt < 2) continue;
                    acc[tt] = MFMA16(Av[ks], ldfrag(As + (16 * tt + c) * RS64 + (32 * ks + 8 * g) * 2), acc[tt]); }
#pragma unroll
            for (int ks = 0; ks < 4; ++ks) { const bf16x8 A0 = pack_pair(Sst[2 * ks], Sst[2 * ks + 1]);
#pragma unroll
                for (int tt = 0; tt < 4; ++tt) acc[tt] = MFMA16(A0, ldfrag(Qh + (16 * tt + c) * RS128 + (32 * ks + 8 * g) * 2), acc[tt]); }
            int ce = c, ge = g; MIX_LAUNDER(ce); MIX_LAUNDER(ge);
#pragma unroll
            for (int tt = 0; tt < 4; ++tt) { const int t = 16 * tt + ce; float s2 = 0.f;
#pragma unroll
                for (int r = 0; r < 4; ++r) s2 += acc[tt][r] * acc[tt][r];
                s2 += mix_shfl_xor(s2, 16); s2 += mix_shfl_xor(s2, 32);
                if (ge == 0) tab[HT_HNP + w * 64 + t] = s2; }
            MIX_SYNC();
#pragma unroll
            for (int tt = 0; tt < 4; ++tt) { const int t = 16 * tt + ce; float a2 = 0.f;
#pragma unroll
                for (int ww = 0; ww < 8; ++ww) a2 += tab[HT_HNP + ww * 64 + t];
                const float rstd = 1.f / sqrtf(a2 * (1.f / 128.f) + LN_EPS); const int v0 = 16 * w + 4 * ge;
                const v2u gg = *(const v2u*)(PROJ + (m0 + t) * NPROJ + PC_GH + h * 128 + v0); const f32x4 wn = *(const f32x4*)(hnw + h * 128 + v0);
                const f32x4 x = acc[tt];
                v2u o; o.x = pk2(x[0] * rstd * wn[0] * silu_f(bflo(gg.x)), x[1] * rstd * wn[1] * silu_f(bfhi(gg.x))); o.y = pk2(x[2] * rstd * wn[2] * silu_f(bflo(gg.y)), x[3] * rstd * wn[3] * silu_f(bfhi(gg.y)));
                *(v2u*)(YMIX + (m0 + t) * 2048 + 1024 + h * 128 + v0) = o; }
        }
#pragma unroll
        for (int dt = 0; dt < 8; ++dt) { const f32x4 dc = *(const LAS f32x4*)(tab + HT_DEC + 16 * dt + 4 * g);
            f32x4 a = Sst[dt] * dc;
            a = MFMA16(ldfrag(Ke + (16 * dt + c) * RS64 + (8 * g) * 2), Av[0], a); a = MFMA16(ldfrag(Ke + (16 * dt + c) * RS64 + (32 + 8 * g) * 2), Av[1], a); Sst[dt] = a; }
    }
    if (PASS == 0) {
        MIX_SYNC();
        float* gs = MB.GSH + (size_t)unit * 16384;
#pragma unroll
        for (int dt = 0; dt < 8; ++dt) *(f32x4*)(gs + (size_t)(16 * w + c) * 128 + 16 * dt + 4 * g) = Sst[dt];
        if (tid < 128) MB.GHD[(size_t)unit * 128 + tid] = tab[HT_BTOT + tid];
    }
}
MIXDEV void mix_scan(int gt  , MixBuf MB) {
    if (gt < 65536) {
        const int seq = gt >> 13, e4 = gt & 8191;
        f32x4 run = (f32x4){0.f, 0.f, 0.f, 0.f}, nrun = run; float mrun = 0.f;
        const bool don = e4 < 32;
        for (int gi = 0; gi < NGRP; ++gi) { const int unit = seq * NGRP + gi;
            f32x4* p = (f32x4*)(MB.GSM + (size_t)unit * 32768) + e4; const f32x4 tmp = *p; *p = run;
            const float mg = MB.GSS[unit * 4 + 0], bt = MB.GSS[unit * 4 + 1];
            const float mn = fmaxf(bt + mrun, mg), sa = __expf(bt + mrun - mn), sg = __expf(mg - mn);
            run = run * sa + tmp * sg;
            if (don) { f32x4* pn = (f32x4*)(MB.GSN + (size_t)unit * 128) + e4; const f32x4 tn = *pn; *pn = nrun; nrun = nrun * sa + tn * sg; }
            if (e4 == 0) MB.GSS[unit * 4 + 2] = mrun;
            mrun = mn; }
    } else {
        const int q = gt - 65536, seq = q >> 12, e4 = q & 4095, d4 = e4 & 31;
        f32x4 run = (f32x4){0.f, 0.f, 0.f, 0.f};
        for (int gi = 0; gi < NGRP; ++gi) { const int unit = seq * NGRP + gi;
            f32x4* p = (f32x4*)(MB.GSH + (size_t)unit * 16384) + e4; const f32x4 tmp = *p; *p = run;
            const f32x4 ld = *((const f32x4*)(MB.GHD + (size_t)unit * 128) + d4);
            run[0] = run[0] * __expf(ld[0]) + tmp[0]; run[1] = run[1] * __expf(ld[1]) + tmp[1]; run[2] = run[2] * __expf(ld[2]) + tmp[2]; run[3] = run[3] * __expf(ld[3]) + tmp[3]; }
    }
}
constexpr int NPL = 9, NPH = 2 + NPL * DEPTH;
struct Args { const float* in[20]; float* out; unsigned char* ws; int ph_lo, ph_hi; };
__global__ void __launch_bounds__(NTHR, 2) fwd(Args args) {
    extern __shared__ __attribute__((aligned(16))) unsigned char lds_raw[];
    LAS unsigned char* lds = (LAS unsigned char*)lds_raw;
    const int tid0 = threadIdx.x, G = gridDim.x;
#define PHASE_IDS() int tid = threadIdx.x; asm volatile("" : "+v"(tid)); const int lane = tid & 63, wave = __builtin_amdgcn_readfirstlane(tid >> 6); (void)lane; (void)wave
    Ptrs P;
    P.x = args.in[0]; P.c = args.in[1]; P.w_mod = args.in[2]; P.b_mod = args.in[3]; P.w_in = args.in[4]; P.conv_w = args.in[5]; P.conv_b = args.in[6]; P.b_ig = args.in[7]; P.b_fg = args.in[8];
    P.mnorm_w = args.in[9]; P.hnorm_w = args.in[10]; P.lb_logits = args.in[11]; P.w_out = args.in[12]; P.ln1_g = args.in[13]; P.ln1_b = args.in[14]; P.w_gate = args.in[15]; P.w_up = args.in[16];
    P.w_down = args.in[17]; P.ln2_g = args.in[18]; P.ln2_b = args.in[19]; P.out = args.out; P.ws = args.ws;
    volatile LAS unsigned* MISC = (volatile LAS unsigned*)(lds + MISC_OFF);
    if (tid0 < 32) MISC[tid0] = 0u;
    __syncthreads();
#if MK_ONE_LAUNCH
    XcdBarrier bar = xcd_barrier_post((unsigned*)(P.ws + WS_CTL) + CW_BAR, MISC + 8);
#define SEAM() xcd_barrier(bar)
#else
#define SEAM() do { } while (0)
#endif
    const int lo = args.ph_lo, hi = args.ph_hi;
#define IN(k) (lo <= (k) && (k) < hi)
#define SEAM_AFTER(k) do { if ((k) + 1 < hi) { SEAM(); } } while (0)
    float* MOD = (float*)(P.ws + WS_MOD); float* X = (float*)(P.ws + WS_X); bf16* U = (bf16*)(P.ws + WS_U); bf16* YMIX = (bf16*)(P.ws + WS_YMIX); bf16* PROJ = (bf16*)(P.ws + WS_PROJ); bf16* HB = (bf16*)(P.ws + WS_PROJ);
    float* GT = (float*)(P.ws + WS_GATES);
    MixBuf MB; MB.GSM = (float*)(P.ws + WS_GSM); MB.GSN = (float*)(P.ws + WS_GSN); MB.GSS = (float*)(P.ws + WS_GSS); MB.GSH = (float*)(P.ws + WS_GSH); MB.GHD = (float*)(P.ws + WS_GHD);

#ifndef SKIP_PRO
    if (IN(0)) { PHASE_IDS(); phase_prologue(P, lds, tid, lane, wave, G); SEAM_AFTER(0); }
#endif

    for (int l = 0; l < DEPTH; ++l) {
        const int base = 1 + NPL * l;
        if (base + NPL <= lo || base >= hi) continue;
        const float* modl = MOD + (size_t)l * 2 * NMODC;
#ifndef SKIP_P0
        if (IN(base + 0)) {
            PHASE_IDS();
            const float* gwl = (const float*)(P.ws + WS_GW) + (size_t)l * 8 * D;
            if (l == 0) phase_rows<false, true, true>(lds, tid, lane, wave, G, P.x, X, nullptr, nullptr, U, modl + 1 * D, modl + 0 * D, gwl, P.b_ig + l * 4, P.b_fg + l * 4, GT);
            else        phase_rows<true, true, true>(lds, tid, lane, wave, G, X, X, P.ln2_g + (l - 1) * D, P.ln2_b + (l - 1) * D, U, modl + 1 * D, modl + 0 * D, gwl, P.b_ig + l * 4, P.b_fg + l * 4, GT);
            SEAM_AFTER(base + 0);
        }
#endif
#ifndef SKIP_P1
        if (IN(base + 1)) {
            PHASE_IDS();
            pg8::Gemm g{U, (const bf16*)(P.ws + WS_WIN) + (size_t)l * NPROJ * D, M, NPROJ, D}; pg8::StaticOrder S; S.init(M, NPROJ, G, (int)blockIdx.x);
            pg8::EpiProj E{PROJ, NPROJ};
            pg8::gemm_phase<pg8::EpiProj, pg8::StaticOrder, true, true>(lds, g, S, E);
            SEAM_AFTER(base + 1);
        }
#endif
#ifndef SKIP_P2
        if (IN(base + 2)) {
            PHASE_IDS();
            for (int um = (int)blockIdx.x; um < 2 * 4 * NGRP; um += G) mlstm_unit<0>(lds, tid, lane, wave, um, PROJ, GT, P.conv_w + (size_t)l * 4 * 1024, P.conv_b + (size_t)l * 1024, P.mnorm_w + l * 1024, MB, YMIX);
            for (int uh = (int)blockIdx.x; uh < 2 * 8 * NGRP; uh += G) hgrn_unit<0>(lds, tid, lane, wave, uh, PROJ, (const float*)(P.ws + WS_LB) + l * 1024, P.hnorm_w + l * 1024, MB, YMIX);
            SEAM_AFTER(base + 2);
        }
#endif
#ifndef SKIP_P3
        if (IN(base + 3)) {
            PHASE_IDS();
            for (int gt = (int)blockIdx.x * NTHR + tid; gt < 131072; gt += G * NTHR) mix_scan(gt, MB);
            SEAM_AFTER(base + 3);
        }
#endif
#ifndef SKIP_PC
        if (IN(base + 4)) {
            PHASE_IDS();
#ifndef SKIP_PCM
            for (int um = (int)blockIdx.x; um < 2 * 4 * NGRP; um += G) mlstm_unit<1>(lds, tid, lane, wave, um, PROJ, GT, P.conv_w + (size_t)l * 4 * 1024, P.conv_b + (size_t)l * 1024, P.mnorm_w + l * 1024, MB, YMIX);
#endif
#ifndef SKIP_PCH
            for (int uh = (int)blockIdx.x; uh < 2 * 8 * NGRP; uh += G) hgrn_unit<1>(lds, tid, lane, wave, uh, PROJ, (const float*)(P.ws + WS_LB) + l * 1024, P.hnorm_w + l * 1024, MB, YMIX);
#endif
            SEAM_AFTER(base + 4);
        }
#endif
#ifndef SKIP_P4
        if (IN(base + 5)) {
            PHASE_IDS();
            pg8::Gemm g{YMIX, (const bf16*)(P.ws + WS_WOUT) + (size_t)l * D * D, M, D, D}; pg8::StaticOrder S; S.init(M, D, G, (int)blockIdx.x);
            pg8::EpiResid E{X, D, modl + 2 * D, modl + NMODC + 2 * D, DN_ALPHA};
            pg8::gemm_phase<pg8::EpiResid, pg8::StaticOrder, true, true>(lds, g, S, E);
            SEAM_AFTER(base + 5);
        }
#endif
#ifndef SKIP_P5
        if (IN(base + 6)) {
            PHASE_IDS();
            phase_rows<true, true, false>(lds, tid, lane, wave, G, X, X, P.ln1_g + l * D, P.ln1_b + l * D, U, modl + 4 * D, modl + 3 * D, nullptr, nullptr, nullptr, nullptr);
            SEAM_AFTER(base + 6);
        }
#endif
#ifndef SKIP_P6
        if (IN(base + 7)) {
            PHASE_IDS();
            pg8::Gemm g{U, (const bf16*)(P.ws + WS_WGU) + (size_t)l * NGU * D, M, NGU, D}; pg8::StaticOrder S; S.init(M, NGU, G, (int)blockIdx.x);
            pg8::EpiSwiGLU E{HB, FF};
            pg8::gemm_phase<pg8::EpiSwiGLU, pg8::StaticOrder, true, true>(lds, g, S, E);
            SEAM_AFTER(base + 7);
        }
#endif
#ifndef SKIP_P7
        if (IN(base + 8)) {
            PHASE_IDS();
            pg8::Gemm g{HB, (const bf16*)(P.ws + WS_WDN) + (size_t)l * D * FF, M, D, FF}; pg8::StaticOrder S; S.init(M, D, G, (int)blockIdx.x);
            pg8::EpiResid E{X, D, modl + 5 * D, modl + NMODC + 5 * D, DN_ALPHA};
            pg8::gemm_phase<pg8::EpiResid, pg8::StaticOrder, true, true>(lds, g, S, E);
            SEAM_AFTER(base + 8);
        }
#endif
    }
    if (IN(NPH - 1)) { PHASE_IDS(); phase_rows<true, false, false>(lds, tid, lane, wave, G, X, P.out, P.ln2_g + (DEPTH - 1) * D, P.ln2_b + (DEPTH - 1) * D, nullptr, nullptr, nullptr, nullptr, nullptr, nullptr, nullptr); }
#undef IN
#undef SEAM_AFTER
#undef SEAM
}
extern "C" void kernel_launch(void* const* d_in, const int* in_sizes, int n_in, void* d_out, int out_size, void* d_ws, size_t ws_size, hipStream_t stream) {
    static int grid = 0;
    if (grid == 0) {
        if (n_in != 20 || out_size != M * D || ws_size < WS_END) { fprintf(stderr, "kernel_launch: unexpected problem (n_in %d, out %d, ws %zu < %zu)\n", n_in, out_size, ws_size, (size_t)WS_END); grid = -1; return; }
        int dev = 0, cus = 0;
        if (hipGetDevice(&dev) != hipSuccess || hipDeviceGetAttribute(&cus, hipDeviceAttributeMultiprocessorCount, dev) != hipSuccess) { grid = -1; return; }
        if (hipFuncSetAttribute((const void*)fwd, hipFuncAttributeMaxDynamicSharedMemorySize, LDS_BYTES) != hipSuccess) { fprintf(stderr, "kernel_launch: hipFuncSetAttribute failed\n"); grid = -1; return; }
        int per_cu = 0; (void)hipOccupancyMaxActiveBlocksPerMultiprocessor(&per_cu, (const void*)fwd, NTHR, LDS_BYTES); (void)hipGetLastError();
        if (per_cu < 1) fprintf(stderr, "kernel_launch: occupancy query reports %d workgroups per CU\n", per_cu);
        grid = cus;
    }
    if (grid < 0) return;
    (void)hipMemsetAsync((char*)d_ws + WS_CTL, 0, CTL_ZERO_BYTES, stream);
    Args a{};
    for (int i = 0; i < 20; ++i) a.in[i] = (const float*)d_in[i];
    a.out = (float*)d_out; a.ws = (unsigned char*)d_ws;
#if MK_ONE_LAUNCH
    a.ph_lo = 0; a.ph_hi = NPH;
    hipLaunchKernelGGL(fwd, dim3(grid), dim3(NTHR), LDS_BYTES, stream, a);
#else
    for (int p = 0; p < NPH; ++p) { a.ph_lo = p; a.ph_hi = p + 1; hipLaunchKernelGGL(fwd, dim3(grid), dim3(NTHR), LDS_BYTES, stream, a); }
#endif
}
```

```cpp
#include <hip/hip_runtime.h>
#include <cstdio>
#include <cstdint>
#ifndef MK_ONE_LAUNCH
#define MK_ONE_LAUNCH 1
#endif
#ifndef PROBE_MASK_A
#define PROBE_MASK_A 0
#endif
#ifndef PROBE_MASK_R
#define PROBE_MASK_R 0
#endif
#ifndef DUP_MASK
#define DUP_MASK 0
#endif
#ifndef GEMM_ALIGN
#define GEMM_ALIGN true
#endif
#ifndef GEMM_SKEW_TICKS
#define GEMM_SKEW_TICKS 0
#endif
#ifndef XCD_AFFINE
#define XCD_AFFINE 0
#endif
#ifndef PROJ_BLOCKED
#define PROJ_BLOCKED 1
#endif
#ifndef MIX_ORDER
#define MIX_ORDER 1
#endif
#ifndef GIN_CMAP
#define GIN_CMAP 0x5410632u
#endif
#ifndef GEMM_SP2
#define GEMM_SP2 true
#endif
#ifndef GEMM_ALIGN_GU
#define GEMM_ALIGN_GU true
#endif
#ifndef CODE_SHIFT_NOPS
#define CODE_SHIFT_NOPS 0
#endif
#define CODE_SHIFT_STR_(x) #x
#define CODE_SHIFT_STR__(x) CODE_SHIFT_STR_(x)
#define CODE_SHIFT_STR CODE_SHIFT_STR__(CODE_SHIFT_NOPS)
#ifndef KLOOP_P2ALIGN
#define KLOOP_P2ALIGN 0
#endif
#define KLOOP_P2ALIGN_STR CODE_SHIFT_STR__(KLOOP_P2ALIGN)
namespace pg8 {
#define PG8_LAS __attribute__((address_space(3)))
typedef unsigned short bf16_t;
typedef short bf16x8 __attribute__((ext_vector_type(8)));
typedef float f32x4 __attribute__((ext_vector_type(4)));
typedef unsigned u32x4 __attribute__((ext_vector_type(4)));
constexpr int BM = 256, BK = 64, HALF = 128, HTB = HALF * BK * 2  , STAGE_BYTES = 8 * HTB, NXCD = 8, WGM = 8;

__host__ __device__ __forceinline__ int lds_byte(int r, int c) { const int st = (r >> 4) * 2 + (c >> 5), rr = r & 15, cc = c & 31, ob = rr * 64 + cc * 2; return st * 1024 + (ob ^ (((ob >> 9) & 1) << 5)); }
__host__ __device__ __forceinline__ void stage_rc(int b, int& R, int& C) { const int st = b / 1024, sb = b % 1024, swz = sb ^ (((sb >> 9) & 1) << 5); R = (st >> 1) * 16 + swz / 64; C = (st & 1) * 32 + (swz % 64) / 2; }
__host__ __device__ __forceinline__ int perm32(int rho) { const int n = rho >> 4, i = rho & 15; return 8 * (i >> 2) + 4 * n + (i & 3); }

struct Unit { int pm, pn; };
struct Gemm { const bf16_t* A; const bf16_t* Bt; int M, N, K; };

struct StaticOrder {
    int nM, nN, nwg, G, c; unsigned cmap;
    __host__ __device__ void init(int M, int N, int G_, int c_, unsigned cmap_ = 0u) { nM = M / BM; nN = N / BM; nwg = nM * nN; G = G_; c = c_; cmap = cmap_; }
    __host__ __device__ bool next(int i, Unit& u) const {
        const long L = (long)i * G + c; if (L >= nwg) return false;
        int wgid = (int)L; { const int q = nwg / NXCD, r = nwg % NXCD, xcd = wgid % NXCD, off = wgid / NXCD; wgid = (xcd < r ? xcd * (q + 1) : r * (q + 1) + (xcd - r) * q) + off; }
        const int nig = WGM * nN, gid = wgid / nig, fm = gid * WGM, gsz = (nM - fm) < WGM ? (nM - fm) : WGM;
        u.pm = fm + ((wgid % nig) % gsz); u.pn = (wgid % nig) / gsz; if (cmap) u.pn = (int)((cmap >> (4 * (u.pn >> 2))) & 15u) * 4 + (u.pn & 3); return true;
    }
    __device__ __forceinline__ void a_ready(const Unit&) const {}
    __device__ __forceinline__ void done(const Unit&) const {}
};

__device__ __forceinline__ unsigned cvt_pk_bf16(float lo, float hi) { typedef __bf16 b2_t __attribute__((ext_vector_type(2))); typedef float f2_t __attribute__((ext_vector_type(2))); const b2_t r = __builtin_convertvector((f2_t){lo, hi}, b2_t); return __builtin_bit_cast(unsigned, r); }
typedef float f32x2 __attribute__((ext_vector_type(2)));
#ifndef EPI_NT
#define EPI_NT 0
#endif
#ifndef EPI_SC1
#define EPI_SC1 0
#endif
#if EPI_SC1
#define EPI_STORE16(p, v) asm volatile("global_store_dwordx4 %0, %1, off sc1\n\ts_nop 1" :: "v"(p), "v"(v) : "memory")
#elif EPI_NT
#define EPI_STORE16(p, v) __builtin_nontemporal_store((v), (p))
#else
#define EPI_STORE16(p, v) (*(p) = (v))
#endif
__device__ __forceinline__ float fast_silu(float x) { return x * __builtin_amdgcn_rcpf(1.0f + __expf(-x)); }
#ifndef EPI_PREACT
#define EPI_PREACT 1
#endif
struct EpiProj {
    static constexpr bool PERM = true, AFTER_DRAIN = false; static constexpr int NSTORE = 0;
    bf16_t* O; int ldc; size_t blk;
    __device__ __forceinline__ void operator()(const f32x4 (&acc)[2][2][4][2], const Unit& u, int wr, int wc, int fr, int fq) const {
        const int row0 = u.pm * BM + wr * 64 + fr, col0 = u.pn * BM + wc * 32 + 8 * fq;
        const int seg = u.pn >> 2, act = EPI_PREACT ? ((seg == 2) ? 1 : (seg == 3 || seg == 6) ? 2 : 0) : 0;
#pragma unroll
        for (int ai = 0; ai < 2; ++ai)
#pragma unroll
            for (int m = 0; m < 4; ++m) { bf16_t* rowp = PROJ_BLOCKED ? O + (size_t)(2 * u.pn) * blk + (size_t)(row0 + ai * HALF + m * 16) * 128 + (wc * 32 + 8 * fq) : O + (size_t)(row0 + ai * HALF + m * 16) * ldc + col0;
#pragma unroll
                for (int bj = 0; bj < 2; ++bj) { f32x4 v0 = acc[ai][bj][m][0], v1 = acc[ai][bj][m][1];
                    if (act == 1) {
#pragma unroll
                        for (int j = 0; j < 4; ++j) { v0[j] = __builtin_amdgcn_rcpf(1.0f + __expf(-v0[j])); v1[j] = __builtin_amdgcn_rcpf(1.0f + __expf(-v1[j])); } }
                    else if (act == 2) {
#pragma unroll
                        for (int j = 0; j < 4; ++j) { v0[j] = fast_silu(v0[j]); v1[j] = fast_silu(v1[j]); } }
                    u32x4 w; w.x = cvt_pk_bf16(v0[0], v0[1]); w.y = cvt_pk_bf16(v0[2], v0[3]); w.z = cvt_pk_bf16(v1[0], v1[1]); w.w = cvt_pk_bf16(v1[2], v1[3]);
                    EPI_STORE16((u32x4*)(rowp + (PROJ_BLOCKED ? (size_t)bj * blk : (size_t)(bj * HALF))), w); } }
    }
};
struct EpiResid {
    static constexpr bool PERM = false, AFTER_DRAIN = false; static constexpr int NSTORE = 0;
    float* X; int ldc; const float* g0; const float* g1; float alpha; float* Xout;
    __device__ __forceinline__ void operator()(const f32x4 (&acc)[2][2][4][2], const Unit& u, int wr, int wc, int fr, int fq) const {
        const int row0 = u.pm * BM + wr * 64 + fr, col0 = u.pn * BM + wc * 32 + 4 * fq;
        const float* g = (u.pm >= 32) ? g1 : g0;
        f32x4 gv[2][2];
#pragma unroll
        for (int bj = 0; bj < 2; ++bj)
#pragma unroll
            for (int n = 0; n < 2; ++n) gv[bj][n] = *(const f32x4*)(g + col0 + bj * HALF + n * 16) + 1.0f;
#pragma unroll
        for (int ai = 0; ai < 2; ++ai)
#pragma unroll
            for (int m = 0; m < 4; ++m) { const size_t ro = (size_t)(row0 + ai * HALF + m * 16) * ldc + col0; const float* rowp = X + ro; float* rowo = Xout + ro;
#pragma unroll
                for (int bj = 0; bj < 2; ++bj)
#pragma unroll
                    for (int n = 0; n < 2; ++n) { const f32x4 xo = *(const f32x4*)(rowp + bj * HALF + n * 16); *(f32x4*)(rowo + bj * HALF + n * 16) = xo * alpha + gv[bj][n] * acc[ai][bj][m][n]; }
                asm volatile("" ::: "memory"); }
    }
};
struct EpiSwiGLU {
    static constexpr bool PERM = true, AFTER_DRAIN = false; static constexpr int NSTORE = 0;
    bf16_t* O; int ldc;
    __device__ __forceinline__ void operator()(const f32x4 (&acc)[2][2][4][2], const Unit& u, int wr, int wc, int fr, int fq) const {
        const int row0 = u.pm * BM + wr * 64 + fr, col0 = u.pn * HALF + wc * 32 + 8 * fq;
#pragma unroll
        for (int ai = 0; ai < 2; ++ai)
#pragma unroll
            for (int m = 0; m < 4; ++m) { bf16_t* rowp = O + (size_t)(row0 + ai * HALF + m * 16) * ldc + col0;
                const f32x4 g0 = acc[ai][0][m][0], g1 = acc[ai][0][m][1], u0 = acc[ai][1][m][0], u1 = acc[ai][1][m][1];
                f32x4 h0, h1;
#pragma unroll
                for (int j = 0; j < 4; ++j) { h0[j] = fast_silu(g0[j]) * u0[j]; h1[j] = fast_silu(g1[j]) * u1[j]; }
                u32x4 w; w.x = cvt_pk_bf16(h0[0], h0[1]); w.y = cvt_pk_bf16(h0[2], h0[3]); w.z = cvt_pk_bf16(h1[0], h1[1]); w.w = cvt_pk_bf16(h1[2], h1[3]);
                EPI_STORE16((u32x4*)rowp, w); }
    }
};
struct EpiNull {
    static constexpr bool PERM = true, AFTER_DRAIN = false; static constexpr int NSTORE = 0;
    bf16_t* O; int mode;
    __device__ __forceinline__ void operator()(const f32x4 (&acc)[2][2][4][2], const Unit& u, int wr, int wc, int fr, int fq) const {
        const int row0 = wr * 64 + fr, col0 = wc * 32 + 8 * fq;
        bf16_t* Ob = O + ((mode == 3) ? (size_t)(u.pm * 28 + u.pn) * 65536 : (size_t)0);
#pragma unroll
        for (int ai = 0; ai < 2; ++ai)
#pragma unroll
            for (int m = 0; m < 4; ++m) { bf16_t* rowp = Ob + (size_t)((mode == 2) ? (row0 & 15) : (row0 + ai * HALF + m * 16)) * 256 + col0;
#pragma unroll
                for (int bj = 0; bj < 2; ++bj) { const f32x4 v0 = acc[ai][bj][m][0], v1 = acc[ai][bj][m][1];
                    u32x4 w; w.x = cvt_pk_bf16(v0[0], v0[1]); w.y = cvt_pk_bf16(v0[2], v0[3]); w.z = cvt_pk_bf16(v1[0], v1[1]); w.w = cvt_pk_bf16(v1[2], v1[3]);
                    if (mode == 4) *(u32x4*)(O + (size_t)(u.pm * 28 + u.pn) * 65536 + (size_t)((((wr * 4 + wc) * 2 + ai) * 4 + m) * 2 + bj) * 512 + (fr * 4 + fq) * 8) = w;
                    else if (mode) *(u32x4*)(rowp + bj * HALF) = w; else asm volatile("" :: "v"(w)); } }
    }
};
struct EpiYb {
    static constexpr bool PERM = true, AFTER_DRAIN = false; static constexpr int NSTORE = 0;
    bf16_t* O; int ldc; const float* g0; const float* g1;
    __device__ __forceinline__ void operator()(const f32x4 (&acc)[2][2][4][2], const Unit& u, int wr, int wc, int fr, int fq) const {
        const int row0 = u.pm * BM + wr * 64 + fr, col0 = u.pn * BM + wc * 32 + 8 * fq;
        const float* g = (u.pm >= 32) ? g1 : g0;
        f32x4 gv[2][2];
#pragma unroll
        for (int bj = 0; bj < 2; ++bj)
#pragma unroll
            for (int n = 0; n < 2; ++n) gv[bj][n] = *(const f32x4*)(g + col0 + bj * HALF + 4 * n) + 1.0f;
#pragma unroll
        for (int ai = 0; ai < 2; ++ai)
#pragma unroll
            for (int m = 0; m < 4; ++m) { bf16_t* rowp = O + (size_t)(row0 + ai * HALF + m * 16) * ldc + col0;
#pragma unroll
                for (int bj = 0; bj < 2; ++bj) { const f32x4 v0 = acc[ai][bj][m][0] * gv[bj][0], v1 = acc[ai][bj][m][1] * gv[bj][1];
                    u32x4 w; w.x = cvt_pk_bf16(v0[0], v0[1]); w.y = cvt_pk_bf16(v0[2], v0[3]); w.z = cvt_pk_bf16(v1[0], v1[1]); w.w = cvt_pk_bf16(v1[2], v1[3]);
                    EPI_STORE16((u32x4*)(rowp + bj * HALF), w); } }
    }
};
struct EpiLin {
    static constexpr bool PERM = true, AFTER_DRAIN = false; static constexpr int NSTORE = 0;
    bf16_t* O;
    __device__ __forceinline__ void operator()(const f32x4 (&acc)[2][2][4][2], const Unit& u, int wr, int wc, int fr, int fq) const {
        bf16_t* base = O + (size_t)(u.pm * 28 + u.pn) * 65536 + (size_t)(wr * 4 + wc) * 8192 + (fr * 4 + fq) * 8;
#pragma unroll
        for (int ai = 0; ai < 2; ++ai)
#pragma unroll
            for (int m = 0; m < 4; ++m)
#pragma unroll
                for (int bj = 0; bj < 2; ++bj) { const f32x4 v0 = acc[ai][bj][m][0], v1 = acc[ai][bj][m][1];
                    u32x4 w; w.x = cvt_pk_bf16(v0[0], v0[1]); w.y = cvt_pk_bf16(v0[2], v0[3]); w.z = cvt_pk_bf16(v1[0], v1[1]); w.w = cvt_pk_bf16(v1[2], v1[3]);
                    *(u32x4*)(base + ((ai * 4 + m) * 2 + bj) * 512) = w; }
    }
};
template <class Epi, class Sched, bool ALIGN_EPI = false, bool SP2 = false>
__device__ __forceinline__ void gemm_phase(PG8_LAS unsigned char* lds, const Gemm g, const Sched& S, const Epi& E, int tid_arg) {
    int tid_ = tid_arg; asm volatile("" : "+v"(tid_));
    const int tid = tid_, wid = __builtin_amdgcn_readfirstlane(tid >> 6), lane = tid & 63, wr = wid >> 2, wc = wid & 3, fr = lane & 15, fq = lane >> 4;
    const int K = g.K, nt = K / BK;
    unsigned voffA[2], voffB[2];
#pragma unroll
    for (int i = 0; i < 2; ++i) { int R, C; stage_rc(tid * 16 + i * 8192, R, C); const int Rb = Epi::PERM ? ((R & ~31) + perm32(R & 31)) : R;
        voffA[i] = (unsigned)(R * K + C) * 2u; voffB[i] = (unsigned)(Rb * K + C) * 2u; }
    const size_t kstep = (size_t)(BK * 2);
    const size_t hstep = (size_t)HALF * K * 2;
    const size_t tstep = 2 * hstep;
    const unsigned ldsw = (unsigned)wid * 1024u;
    const int aoff = lds_byte(wr * 64 + fr, fq * 8), boff = lds_byte(wc * 32 + fr, fq * 8);
#define PG8_SA(b, h) (((b) * 2 + (h)) * HTB)
#define PG8_SB(b, h) ((4 + (b) * 2 + (h)) * HTB)
#define PG8_STAGE(bufoff, gbase, voff) do { _Pragma("unroll") for (int _i = 0; _i < 2; ++_i) \
        __builtin_amdgcn_global_load_lds((const unsigned*)((const char*)(gbase) + (voff)[_i]), (PG8_LAS unsigned*)(lds + (bufoff) + ldsw + _i * 8192), 16, 0, 0); } while (0)
#define PG8_LDA(dst, b, h) do { _Pragma("unroll") for (int m = 0; m < 4; ++m) _Pragma("unroll") for (int k = 0; k < 2; ++k) dst[m][k] = *(const PG8_LAS bf16x8*)(lds + PG8_SA(b, h) + aoff + m * 2048 + k * 1024); } while (0)
#define PG8_LDB(dst, b, h) do { _Pragma("unroll") for (int n = 0; n < 2; ++n) _Pragma("unroll") for (int k = 0; k < 2; ++k) dst[n][k] = *(const PG8_LAS bf16x8*)(lds + PG8_SB(b, h) + boff + n * 2048 + k * 1024); } while (0)
#define PG8_MMA(ai, bj, At, Bt) do { __builtin_amdgcn_s_setprio(1); _Pragma("unroll") for (int m = 0; m < 4; ++m) _Pragma("unroll") for (int n = 0; n < 2; ++n) _Pragma("unroll") for (int k = 0; k < 2; ++k) \
        acc[ai][bj][m][n] = __builtin_amdgcn_mfma_f32_16x16x32_bf16(Bt[n][k], At[m][k], acc[ai][bj][m][n], 0, 0, 0); __builtin_amdgcn_s_setprio(0); } while (0)
#define PG8_WAIT_V(n) asm volatile("s_waitcnt vmcnt(" #n ")" ::: "memory")
#define PG8_WAIT_L(n) asm volatile("s_waitcnt lgkmcnt(" #n ")" ::: "memory")
#define PG8_BAR __builtin_amdgcn_s_barrier()
#define PG8_SCHED __builtin_amdgcn_sched_barrier(0)
    Unit cur, nxt; int ui = 0;
    if (!S.next(0, cur)) return;
    f32x4 acc[2][2][4][2];
#pragma unroll
    for (int a = 0; a < 2; ++a)
#pragma unroll
        for (int b = 0; b < 2; ++b)
#pragma unroll
            for (int m = 0; m < 4; ++m)
#pragma unroll
                for (int n = 0; n < 2; ++n) acc[a][b][m][n] = (f32x4){0.f, 0.f, 0.f, 0.f};
    bf16x8 At[4][2], B0[2][2], B1[2][2];
    const char* cA = (const char*)g.A + (size_t)cur.pm * tstep; const char* cB = (const char*)g.Bt + (size_t)cur.pn * tstep;
    S.a_ready(cur);
    if constexpr (SP2) {
        PG8_STAGE(PG8_SB(0, 0), cB, voffB); PG8_STAGE(PG8_SB(0, 1), cB + hstep, voffB); PG8_STAGE(PG8_SA(0, 0), cA, voffA); PG8_STAGE(PG8_SA(0, 1), cA + hstep, voffA);
        if (wr == 1) PG8_BAR;
        PG8_WAIT_V(2); PG8_BAR;
        PG8_STAGE(PG8_SB(1, 0), cB + kstep, voffB); PG8_STAGE(PG8_SA(1, 0), cA + kstep, voffA); PG8_STAGE(PG8_SB(1, 1), cB + hstep + kstep, voffB);
        PG8_WAIT_V(6); PG8_BAR;
    } else {
        PG8_STAGE(PG8_SB(0, 0), cB, voffB); PG8_STAGE(PG8_SA(0, 0), cA, voffA); PG8_STAGE(PG8_SB(0, 1), cB + hstep, voffB); PG8_STAGE(PG8_SA(0, 1), cA + hstep, voffA);
        if (wr == 1) PG8_BAR;
        PG8_WAIT_V(4); PG8_BAR;
        PG8_STAGE(PG8_SB(1, 0), cB + kstep, voffB); PG8_STAGE(PG8_SA(1, 0), cA + kstep, voffA); PG8_STAGE(PG8_SB(1, 1), cB + hstep + kstep, voffB);
        PG8_WAIT_V(6); PG8_BAR;
    }
    for (;;) {
        const bool has_next = S.next(ui + 1, nxt);
        const char* nA = has_next ? (const char*)g.A + (size_t)nxt.pm * tstep : cA; const char* nB = has_next ? (const char*)g.Bt + (size_t)nxt.pn * tstep : cB;
        for (int t = 0; t < nt; t += 2) {
#if KLOOP_P2ALIGN > 0
            asm volatile(".p2align " KLOOP_P2ALIGN_STR);
#endif
            const bool last = (t == nt - 2);
            const char* a1 = cA + (size_t)(t + 1) * kstep;
            const char* a2 = last ? nA : cA + (size_t)(t + 2) * kstep; const char* b2 = last ? nB : cB + (size_t)(t + 2) * kstep;
            const char* a3 = a2 + kstep; const char* b3 = b2 + kstep;
            if (last && has_next) S.a_ready(nxt);
            const int freshi = __builtin_amdgcn_readfirstlane(((t == 0) && (ui > 0)) ? 1 : 0);
            if constexpr (SP2) {
#define PG8_SP2_ITER(WV12) \
            PG8_LDB(B0, 0, 0); PG8_LDB(B1, 0, 1); PG8_SCHED; PG8_LDA(At, 0, 0); PG8_STAGE(PG8_SA(1, 1), a1 + hstep, voffA); \
            WV12; PG8_WAIT_L(0); PG8_BAR; PG8_MMA(0, 0, At, B0); PG8_MMA(0, 1, At, B1); PG8_BAR; PG8_SCHED; \
            PG8_LDA(At, 0, 1); PG8_STAGE(PG8_SB(0, 0), b2, voffB); PG8_STAGE(PG8_SB(0, 1), b2 + hstep, voffB); PG8_STAGE(PG8_SA(0, 0), a2, voffA); \
            WV12; PG8_WAIT_L(0); PG8_BAR; PG8_MMA(1, 0, At, B0); PG8_MMA(1, 1, At, B1); PG8_BAR; PG8_SCHED; \
            PG8_LDB(B0, 1, 0); PG8_LDB(B1, 1, 1); PG8_SCHED; PG8_LDA(At, 1, 0); PG8_STAGE(PG8_SA(0, 1), a2 + hstep, voffA); \
            PG8_WAIT_V(8); PG8_WAIT_L(0); PG8_BAR; PG8_MMA(0, 0, At, B0); PG8_MMA(0, 1, At, B1); PG8_BAR; PG8_SCHED; \
            PG8_LDA(At, 1, 1); PG8_STAGE(PG8_SB(1, 0), b3, voffB); PG8_STAGE(PG8_SB(1, 1), b3 + hstep, voffB); PG8_STAGE(PG8_SA(1, 0), a3, voffA); \
            PG8_WAIT_V(8); PG8_WAIT_L(0); PG8_BAR; PG8_MMA(1, 0, At, B0); PG8_MMA(1, 1, At, B1); PG8_BAR; PG8_SCHED;
#define PG8_WAIT_V8F() do { if constexpr (Epi::NSTORE == 16) asm volatile("s_cmp_lg_u32 %0, 0\n\ts_cbranch_scc0 .Lw8_%=\n\ts_waitcnt vmcnt(24)\n\ts_branch .Lwd_%=\n.Lw8_%=:\n\ts_waitcnt vmcnt(8)\n.Lwd_%=:" :: "s"(freshi) : "memory", "scc"); \
        else if constexpr (Epi::NSTORE == 8) asm volatile("s_cmp_lg_u32 %0, 0\n\ts_cbranch_scc0 .Lw8_%=\n\ts_waitcnt vmcnt(16)\n\ts_branch .Lwd_%=\n.Lw8_%=:\n\ts_waitcnt vmcnt(8)\n.Lwd_%=:" :: "s"(freshi) : "memory", "scc"); \
        else PG8_WAIT_V(8); } while (0)
            PG8_SP2_ITER(PG8_WAIT_V8F())
#undef PG8_WAIT_V8F
#undef PG8_SP2_ITER
            } else {
            PG8_LDB(B0, 0, 0); PG8_SCHED; PG8_LDA(At, 0, 0); PG8_STAGE(PG8_SA(1, 1), a1 + hstep, voffA);
            PG8_WAIT_L(8); PG8_BAR; PG8_WAIT_L(0); PG8_MMA(0, 0, At, B0); PG8_BAR; PG8_SCHED;
            PG8_LDB(B1, 0, 1); PG8_STAGE(PG8_SB(0, 0), b2, voffB);
            PG8_BAR; PG8_WAIT_L(0); PG8_MMA(0, 1, At, B1); PG8_BAR;
            PG8_LDA(At, 0, 1); PG8_STAGE(PG8_SA(0, 0), a2, voffA);
            PG8_BAR; PG8_WAIT_L(0); PG8_MMA(1, 0, At, B0); PG8_BAR; PG8_SCHED;
            PG8_STAGE(PG8_SB(0, 1), b2 + hstep, voffB);
            PG8_WAIT_V(6); PG8_BAR; PG8_MMA(1, 1, At, B1); PG8_BAR;
            PG8_LDB(B0, 1, 0); PG8_SCHED; PG8_LDA(At, 1, 0); PG8_STAGE(PG8_SA(0, 1), a2 + hstep, voffA);
            PG8_WAIT_L(8); PG8_BAR; PG8_WAIT_L(0); PG8_MMA(0, 0, At, B0); PG8_BAR; PG8_SCHED;
            PG8_LDB(B1, 1, 1); PG8_STAGE(PG8_SB(1, 0), b3, voffB);
            PG8_BAR; PG8_WAIT_L(0); PG8_MMA(0, 1, At, B1); PG8_BAR;
            PG8_LDA(At, 1, 1); PG8_STAGE(PG8_SA(1, 0), a3, voffA);
            PG8_BAR; PG8_WAIT_L(0); PG8_MMA(1, 0, At, B0); PG8_BAR; PG8_SCHED;
            PG8_STAGE(PG8_SB(1, 1), b3 + hstep, voffB);
            PG8_WAIT_V(6); PG8_BAR; PG8_MMA(1, 1, At, B1); PG8_BAR;
            }
        }
        if constexpr (ALIGN_EPI) { if (wr == 0) PG8_BAR; }
        if constexpr (!Epi::AFTER_DRAIN) { E(acc, cur, wr, wc, fr, fq); S.done(cur); }
        if (!has_next) break;
#pragma unroll
        for (int a = 0; a < 2; ++a)
#pragma unroll
            for (int b = 0; b < 2; ++b)
#pragma unroll
                for (int m = 0; m < 4; ++m)
#pragma unroll
                    for (int n = 0; n < 2; ++n) acc[a][b][m][n] = (f32x4){0.f, 0.f, 0.f, 0.f};
        cur = nxt; cA = nA; cB = nB; ++ui;
        if constexpr (ALIGN_EPI) { if (wr == 1) PG8_BAR; }
    }
    PG8_WAIT_V(0);
    if constexpr (!ALIGN_EPI) { if (wr == 0) PG8_BAR; }
    PG8_BAR;
    if constexpr (Epi::AFTER_DRAIN) { E.fused(acc, cur, wr, wc, fr, fq, lds, wid, lane); S.done(cur); }
#undef PG8_SA
#undef PG8_SB
#undef PG8_STAGE
#undef PG8_LDA
#undef PG8_LDB
#undef PG8_MMA
#undef PG8_WAIT_V
#undef PG8_WAIT_L
#undef PG8_BAR
#undef PG8_SCHED
}
}
constexpr int NWAVES = 8, NTHR = 512;
constexpr int D = 2048, BATCH = 2, T = 8192, DEPTH = 4, M = BATCH * T;
constexpr int NPROJ = 7168, DIN = 7176, FF = 5632, NGU = 2 * FF, NMODC = 6 * D;
constexpr float LN_EPS = 1e-5f, DN_ALPHA = 1.6817928305074292f, QSCALE = 0.08838834764831845f;
constexpr int PC_QK = 0, PC_V = 1024, PC_O = 2048, PC_QH = 3072, PC_FH = 4096, PC_IH = 5120, PC_GH = 6144;
constexpr size_t MiB = 1u << 20;
constexpr size_t WS_CTL = 0, CTL_ZERO_BYTES = 1 * MiB;
constexpr size_t WS_MOD = 1 * MiB;
constexpr size_t WS_LB = WS_MOD + 512 * 1024;
constexpr size_t WS_GW = WS_LB + 64 * 1024;
constexpr size_t WS_GATES = 2 * MiB;
constexpr size_t WS_DEN = 3 * MiB;
constexpr size_t WS_WIN = 4 * MiB;
constexpr size_t WS_WOUT = WS_WIN + 112 * MiB;
constexpr size_t WS_WGU = WS_WOUT + 32 * MiB;
constexpr size_t WS_WDN = WS_WGU + 176 * MiB;
constexpr size_t WS_X = WS_WDN + 88 * MiB;
constexpr size_t WS_U = WS_X + 128 * MiB;
constexpr size_t WS_YMIX = WS_U + 64 * MiB;
constexpr size_t WS_PROJ = WS_YMIX + 64 * MiB;
constexpr size_t WS_HRAW = WS_PROJ + 224 * MiB;
constexpr size_t WS_GSM = WS_HRAW + 128 * MiB;
constexpr size_t WS_GSH = WS_GSM + 32 * MiB;
constexpr size_t WS_GSN = WS_GSH + 32 * MiB;
constexpr size_t WS_GSS = WS_GSN + 128 * 1024;
constexpr size_t WS_GHD = WS_GSS + 4 * 1024;
constexpr size_t WS_YB = WS_GHD + 256 * 1024 + 124 * 1024;
constexpr size_t WS_END = WS_YB + 64 * MiB;
constexpr int CW_BAR = 4096;
constexpr int RING_BYTES = 131072, MISC_OFF = 150528, LDS_BYTES = 151552;
#define GAS __attribute__((address_space(1)))
#define LAS __attribute__((address_space(3)))
typedef unsigned short bf16;
typedef unsigned v4u __attribute__((ext_vector_type(4)));
typedef unsigned v2u __attribute__((ext_vector_type(2)));
typedef float f32x4 __attribute__((ext_vector_type(4)));
typedef float f32x2 __attribute__((ext_vector_type(2)));
#define LDS_WAIT() asm volatile("s_waitcnt lgkmcnt(0)" ::: "memory")
#define VM_WAIT() asm volatile("s_waitcnt vmcnt(0)" ::: "memory")
__device__ __forceinline__ unsigned f2bf(float f) { unsigned u = __builtin_bit_cast(unsigned, f); return (u + 0x7fffu + ((u >> 16) & 1u)) >> 16; }
__device__ __forceinline__ unsigned pk2(float lo, float hi) { return f2bf(lo) | (f2bf(hi) << 16); }
__device__ __forceinline__ float bf2f(unsigned short b) { return __builtin_bit_cast(float, (unsigned)b << 16); }
__device__ __forceinline__ float bflo(unsigned w) { return __builtin_bit_cast(float, w << 16); }
__device__ __forceinline__ float bfhi(unsigned w) { return __builtin_bit_cast(float, w & 0xffff0000u); }
__device__ __forceinline__ float sigmoid_f(float x) { return 1.0f / (1.0f + __expf(-x)); }
__device__ __forceinline__ float silu_f(float x) { return x / (1.0f + __expf(-x)); }
__device__ __forceinline__ float logsigmoid_f(float x) { return x < 0.f ? x - log1pf(expf(x)) : -log1pf(expf(-x)); }
__device__ __forceinline__ float wave_sum(float v) {
#pragma unroll
    for (int o = 1; o < 64; o <<= 1) v += __shfl_xor(v, o);
    return v;
}
#define XB_TMO      128
#define XB_XCNT(j)  (256  + 64 * (j))
#define XB_XSUB(j)  (1280 + 64 * (j))
#define XB_XGEN(j)  (2304 + 64 * (j))
#define XB_TOP      3328
#define XB_TOPGEN   3392
#define XCD_BAR_WORDS 3456
#define XB_SPIN_CAP (1u << 18)

__device__ __forceinline__ unsigned xb_ld(unsigned* p)              { return __hip_atomic_load(p, __ATOMIC_RELAXED, __HIP_MEMORY_SCOPE_AGENT); }
__device__ __forceinline__ unsigned xb_add(unsigned* p, unsigned v) { return __hip_atomic_fetch_add(p, v, __ATOMIC_RELAXED, __HIP_MEMORY_SCOPE_AGENT); }
__device__ __forceinline__ unsigned xb_xcc_id() { return (unsigned)__builtin_amdgcn_s_getreg((3 << 11) | 20) & 0xFu; }
#define XB_SPIN(cond, bar) do { unsigned _sp = 0; while (cond) { __builtin_amdgcn_s_sleep(1); \
    if ((++_sp & 255u) == 0u) { if (xb_ld(&(bar)[XB_TMO])) break; if (_sp > XB_SPIN_CAP) { atomicAdd(&(bar)[XB_TMO], 1u); break; } } } } while (0)

struct XcdBarrier {
    unsigned* bar; unsigned x;
    volatile LAS unsigned* st;
};

__device__ __forceinline__ XcdBarrier xcd_barrier_post(unsigned* bar, volatile LAS unsigned* st) {
    XcdBarrier b; b.bar = bar; b.x = xb_xcc_id(); b.st = st;
    if (threadIdx.x == 0) (void)xb_add(&bar[XB_XCNT(b.x)], 1u);
    return b;
}
__device__ __forceinline__ void xcd_barrier_complete(unsigned* bar, unsigned x, unsigned& nloc, unsigned& nx) {
    const unsigned G = gridDim.x * gridDim.y * gridDim.z;
    unsigned sum, cnt, mine, sp = 0u;
    for (;;) {
        sum = 0u; cnt = 0u; mine = 0u;
#pragma unroll
        for (unsigned j = 0; j < 16; ++j) { const unsigned c = xb_ld(&bar[XB_XCNT(j)]); sum += c; cnt += (c > 0u) ? 1u : 0u; mine = (j == x) ? c : mine; }
        if (sum == G) break;
        __builtin_amdgcn_s_sleep(1);
        if ((++sp & 255u) == 0u) { if (xb_ld(&bar[XB_TMO])) break; if (sp > XB_SPIN_CAP) { atomicAdd(&bar[XB_TMO], 1u); break; } }
    }
    nloc = mine > 0u ? mine : 1u; nx = cnt > 0u ? cnt : 1u;
}

__device__ __forceinline__ void xcd_barrier(const XcdBarrier& b) {
    asm volatile("s_waitcnt vmcnt(0)" ::: "memory");
    __syncthreads();
    if (threadIdx.x == 0) {
        unsigned* bar = b.bar;
        __builtin_amdgcn_s_waitcnt(0);
        unsigned nloc = b.st[0], nx = b.st[1];
        if (nloc == 0u) { xcd_barrier_complete(bar, b.x, nloc, nx); b.st[0] = nloc; b.st[1] = nx; }
        const unsigned old = xb_add(&bar[XB_XSUB(b.x)], 1u);
        const unsigned gen = old / nloc;
        if (old + 1u == (gen + 1u) * nloc) {
            __builtin_amdgcn_fence(__ATOMIC_RELEASE, "agent");
            asm volatile("s_waitcnt vmcnt(0)" ::: "memory");
            const unsigned og = xb_add(&bar[XB_TOP], 1u);
            const unsigned tg = og / nx;
            if (og + 1u == (tg + 1u) * nx) xb_add(&bar[XB_TOPGEN], 1u);
            else XB_SPIN(xb_ld(&bar[XB_TOPGEN]) == tg, bar);
            __builtin_amdgcn_fence(__ATOMIC_ACQUIRE, "agent");
            xb_add(&bar[XB_XGEN(b.x)], 1u);
            asm volatile("s_waitcnt vmcnt(0)" ::: "memory");
        } else {
            XB_SPIN(xb_ld(&bar[XB_XGEN(b.x)]) == gen, bar);
            __builtin_amdgcn_fence(__ATOMIC_ACQUIRE, "agent");
            asm volatile("s_waitcnt vmcnt(0)" ::: "memory");
        }
    }
    __syncthreads();
}
__device__ __forceinline__ void transpose_item(const float* W, int Nsrc, int ns0, int k0, bf16* WT, int Kdim, int nd0, LAS float* scr, int lane) {
#pragma unroll 8
    for (int i = 0; i < 32; ++i) { const int kk = 2 * i + (lane >> 5); scr[kk * 33 + (lane & 31)] = W[(size_t)(k0 + kk) * Nsrc + ns0 + (lane & 31)]; }
    LDS_WAIT(); asm volatile("" ::: "memory");
    const int c = lane & 7;
#pragma unroll
    for (int j = 0; j < 4; ++j) { const int n = (lane >> 3) + 8 * j; const LAS float* s = scr + (8 * c) * 33 + n;
        v4u o; o.x = pk2(s[0 * 33], s[1 * 33]); o.y = pk2(s[2 * 33], s[3 * 33]); o.z = pk2(s[4 * 33], s[5 * 33]); o.w = pk2(s[6 * 33], s[7 * 33]);
        *(GAS v4u*)(WT + (size_t)(nd0 + n) * Kdim + k0 + 8 * c) = o; }
    LDS_WAIT(); asm volatile("" ::: "memory");
}
struct Ptrs {
    const float *x, *c, *w_mod, *b_mod, *w_in, *conv_w, *conv_b, *b_ig, *b_fg, *mnorm_w, *hnorm_w, *lb_logits, *w_out, *ln1_g, *ln1_b, *w_gate, *w_up, *w_down, *ln2_g, *ln2_b;
    float* out; unsigned char* ws;
};
constexpr int IT_IN = 32 * 224, IT_OUT = 32 * 64, IT_GU = 32 * 352, IT_DN = 88 * 64, IT_LAYER = IT_IN + IT_OUT + IT_GU + IT_DN, IT_ALL = DEPTH * IT_LAYER;
__device__ __forceinline__ void do_transpose(const Ptrs& P, int it, LAS float* scr, int lane) {
    const int l = it / IT_LAYER; int r = it % IT_LAYER;
    if (r < IT_IN) { const int kb = r / 224, nb = r % 224, n0 = 32 * nb;
        transpose_item(P.w_in + (size_t)l * D * DIN, DIN, n0 + (n0 >= 3072 ? 8 : 0), 64 * kb, (bf16*)(P.ws + WS_WIN) + (size_t)l * NPROJ * D, D, n0, scr, lane); return; }
    r -= IT_IN;
    if (r < IT_OUT) { const int kb = r / 64, nb = r % 64, n0 = 32 * nb;
        transpose_item(P.w_out + (size_t)l * D * D, D, n0, 64 * kb, (bf16*)(P.ws + WS_WOUT) + (size_t)l * D * D, D, n0, scr, lane); return; }
    r -= IT_OUT;
    if (r < IT_GU) { const int kb = r / 352, nb = r % 352, n0 = 32 * nb, pn = n0 >> 8, wi = n0 & 255, bj = wi >> 7, jc = wi & 127;
        transpose_item((bj ? P.w_up : P.w_gate) + (size_t)l * D * FF, FF, 128 * pn + jc, 64 * kb, (bf16*)(P.ws + WS_WGU) + (size_t)l * NGU * D, D, n0, scr, lane); return; }
    r -= IT_GU;
    { const int kb = r / 64, nb = r % 64, n0 = 32 * nb;
        transpose_item(P.w_down + (size_t)l * FF * D, D, n0, 64 * kb, (bf16*)(P.ws + WS_WDN) + (size_t)l * D * FF, FF, n0, scr, lane); }
}
__device__ __forceinline__ void phase_prologue(const Ptrs& P, LAS unsigned char* lds, int tid, int lane, int wave, int G) {
    LAS float* ca = (LAS float*)(lds + 8 * 8704);
    for (int i = tid; i < 2 * D; i += NTHR) ca[i] = silu_f(P.c[i]);
    __syncthreads();
    const int gw = wave * G + (int)blockIdx.x, NGW = G * NWAVES;
    float* MOD = (float*)(P.ws + WS_MOD);
    for (int item = gw; item < DEPTH * 192; item += NGW) {
        const int l = item / 192, j = (item % 192) * 64 + lane;
        const float* w = P.w_mod + (size_t)l * D * NMODC + j;
        float a0 = 0.f, a1 = 0.f;
        for (int k = 0; k < D; k += 16) { float wv[16];
#pragma unroll
            for (int i = 0; i < 16; ++i) wv[i] = w[(size_t)(k + i) * NMODC];
#pragma unroll
            for (int i = 0; i < 16; ++i) { a0 += ca[k + i] * wv[i]; a1 += ca[D + k + i] * wv[i]; } }
        const float bm = P.b_mod[l * NMODC + j];
        MOD[(l * 2 + 0) * NMODC + j] = a0 + bm; MOD[(l * 2 + 1) * NMODC + j] = a1 + bm;
    }
    const int gid = (int)blockIdx.x * NTHR + tid;
    if (gid < DEPTH * 8 * D) { const int l = gid >> 14, jg = (gid >> 11) & 7, k = gid & 2047; ((float*)(P.ws + WS_GW))[gid] = P.w_in[((size_t)l * D + k) * DIN + 3072 + jg]; }
    if (gid < 1024) { const float g0 = P.lb_logits[gid], g1 = P.lb_logits[1024 + gid], g2 = P.lb_logits[2048 + gid], g3 = P.lb_logits[3072 + gid];
        const float mx = fmaxf(fmaxf(g0, g1), fmaxf(g2, g3)), e0 = expf(g0 - mx), e1 = expf(g1 - mx), e2 = expf(g2 - mx), e3 = expf(g3 - mx), inv = 1.0f / (e0 + e1 + e2 + e3);
        float* LB = (float*)(P.ws + WS_LB); LB[gid] = 0.f; LB[1024 + gid] = e1 * inv; LB[2048 + gid] = (e1 + e2) * inv; LB[3072 + gid] = (e1 + e2 + e3) * inv; }
    LAS float* scr = (LAS float*)(lds + wave * 8704);
    const int nmodw = DEPTH * 192 < NGW ? DEPTH * 192 : NGW;
    const int rest = NGW - nmodw;
    int r1, r2;
    if (rest > 0) { r2 = (IT_ALL + 50 * nmodw + NGW - 1) / NGW; r1 = r2 - 50; if (r1 < 0) r1 = 0; while ((long)r1 * nmodw + (long)r2 * rest < IT_ALL) ++r2; } else { r1 = (IT_ALL + NGW - 1) / NGW; r2 = r1; }
    int lo, hi;
    if (gw < nmodw) { lo = gw * r1; hi = lo + r1; } else { lo = nmodw * r1 + (gw - nmodw) * r2; hi = lo + r2; }
    if (hi > IT_ALL) hi = IT_ALL;
    for (int it = lo; it < hi; ++it) do_transpose(P, it, scr, lane);
}
template <int CTRL> __device__ __forceinline__ float dpp_add(float v) { return v + __builtin_bit_cast(float, __builtin_amdgcn_update_dpp(0, __builtin_bit_cast(int, v), CTRL, 0xF, 0xF, false)); }
__device__ __forceinline__ float wave_sum_fast(float v) {
    v = dpp_add<0xB1>(v); v = dpp_add<0x4E>(v); v = dpp_add<0x141>(v); v = dpp_add<0x140>(v);
    v += __shfl_xor(v, 16); v += __shfl_xor(v, 32); return v;
}
template <bool DO_LN, bool MAKE_U, bool GATES, bool SRC_BF16, bool DST_BF16>
__device__ __forceinline__ void phase_rows(LAS unsigned char* lds, int tid, int lane, int wave, int G, const void* srcv, const bf16* ysrc  , void* dstv, const float* lng, const float* lnb,
                                           bf16* U, const float* sc, const float* sh, const float* gwl, const float* b_ig, const float* b_fg, float* GT) {
    LAS float* wg = (LAS float*)lds;
    LAS float* tg = wg + 8 * D;
    if (GATES) for (int i = tid; i < 8 * D; i += NTHR) wg[i] = gwl[i];
    if (DO_LN) for (int i = tid; i < D; i += NTHR) { tg[i] = lng[i]; tg[D + i] = lnb[i]; }
    if (MAKE_U) for (int i = tid; i < 2 * D; i += NTHR) { const int bb = i >> 11, cc = i & 2047; tg[2 * D + i] = 1.0f + sc[(size_t)bb * NMODC + cc]; tg[4 * D + i] = sh[(size_t)bb * NMODC + cc]; }
    __syncthreads();
#if XCD_AFFINE
    const bool aff = (G == 256);
    const int gw = aff ? (((int)blockIdx.x & 7) * 2048 + ((int)blockIdx.x >> 3) * NWAVES + wave) : ((int)blockIdx.x * NWAVES + wave), NGW = aff ? 256 : G * NWAVES, MEND = aff ? (((int)blockIdx.x & 7) + 1) * 2048 : M;
#else
    const int gw = (int)blockIdx.x * NWAVES + wave, NGW = G * NWAVES, MEND = M;
#endif
    const float* src = (const float*)srcv; const bf16* srcb = (const bf16*)srcv; float* dst = (float*)dstv; bf16* dstb = (bf16*)dstv;
    f32x4 v[8], vn[8]; v2u xn[8], yv[8], yn[8];
#define ROW_LOAD(mm_) do { _Pragma("unroll") for (int j = 0; j < 8; ++j) { if (SRC_BF16) xn[j] = *(const v2u*)(srcb + (size_t)(mm_) * D + 4 * lane + 256 * j); else vn[j] = *(const f32x4*)(src + (size_t)(mm_) * D + 4 * lane + 256 * j); \
        if (DO_LN) yn[j] = *(const v2u*)(ysrc + (size_t)(mm_) * D + 4 * lane + 256 * j); } } while (0)
    if (gw < MEND) ROW_LOAD(gw);
    for (int m = gw; m < MEND; m += NGW) {
        const int b = m >> 13;
#pragma unroll
        for (int j = 0; j < 8; ++j) { if (SRC_BF16) v[j] = (f32x4){bflo(xn[j].x), bfhi(xn[j].x), bflo(xn[j].y), bfhi(xn[j].y)}; else v[j] = vn[j]; if (DO_LN) yv[j] = yn[j]; }
        { const int ml = (m + NGW < MEND) ? m + NGW : m;
          ROW_LOAD(ml); }
        if (DO_LN) {
            float s = 0.f;
#pragma unroll
            for (int j = 0; j < 8; ++j) { v[j] = v[j] * DN_ALPHA + (f32x4){bflo(yv[j].x), bfhi(yv[j].x), bflo(yv[j].y), bfhi(yv[j].y)}; s += (v[j].x + v[j].y) + (v[j].z + v[j].w); }
            const float mean = wave_sum_fast(s) * (1.f / D); float s2 = 0.f;
#pragma unroll
            for (int j = 0; j < 8; ++j) { v[j] = v[j] - mean; s2 += (v[j].x * v[j].x + v[j].y * v[j].y) + (v[j].z * v[j].z + v[j].w * v[j].w); }
            const float rstd = 1.f / sqrtf(wave_sum_fast(s2) * (1.f / D) + LN_EPS);
#pragma unroll
            for (int j = 0; j < 8; ++j) { const f32x4 g = *(const LAS f32x4*)(tg + 4 * lane + 256 * j), bb = *(const LAS f32x4*)(tg + D + 4 * lane + 256 * j); v[j] = v[j] * rstd * g + bb; }
        }
        if (dstv) {
#pragma unroll
            for (int j = 0; j < 8; ++j) { if (DST_BF16) { v2u w; w.x = pg8::cvt_pk_bf16(v[j].x, v[j].y); w.y = pg8::cvt_pk_bf16(v[j].z, v[j].w); *(v2u*)(dstb + (size_t)m * D + 4 * lane + 256 * j) = w; }
                else *(f32x4*)(dst + (size_t)m * D + 4 * lane + 256 * j) = v[j]; }
        }
        if (MAKE_U) {
            bf16* uo = U + (size_t)m * D + 4 * lane;
#pragma unroll
            for (int j = 0; j < 8; ++j) { const f32x4 a = *(const LAS f32x4*)(tg + 2 * D + b * D + 4 * lane + 256 * j), c = *(const LAS f32x4*)(tg + 4 * D + b * D + 4 * lane + 256 * j); v[j] = v[j] * a + c;
                v2u w; w.x = pg8::cvt_pk_bf16(v[j].x, v[j].y); w.y = pg8::cvt_pk_bf16(v[j].z, v[j].w); *(v2u*)(uo + 256 * j) = w; }
            if (GATES) {
                float p[8];
#pragma unroll
                for (int jg = 0; jg < 8; ++jg) { float a = 0.f;
#pragma unroll
                    for (int j = 0; j < 8; ++j) { const f32x4 w = *(const LAS f32x4*)(wg + jg * D + 4 * lane + 256 * j); a += (v[j].x * w.x + v[j].y * w.y) + (v[j].z * w.z + v[j].w * w.w); }
                    p[jg] = a; asm volatile("" ::: "memory"); }
                float q[4], r[2], t1;
                { const bool hi = lane & 1;
#pragma unroll
                  for (int i = 0; i < 4; ++i) { const float mine = hi ? p[4 + i] : p[i], oth = hi ? p[i] : p[4 + i]; q[i] = mine + __shfl_xor(oth, 1); } }
                { const bool hi = lane & 2;
#pragma unroll
                  for (int i = 0; i < 2; ++i) { const float mine = hi ? q[2 + i] : q[i], oth = hi ? q[i] : q[2 + i]; r[i] = mine + __shfl_xor(oth, 2); } }
                { const bool hi = lane & 4; const float mine = hi ? r[1] : r[0], oth = hi ? r[0] : r[1]; t1 = mine + __shfl_xor(oth, 4); }
                t1 += __shfl_xor(t1, 8); t1 += __shfl_xor(t1, 16); t1 += __shfl_xor(t1, 32);
                if (lane < 8) { const int jg = 4 * (lane & 1) + 2 * ((lane >> 1) & 1) + ((lane >> 2) & 1); GT[(size_t)m * 8 + jg] = t1 + (jg < 4 ? b_ig[jg] : b_fg[jg - 4]); }
            }
        }
    }
}
#undef ROW_LOAD
constexpr int TS = 16;
__device__ __forceinline__ void naive_mlstm(LAS unsigned char* lds, int bh, int tid, const bf16* PROJ, const float* GT, const float* convw, const float* convb, float* HRAW, float* DEN) {
    const int b = bh >> 2, h = bh & 3;
    LAS float* qs = (LAS float*)lds; LAS float* ks = qs + TS * 128; LAS float* vs = ks + TS * 128; LAS float* gs = vs + TS * 256;
    float C[128];
#pragma unroll
    for (int d = 0; d < 128; ++d) C[d] = 0.f;
    float mrun = 0.f;
    const bool isv = tid < 256, isn = tid == 256;
    for (int t0 = 0; t0 < T; t0 += TS) {
        __syncthreads();
        for (int i = tid; i < TS * 256; i += NTHR) {
            const int tt = i >> 8, c = i & 255, ch = (c < 128) ? (h * 128 + c) : (512 + h * 128 + (c - 128)), t = t0 + tt;
            float a = convb[ch];
#pragma unroll
            for (int j = 0; j < 4; ++j) { const int ts = t - 3 + j; if (ts >= 0) a += convw[j * 1024 + ch] * bf2f(PROJ[(size_t)(b * T + ts) * NPROJ + PC_QK + ch]); }
            a = silu_f(a);
            if (c < 128) qs[tt * 128 + c] = a * QSCALE; else ks[tt * 128 + (c - 128)] = a;
        }
        for (int i = tid; i < TS * 256; i += NTHR) { const int tt = i >> 8, v = i & 255; vs[i] = bf2f(PROJ[(size_t)(b * T + t0 + tt) * NPROJ + PC_V + h * 256 + v]); }
        if (tid < TS) { const float* g = GT + (size_t)(b * T + t0 + tid) * 8; gs[tid * 2] = logsigmoid_f(g[4 + h]); gs[tid * 2 + 1] = g[h]; }
        __syncthreads();
        if (isv || isn) {
            for (int tt = 0; tt < TS; ++tt) {
                const float lf = gs[tt * 2], ig = gs[tt * 2 + 1];
                const float mnew = fmaxf(lf + mrun, ig), fdec = __expf(lf + mrun - mnew), iw = __expf(ig - mnew);
                mrun = mnew;
                const float a = iw * (isn ? 1.0f : vs[tt * 256 + (tid & 255)]);
                float n0 = 0.f, n1 = 0.f, n2 = 0.f, n3 = 0.f;
#pragma unroll
                for (int d = 0; d < 128; d += 4) {
                    const f32x4 kv = *(const LAS f32x4*)(ks + tt * 128 + d), qv = *(const LAS f32x4*)(qs + tt * 128 + d);
                    C[d] = fdec * C[d] + a * kv.x; n0 += qv.x * C[d];
                    C[d + 1] = fdec * C[d + 1] + a * kv.y; n1 += qv.y * C[d + 1];
                    C[d + 2] = fdec * C[d + 2] + a * kv.z; n2 += qv.z * C[d + 2];
                    C[d + 3] = fdec * C[d + 3] + a * kv.w; n3 += qv.w * C[d + 3];
                }
                const float num = (n0 + n1) + (n2 + n3);
                const size_t m = (size_t)(b * T + t0 + tt);
                if (isn) DEN[m * 4 + h] = fmaxf(fabsf(num), __expf(-mnew)); else HRAW[m * 2048 + h * 256 + tid] = num;
            }
        }
    }
}
__device__ __forceinline__ void naive_hgrn(LAS unsigned char* lds, int bh, int tid, const bf16* PROJ, const float* lbl, float* HRAW) {
    const int b = bh >> 3, h = bh & 7;
    LAS float* qs = (LAS float*)lds; LAS float* fs = qs + TS * 128; LAS float* ks = fs + TS * 128; LAS float* vs = ks + TS * 128;
    float S[128];
#pragma unroll
    for (int d = 0; d < 128; ++d) S[d] = 0.f;
    for (int t0 = 0; t0 < T; t0 += TS) {
        __syncthreads();
        for (int i = tid; i < TS * 128; i += NTHR) {
            const int tt = i >> 7, d = i & 127; const bf16* pr = PROJ + (size_t)(b * T + t0 + tt) * NPROJ + h * 128 + d;
            const float qr = bf2f(pr[PC_QH]), fp = bf2f(pr[PC_FH]), iv = bf2f(pr[PC_IH]), lbv = lbl[h * 128 + d];
            const float sg = 1.0f / (1.0f + __expf(-fp)), sn = 1.0f / (1.0f + __expf(fp));
            qs[i] = silu_f(qr); fs[i] = lbv + (1.0f - lbv) * sg; ks[i] = (1.0f - lbv) * sn; vs[i] = iv;
        }
        __syncthreads();
        if (tid < 128) {
            for (int tt = 0; tt < TS; ++tt) {
                const float vt = vs[tt * 128 + tid];
                float n0 = 0.f, n1 = 0.f, n2 = 0.f, n3 = 0.f;
#pragma unroll
                for (int d = 0; d < 128; d += 4) {
                    const f32x4 fv = *(const LAS f32x4*)(fs + tt * 128 + d), kv = *(const LAS f32x4*)(ks + tt * 128 + d), qv = *(const LAS f32x4*)(qs + tt * 128 + d);
                    S[d] = fv.x * S[d] + kv.x * vt; n0 += qv.x * S[d];
                    S[d + 1] = fv.y * S[d + 1] + kv.y * vt; n1 += qv.y * S[d + 1];
                    S[d + 2] = fv.z * S[d + 2] + kv.z * vt; n2 += qv.z * S[d + 2];
                    S[d + 3] = fv.w * S[d + 3] + kv.w * vt; n3 += qv.w * S[d + 3];
                }
                HRAW[(size_t)(b * T + t0 + tt) * 2048 + 1024 + h * 128 + tid] = (n0 + n1) + (n2 + n3);
            }
        }
    }
}
__device__ __forceinline__ void phase_fin(int lane, int wave, int G, const float* HRAW, const float* DEN, const bf16* PROJ, const float* mnw, const float* hnw, bf16* YMIX) {
    const int gw = (int)blockIdx.x * NWAVES + wave, NGW = G * NWAVES;
    for (int m = gw; m < M; m += NGW) {
        const float* hr = HRAW + (size_t)m * 2048; const bf16* pr = PROJ + (size_t)m * NPROJ; bf16* y = YMIX + (size_t)m * 2048;
#pragma unroll
        for (int h = 0; h < 4; ++h) {
            f32x4 v = *(const f32x4*)(hr + h * 256 + 4 * lane); const float dn = DEN[(size_t)m * 4 + h];
            v = v / dn;
            const float mean = wave_sum((v.x + v.y) + (v.z + v.w)) * (1.f / 256.f); v = v - mean;
            const float var = wave_sum((v.x * v.x + v.y * v.y) + (v.z * v.z + v.w * v.w)) * (1.f / 256.f), r = 1.f / sqrtf(var + LN_EPS);
            const f32x4 w = *(const f32x4*)(mnw + h * 256 + 4 * lane); const v2u o = *(const v2u*)(pr + PC_O + h * 256 + 4 * lane);
            const float o0 = v.x * r * w.x * sigmoid_f(bflo(o.x)), o1 = v.y * r * w.y * sigmoid_f(bfhi(o.x)), o2 = v.z * r * w.z * sigmoid_f(bflo(o.y)), o3 = v.w * r * w.w * sigmoid_f(bfhi(o.y));
            v2u q; q.x = pk2(o0, o1); q.y = pk2(o2, o3); *(v2u*)(y + h * 256 + 4 * lane) = q;
        }
#pragma unroll
        for (int h = 0; h < 8; ++h) {
            const f32x2 v = *(const f32x2*)(hr + 1024 + h * 128 + 2 * lane);
            const float ms = wave_sum(v.x * v.x + v.y * v.y) * (1.f / 128.f), r = 1.f / sqrtf(ms + LN_EPS);
            const f32x2 w = *(const f32x2*)(hnw + h * 128 + 2 * lane); const unsigned g = *(const unsigned*)(pr + PC_GH + h * 128 + 2 * lane);
            *(unsigned*)(y + 1024 + h * 128 + 2 * lane) = pk2(v.x * r * w.x * silu_f(bflo(g)), v.y * r * w.y * silu_f(bfhi(g)));
        }
    }
}
#define MIXDEV __device__ __forceinline__
#define MIX_STR2(x) #x
#define MIX_STR(x) MIX_STR2(x)
#ifdef MIX_MARKS
#define MIX_SYNC() do { asm volatile("s_waitcnt lgkmcnt(0) ; MARK line " MIX_STR(__LINE__) ::: "memory"); __builtin_amdgcn_s_barrier(); asm volatile("" ::: "memory"); } while (0)
#else
#define MIX_SYNC() do { asm volatile("s_waitcnt lgkmcnt(0)" ::: "memory"); __builtin_amdgcn_s_barrier(); asm volatile("" ::: "memory"); } while (0)
#endif
#define MFMA16(a, b, c) __builtin_amdgcn_mfma_f32_16x16x32_bf16((a), (b), (c), 0, 0, 0)
#define mix_shfl_up(v, o) __shfl_up((v), (o))
#define mix_shfl_xor(v, o) __shfl_xor((v), (o))
#define mix_shfl(v, l) __shfl((v), (l))
#define mix_cvt_pk(lo, hi) pg8::cvt_pk_bf16((lo), (hi))
#define MIX_CFENCE() asm volatile("" ::: "memory")
#define MIX_LAUNDER(x) asm volatile("" : "+v"(x))
#define mix_rcp(x) __builtin_amdgcn_rcpf(x)
#define mix_rsq(x) __builtin_amdgcn_rsqf(x)
#define mix_log(x) __logf(x)
__device__ __forceinline__ float mix_sigmoid(float x) { return __builtin_amdgcn_rcpf(1.0f + __expf(-x)); }
__device__ __forceinline__ float mix_silu(float x) { return x * __builtin_amdgcn_rcpf(1.0f + __expf(-x)); }
__device__ __forceinline__ float mix_logsig(float x) { return x < 0.f ? x - __logf(1.0f + __expf(x)) : -__logf(1.0f + __expf(-x)); }
#ifndef MIX_GCH
#define MIX_GCH 4
#endif
constexpr int GCM = 4, NGM = T / (64 * GCM), GCH = MIX_GCH, NGH = T / (64 * GCH);
constexpr int RS128 = 288, RS64 = 160;
constexpr float NEG_BIG = -1.0e30f;
#ifndef MIX_PREACT
#define MIX_PREACT 1
#endif
#if MIX_PREACT
#define MIX_OG(x) (x)
#define MIX_GQ(x) (x)
#else
#define MIX_OG(x) mix_sigmoid(x)
#define MIX_GQ(x) mix_silu(x)
#endif
#ifndef ML_PREFETCH
#define ML_PREFETCH 1
#endif
#ifndef PROJ_BLOCKED
#define PROJ_BLOCKED 1
#endif
MIXDEV size_t proj_off(size_t row, int col) { return PROJ_BLOCKED ? ((size_t)(col >> 7) * M + row) * 128 + (col & 127) : row * NPROJ + col; }
typedef short bf16x8 __attribute__((ext_vector_type(8)));
#ifndef MIX_ST16
#define MIX_ST16 1
#endif
#if MIX_ST16
typedef unsigned short mst_t;
#else
typedef float mst_t;
#endif
struct MixBuf { mst_t* GSM; float* GSN; float* GSS; mst_t* GSH; float* GHD; };
MIXDEV int dpos(int d) { return (d & ~31) | ((d & 12) << 1) | ((d & 16) >> 2) | (d & 3); }
MIXDEV int o64(int row, int colbyte) { return row * RS64 + (colbyte ^ (((row >> 4) & 7) << 4)); }
MIXDEV bf16x8 ldfrag(const LAS unsigned char* p) { return *(const LAS bf16x8*)p; }
MIXDEV bf16x8 pack_pair(const f32x4& x, const f32x4& y) { v4u p; p.x = mix_cvt_pk(x[0], x[1]); p.y = mix_cvt_pk(x[2], x[3]); p.z = mix_cvt_pk(y[0], y[1]); p.w = mix_cvt_pk(y[2], y[3]); return __builtin_bit_cast(bf16x8, p); }
#if MIX_ST16
MIXDEV f32x4 ld_st4(const mst_t* p) { const v2u q = *(const v2u*)p; return (f32x4){bflo(q.x), bfhi(q.x), bflo(q.y), bfhi(q.y)}; }
MIXDEV void st_st4(mst_t* p, const f32x4& v) { v2u q; q.x = mix_cvt_pk(v[0], v[1]); q.y = mix_cvt_pk(v[2], v[3]); *(v2u*)p = q; }
#else
MIXDEV f32x4 ld_st4(const mst_t* p) { return *(const f32x4*)p; }
MIXDEV void st_st4(mst_t* p, const f32x4& v) { *(f32x4*)p = v; }
#endif
MIXDEV void st_bf16(LAS unsigned char* p, float v) { *(LAS unsigned short*)p = (unsigned short)mix_cvt_pk(v, 0.f); }
MIXDEV float ld_bf16(const LAS unsigned char* p) { return bf2f(*(const LAS unsigned short*)p); }

constexpr int ML_Q = 0, ML_K = 18432, ML_KT = 36864, ML_VT = 57344, ML_SS = 98304, ML_TAB = 108544;
constexpr int MT_BCUM = 0, MT_GSV = 64, MT_MROW = 128, MT_WINT = 192, MT_WEND = 256, MT_RDEN = 320, MT_NP = 384, MT_SCAL = 512, MT_CW = 528, MT_HNP = 1808, MT_NW = 2832, MT_END = 3088;
template <int PASS, int DIAG = 0>
MIXDEV void mlstm_unit(LAS unsigned char* lds, int tid, int lane, int w, int unit, const bf16* PROJ, const float* GT, const float* convw, const float* convb, const float* mnw, MixBuf MB, bf16* YMIX) {
    const int b = unit / (4 * NGM), h = (unit / NGM) & 3, grp = unit % NGM;
    const int c = lane & 15, g = lane >> 4;
    LAS unsigned char* Qs = lds + ML_Q; LAS unsigned char* Ks = lds + ML_K; LAS unsigned char* Kwt = lds + ML_KT; LAS unsigned char* Vt = lds + ML_VT; LAS unsigned char* Ss = lds + ML_SS;
    LAS float* tab = (LAS float*)(lds + ML_TAB);
    f32x4 Cst[2][8];
    float m_run, btot = 0.f;
    MIX_SYNC();
    if (PASS == 1 && tid < 256) tab[MT_NW + tid] = mnw[h * 256 + tid];
    for (int i = tid; i < 5 * 256; i += NTHR) { const int j = i >> 8, cc = i & 255, ch = (cc < 128) ? (h * 128 + cc) : (512 + h * 128 + (cc - 128)); tab[MT_CW + i] = (j < 4) ? convw[j * 1024 + ch] : convb[ch]; }
    if (PASS == 0) {
#pragma unroll
        for (int vt = 0; vt < 2; ++vt)
#pragma unroll
            for (int dt = 0; dt < 8; ++dt) Cst[vt][dt] = (f32x4){0.f, 0.f, 0.f, 0.f};
        if (tid < 128) tab[MT_NP + tid] = 0.f;
        m_run = NEG_BIG;
    } else {
        const mst_t* gs = MB.GSM + (size_t)unit * 32768;
#pragma unroll
        for (int vt = 0; vt < 2; ++vt)
#pragma unroll
            for (int dt = 0; dt < 8; ++dt) Cst[vt][dt] = ld_st4(gs + (size_t)(32 * w + 16 * vt + c) * 128 + 16 * dt + 4 * g);
        if (tid < 128) tab[MT_NP + dpos(tid)] = MB.GSN[(size_t)unit * 128 + tid];
        m_run = MB.GSS[unit * 4 + 2];
    }
    float g_f = 0.f, g_i = 0.f; v4u rawc[7], rawv[4];
#define ML_LOADS(nn_) do { if (DIAG & 64) { unsigned z_ = 0x3f003f00u; MIX_LAUNDER(z_); g_f = 1.f; g_i = 0.5f; _Pragma("unroll") for (int i = 0; i < 7; ++i) rawc[i] = (v4u){z_, z_, z_, z_}; _Pragma("unroll") for (int i = 0; i < 4; ++i) rawv[i] = (v4u){z_, z_, z_, z_}; break; } int t_ = tid; MIX_LAUNDER(t_); const int sr_ = t_ >> 5, c8_ = t_ & 31; const bool isk_ = c8_ >= 16; const int ch0_ = isk_ ? (512 + h * 128 + 8 * (c8_ - 16)) : (h * 128 + 8 * c8_); \
        const size_t mm_ = (size_t)b * T + 64 * (nn_); \
        if (w == 0) { g_f = GT[(mm_ + (t_ & 63)) * 8 + 4 + h]; g_i = GT[(mm_ + (t_ & 63)) * 8 + h]; } \
        _Pragma("unroll") for (int i = 0; i < 7; ++i) { const int tg = 64 * (nn_) + 4 * sr_ - 3 + i; rawc[i] = (v4u){0u, 0u, 0u, 0u}; \
            if (((PASS == 1) || isk_) && tg >= 0) rawc[i] = *(const v4u*)(PROJ + proj_off((size_t)b * T + tg, PC_QK + ch0_)); } \
        _Pragma("unroll") for (int i = 0; i < 4; ++i) rawv[i] = *(const v4u*)(PROJ + proj_off(mm_ + 4 * sr_ + i, PC_V + h * 256 + 8 * c8_)); } while (0)
    ML_LOADS(grp * GCM);
    for (int j = 0; j < GCM; ++j) {
        const int n = grp * GCM + j; const size_t m0 = (size_t)b * T + 64 * n;
        if (PASS == 0 || j == 0) MIX_SYNC();
#if !ML_PREFETCH
        if (j > 0) ML_LOADS(n);
#endif
        int tid_s = tid; MIX_LAUNDER(tid_s);
        const int sr = tid_s >> 5, c8 = tid_s & 31;
        const bool isk = c8 >= 16; const bool do_conv = (PASS == 1) || isk;
        const int cc0 = 8 * c8, d0 = cc0 & 127;
        float kv[4][8];
        if (!(DIAG & 8)) {
        if (w == 0) {
            const float lf = mix_logsig(g_f), ig = g_i;
            float bc = lf;
#pragma unroll
            for (int o = 1; o < 64; o <<= 1) { const float y = mix_shfl_up(bc, o); if (lane >= o) bc += y; }
            const float gsx = ig - bc; float pm = gsx;
#pragma unroll
            for (int o = 1; o < 64; o <<= 1) { const float y = mix_shfl_up(pm, o); if (lane >= o) pm = fmaxf(pm, y); }
            const float mr = fmaxf(m_run, pm);
            tab[MT_BCUM + lane] = bc; tab[MT_GSV + lane] = gsx; tab[MT_MROW + lane] = mr; tab[MT_WINT + lane] = __expf(m_run - mr);
            const float mr63 = mix_shfl(mr, 63), bc63 = mix_shfl(bc, 63);
            tab[MT_WEND + lane] = __expf(gsx - mr63);
            if (lane == 0) { tab[MT_SCAL + 0] = __expf(m_run - mr63); tab[MT_SCAL + 1] = bc63 + mr63; tab[MT_SCAL + 2] = bc63; }
        }
        {
            const unsigned wv[4][4] = {{rawv[0].x, rawv[0].y, rawv[0].z, rawv[0].w}, {rawv[1].x, rawv[1].y, rawv[1].z, rawv[1].w}, {rawv[2].x, rawv[2].y, rawv[2].z, rawv[2].w}, {rawv[3].x, rawv[3].y, rawv[3].z, rawv[3].w}};
#pragma unroll
            for (int i = 0; i < 4; ++i) { v2u e, o2;
                e.x = (wv[0][i] & 0xffffu) | (wv[1][i] << 16); e.y = (wv[2][i] & 0xffffu) | (wv[3][i] << 16);
                o2.x = (wv[0][i] >> 16) | (wv[1][i] & 0xffff0000u); o2.y = (wv[2][i] >> 16) | (wv[3][i] & 0xffff0000u);
                *(LAS v2u*)(Vt + o64(8 * c8 + 2 * i, 2 * (4 * sr))) = e; *(LAS v2u*)(Vt + o64(8 * c8 + 2 * i + 1, 2 * (4 * sr))) = o2; }
        }
        MIX_CFENCE();
        unsigned kq[4][4];
        if (do_conv) {
            const unsigned rw[7][4] = {{rawc[0].x, rawc[0].y, rawc[0].z, rawc[0].w}, {rawc[1].x, rawc[1].y, rawc[1].z, rawc[1].w}, {rawc[2].x, rawc[2].y, rawc[2].z, rawc[2].w}, {rawc[3].x, rawc[3].y, rawc[3].z, rawc[3].w},
                                       {rawc[4].x, rawc[4].y, rawc[4].z, rawc[4].w}, {rawc[5].x, rawc[5].y, rawc[5].z, rawc[5].w}, {rawc[6].x, rawc[6].y, rawc[6].z, rawc[6].w}};
            const float sc = isk ? 1.0f : QSCALE;
#pragma unroll
            for (int p = 0; p < 4; ++p) {
                float w0[5], w1[5];
#pragma unroll
                for (int jt = 0; jt < 5; ++jt) { const f32x2 ww = *(const LAS f32x2*)(tab + MT_CW + jt * 256 + cc0 + 2 * p); w0[jt] = ww[0]; w1[jt] = ww[1]; }
#pragma unroll
                for (int o = 0; o < 4; ++o) { float a0 = w0[4], a1 = w1[4];
#pragma unroll
                    for (int jt = 0; jt < 4; ++jt) { a0 += w0[jt] * bflo(rw[o + jt][p]); a1 += w1[jt] * bfhi(rw[o + jt][p]); }
                    a0 = mix_silu(a0); a1 = mix_silu(a1); kv[o][2 * p] = a0; kv[o][2 * p + 1] = a1; kq[o][p] = mix_cvt_pk(a0 * sc, a1 * sc); }
                MIX_CFENCE();
            }
            if (PASS == 1) { LAS unsigned char* dst = isk ? Ks : Qs;
#pragma unroll
                for (int o = 0; o < 4; ++o) { const int s = 4 * sr + o; v2u lo, hi; lo.x = kq[o][0]; lo.y = kq[o][1]; hi.x = kq[o][2]; hi.y = kq[o][3];
                    *(LAS v2u*)(dst + s * RS128 + 2 * dpos(d0)) = lo; *(LAS v2u*)(dst + s * RS128 + 2 * dpos(d0 + 4)) = hi; } }
        }
        }
        MIX_SYNC();
#if ML_PREFETCH
        if (j + 1 < GCM) ML_LOADS(n + 1);
#endif
        const float decay = tab[MT_SCAL + 0], m_new = tab[MT_SCAL + 1]; btot += tab[MT_SCAL + 2];
        const bool upd = (PASS == 0) || (j + 1 < GCM);
        if (isk && upd && !(DIAG & 8)) { const f32x4 we = *(const LAS f32x4*)(tab + MT_WEND + 4 * sr);
#pragma unroll
            for (int i = 0; i < 8; ++i) { v2u q; q.x = mix_cvt_pk(kv[0][i] * we[0], kv[1][i] * we[1]); q.y = mix_cvt_pk(kv[2][i] * we[2], kv[3][i] * we[3]); *(LAS v2u*)(Kwt + o64(d0 + i, 2 * (4 * sr))) = q; } }
        if (PASS == 0) MIX_SYNC();
        int cm = c, gm = g; MIX_LAUNDER(cm); MIX_LAUNDER(gm);
        bf16x8 Av[2][2];
#pragma unroll
        for (int vt = 0; vt < 2; ++vt)
#pragma unroll
            for (int ks = 0; ks < 2; ++ks) Av[vt][ks] = ldfrag(Vt + o64(32 * w + 16 * vt + cm, (32 * ks + 8 * gm) * 2));
        if (PASS == 1 && !(DIAG & 2)) {
            const int ce = cm, ge = gm;
            {
                const int ti = w >> 1;
#pragma unroll
                for (int q2 = 0; q2 < 2; ++q2) { const int sj = 2 * (w & 1) + q2; f32x4 acc = (f32x4){0.f, 0.f, 0.f, 0.f};
                    if (sj <= ti) {
#pragma unroll
                        for (int ks = 0; ks < 4; ++ks) acc = MFMA16(ldfrag(Qs + (16 * ti + cm) * RS128 + (32 * ks + 8 * gm) * 2), ldfrag(Ks + (16 * sj + cm) * RS128 + (32 * ks + 8 * gm) * 2), acc);
                    }
                    const int s = 16 * sj + cm; const float gsx = tab[MT_GSV + s];
#pragma unroll
                    for (int r = 0; r < 4; ++r) { const int t = 16 * ti + 4 * gm + r; const float v = (s <= t) ? acc[r] * __expf(gsx - tab[MT_MROW + t]) : 0.f; st_bf16(Ss + t * RS64 + 2 * s, v); } }
            }
            f32x4 acc1[2][4];
#pragma unroll
            for (int vt = 0; vt < 2; ++vt)
#pragma unroll
                for (int tt = 0; tt < 4; ++tt) acc1[vt][tt] = (f32x4){0.f, 0.f, 0.f, 0.f};
#pragma unroll
            for (int ks = 0; ks < 4; ++ks) { const bf16x8 A0 = pack_pair(Cst[0][2 * ks], Cst[0][2 * ks + 1]), A1 = pack_pair(Cst[1][2 * ks], Cst[1][2 * ks + 1]);
#pragma unroll
                for (int tt = 0; tt < 4; ++tt) { const bf16x8 Bq = ldfrag(Qs + (16 * tt + cm) * RS128 + (32 * ks + 8 * gm) * 2);
                    acc1[0][tt] = MFMA16(A0, Bq, acc1[0][tt]); acc1[1][tt] = MFMA16(A1, Bq, acc1[1][tt]); } MIX_CFENCE(); }
            MIX_SYNC();
            {
                const int t = tid >> 3, part = tid & 7; float p1 = 0.f, p2 = 0.f;
#pragma unroll
                for (int i = 0; i < 8; ++i) p1 += ld_bf16(Ss + t * RS64 + 2 * (8 * part + i));
#pragma unroll
                for (int i = 0; i < 16; ++i) p2 += ld_bf16(Qs + t * RS128 + 2 * (16 * part + i)) * tab[MT_NP + 16 * part + i];
                float den = p1 + tab[MT_WINT + t] * p2;
                den += mix_shfl_xor(den, 1); den += mix_shfl_xor(den, 2); den += mix_shfl_xor(den, 4);
                if (part == 0) tab[MT_RDEN + t] = mix_rcp(fmaxf(fabsf(den), __expf(-(tab[MT_BCUM + t] + tab[MT_MROW + t]))));
            }
#pragma unroll
            for (int tt = 0; tt < 4; ++tt) { const float wi = tab[MT_WINT + 16 * tt + cm]; acc1[0][tt] = acc1[0][tt] * wi; acc1[1][tt] = acc1[1][tt] * wi; }
#pragma unroll
            for (int tt = 0; tt < 4; ++tt)
#pragma unroll
                for (int ks = 0; ks < 2; ++ks) { if (ks == 1 && tt < 2) continue;
                    const bf16x8 Bs = ldfrag(Ss + (16 * tt + cm) * RS64 + (32 * ks + 8 * gm) * 2);
                    acc1[0][tt] = MFMA16(Av[0][ks], Bs, acc1[0][tt]); acc1[1][tt] = MFMA16(Av[1][ks], Bs, acc1[1][tt]); MIX_CFENCE(); }
            if (!(DIAG & 1)) {
            v2u ogv[4][2];
#pragma unroll
            for (int tt = 0; tt < 4; ++tt)
#pragma unroll
                for (int vt = 0; vt < 2; ++vt) ogv[tt][vt] = (DIAG & 32) ? (v2u){0x3f803f80u, 0x3f803f80u} : *(const v2u*)(PROJ + proj_off(m0 + 16 * tt + ce, PC_O + h * 256 + 32 * w + 16 * vt + 4 * ge));
            MIX_SYNC();
            float s1[4], s2[4];
#pragma unroll
            for (int tt = 0; tt < 4; ++tt) { const int t = 16 * tt + ce; const float rd = tab[MT_RDEN + t]; s1[tt] = 0.f; s2[tt] = 0.f;
#pragma unroll
                for (int vt = 0; vt < 2; ++vt) { acc1[vt][tt] = acc1[vt][tt] * rd;
#pragma unroll
                    for (int r = 0; r < 4; ++r) { const float x = acc1[vt][tt][r]; s1[tt] += x; s2[tt] += x * x; } }
                s1[tt] += mix_shfl_xor(s1[tt], 16); s1[tt] += mix_shfl_xor(s1[tt], 32); s2[tt] += mix_shfl_xor(s2[tt], 16); s2[tt] += mix_shfl_xor(s2[tt], 32);
                if (ge == 0) { tab[MT_HNP + (w * 64 + t) * 2] = s1[tt]; tab[MT_HNP + (w * 64 + t) * 2 + 1] = s2[tt]; } }
            MIX_SYNC();
            float mean4[4], rstd4[4];
#pragma unroll
            for (int tt = 0; tt < 4; ++tt) { f32x2 pr[8];
#pragma unroll
                for (int ww = 0; ww < 8; ++ww) pr[ww] = *(const LAS f32x2*)(tab + MT_HNP + (ww * 64 + 16 * tt + ce) * 2);
                float a1 = 0.f, a2 = 0.f;
#pragma unroll
                for (int ww = 0; ww < 8; ++ww) { a1 += pr[ww][0]; a2 += pr[ww][1]; }
                mean4[tt] = a1 * (1.f / 256.f); rstd4[tt] = mix_rsq(fmaxf(a2 * (1.f / 256.f) - mean4[tt] * mean4[tt], 0.f) + LN_EPS); MIX_CFENCE(); }
            f32x4 wn2[2];
#pragma unroll
            for (int vt = 0; vt < 2; ++vt) wn2[vt] = *(const LAS f32x4*)(tab + MT_NW + 32 * w + 16 * vt + 4 * ge);
#pragma unroll
            for (int tt = 0; tt < 4; ++tt) { const int t = 16 * tt + ce; const float mean = mean4[tt], rstd = rstd4[tt];
#pragma unroll
                for (int vt = 0; vt < 2; ++vt) { const int v0 = 32 * w + 16 * vt + 4 * ge;
                    const v2u og = ogv[tt][vt]; const f32x4 wn = wn2[vt];
                    const f32x4 x = acc1[vt][tt];
                    v2u o; o.x = mix_cvt_pk((x[0] - mean) * rstd * wn[0] * MIX_OG(bflo(og.x)), (x[1] - mean) * rstd * wn[1] * MIX_OG(bfhi(og.x)));
                    o.y = mix_cvt_pk((x[2] - mean) * rstd * wn[2] * MIX_OG(bflo(og.y)), (x[3] - mean) * rstd * wn[3] * MIX_OG(bfhi(og.y)));
                    if (!(DIAG & 16)) *(v2u*)(YMIX + (m0 + t) * 2048 + h * 256 + v0) = o; else asm volatile("" :: "v"(o)); } MIX_CFENCE(); }
        }
        }
        if (upd && !(DIAG & 4)) {
#pragma unroll
        for (int dt = 0; dt < 8; ++dt) {
            const bf16x8 K0 = ldfrag(Kwt + o64(16 * dt + cm, (8 * gm) * 2)), K1 = ldfrag(Kwt + o64(16 * dt + cm, (32 + 8 * gm) * 2));
#pragma unroll
            for (int vt = 0; vt < 2; ++vt) { f32x4 a = Cst[vt][dt] * decay; a = MFMA16(K0, Av[vt][0], a); a = MFMA16(K1, Av[vt][1], a); Cst[vt][dt] = a; }
            if (dt & 1) MIX_CFENCE();
        }
        if (tid < 128) { float sum = 0.f;
#pragma unroll
            for (int i = 0; i < 64; ++i) sum += ld_bf16(Kwt + tid * RS64 + 2 * i);
            tab[MT_NP + dpos(tid)] = decay * tab[MT_NP + dpos(tid)] + sum; }
        }
        m_run = m_new;
    }
    if (PASS == 0) {
        MIX_SYNC();
        mst_t* gs = MB.GSM + (size_t)unit * 32768;
#pragma unroll
        for (int vt = 0; vt < 2; ++vt)
#pragma unroll
            for (int dt = 0; dt < 8; ++dt) st_st4(gs + (size_t)(32 * w + 16 * vt + c) * 128 + 16 * dt + 4 * g, Cst[vt][dt]);
        if (tid < 128) MB.GSN[(size_t)unit * 128 + tid] = tab[MT_NP + dpos(tid)];
        if (tid == 0) { MB.GSS[unit * 4 + 0] = m_run; MB.GSS[unit * 4 + 1] = btot; }
    }
#undef ML_LOADS
}

constexpr int HG_QT = 0, HG_QH = 18432, HG_KTI = 36864, HG_KE = 82944, HG_VT = 103424, HG_AS = 123904, HG_TAB = 134144;
constexpr int HT_TOT = 0, HT_DEC = 1024, HT_BTOT = 1152, HT_HNP = 1280, HT_LB = 1792, HT_NW = 1920, HT_END = 2048;
constexpr int HG_LDS_END = HG_TAB + HT_END * 4;
#ifndef MIX_WARM
#define MIX_WARM 0
#endif
MIXDEV unsigned hg_warm(const bf16* PROJ, int unit, int step, int lane, int w, bool pass_c) {
    const int b = unit / (8 * NGH), h = (unit / NGH) & 7, grp = unit % NGH, tsel = w >> 1;
    const int col = ((tsel == 0) ? PC_FH : (tsel == 1) ? PC_QH : (tsel == 2) ? PC_IH : PC_GH) + h * 128 + (w & 1) * 64;
    unsigned v = 0;
    if (pass_c || !(tsel & 1)) v = *(const unsigned*)(PROJ + proj_off((size_t)b * T + 64 * (grp * GCH + step) + lane, col));
    return v;
}
template <int PASS, int DIAG = 0>
MIXDEV void hgrn_unit(LAS unsigned char* lds, int tid, int lane, int w, int unit, const bf16* PROJ, const float* lbl, const float* hnw, MixBuf MB, bf16* YMIX, int next_unit = -1) {
    const int b = unit / (8 * NGH), h = (unit / NGH) & 7, grp = unit % NGH;
    const int c = lane & 15, g = lane >> 4;
    LAS unsigned char* Qt = lds + HG_QT; LAS unsigned char* Qh = lds + HG_QH; LAS unsigned char* Kti = lds + HG_KTI; LAS unsigned char* Ke = lds + HG_KE; LAS unsigned char* Vt = lds + HG_VT; LAS unsigned char* As = lds + HG_AS;
    LAS float* tab = (LAS float*)(lds + HG_TAB);
    f32x4 Sst[8];
    MIX_SYNC();
    if (tid < 128) { tab[HT_LB + tid] = lbl[h * 128 + tid]; tab[HT_NW + tid] = hnw[h * 128 + tid]; }
    if (PASS == 0) {
#pragma unroll
        for (int dt = 0; dt < 8; ++dt) Sst[dt] = (f32x4){0.f, 0.f, 0.f, 0.f};
        if (tid < 128) tab[HT_BTOT + tid] = 0.f;
    } else {
        const mst_t* gs = MB.GSH + (size_t)unit * 16384;
#pragma unroll
        for (int dt = 0; dt < 8; ++dt) Sst[dt] = ld_st4(gs + (size_t)(16 * w + c) * 128 + 16 * dt + 4 * g);
        for (int i = tid; i < 2 * 16 * 16; i += NTHR) { const int which = i >> 8, r = (i >> 4) & 15, cc = i & 15; *(LAS unsigned short*)(As + (32 * which + r) * RS64 + 2 * (32 * which + 16 + cc)) = 0; }
    }
    unsigned rawf[8], rawq[8]; v4u rawv[2]; v2u ggv[4];
    unsigned nf[8], nq[8]; v4u nv[2]; v2u ng[4];
#define HG_LOADS(mrow_) do { if (DIAG & 64) { unsigned z_ = 0x3f003f00u; MIX_LAUNDER(z_); _Pragma("unroll") for (int i = 0; i < 8; ++i) { nf[i] = z_; nq[i] = z_; } nv[0] = (v4u){z_, z_, z_, z_}; nv[1] = nv[0]; _Pragma("unroll") for (int i = 0; i < 4; ++i) ng[i] = (v2u){z_, z_}; break; } \
        int t_ = tid; MIX_LAUNDER(t_); const int r8_ = t_ >> 6, d_ = 2 * (t_ & 63), sr2_ = t_ >> 4, cv_ = t_ & 15, cg_ = t_ & 15, gq_ = (t_ >> 4) & 3; \
        _Pragma("unroll") for (int i = 0; i < 8; ++i) { const size_t ro_ = (mrow_) + 8 * r8_ + i; nf[i] = *(const unsigned*)(PROJ + proj_off(ro_, PC_FH + h * 128 + d_)); nq[i] = (PASS == 1) ? *(const unsigned*)(PROJ + proj_off(ro_, PC_QH + h * 128 + d_)) : 0u; } \
        _Pragma("unroll") for (int i = 0; i < 2; ++i) nv[i] = *(const v4u*)(PROJ + proj_off((mrow_) + 2 * sr2_ + i, PC_IH + h * 128 + 8 * cv_)); \
        if (PASS == 1) { _Pragma("unroll") for (int tt = 0; tt < 4; ++tt) ng[tt] = (DIAG & 32) ? (v2u){0x3f803f80u, 0x3f803f80u} : *(const v2u*)(PROJ + proj_off((mrow_) + 16 * tt + cg_, PC_GH + h * 128 + 16 * w + 4 * gq_)); } } while (0)
    HG_LOADS((size_t)b * T + 64 * (grp * GCH));
    unsigned warm = 0;
    for (int j = 0; j < GCH; ++j) {
        const int n = grp * GCH + j; const size_t m0 = (size_t)b * T + 64 * n;
        if (PASS == 0 || j == 0) MIX_SYNC();
#pragma unroll
        for (int i = 0; i < 8; ++i) { rawf[i] = nf[i]; rawq[i] = nq[i]; }
        rawv[0] = nv[0]; rawv[1] = nv[1];
#pragma unroll
        for (int i = 0; i < 4; ++i) ggv[i] = ng[i];
        if (j + 1 < GCH) HG_LOADS(m0 + 64);
        int tid_s = tid; MIX_LAUNDER(tid_s);
        const int r8 = tid_s >> 6, dp = tid_s & 63, d = 2 * dp, tq = r8 >> 1, sr2 = tid_s >> 4, cv = tid_s & 15;
        const f32x2 lbv = *(const LAS f32x2*)(tab + HT_LB + d);
        float loc[2][8], kk[2][8], qq[2][8];
        {
            float run0 = 0.f, run1 = 0.f;
#pragma unroll
            for (int i = 0; i < 8; ++i) {
                const float fp0 = fmaxf(bflo(rawf[i]), -80.f), fp1 = fmaxf(bfhi(rawf[i]), -80.f);
                const float ef0 = __expf(-fp0), ef1 = __expf(-fp1), sg0 = mix_rcp(1.0f + ef0), sg1 = mix_rcp(1.0f + ef1), sn0 = ef0 * sg0, sn1 = ef1 * sg1;
                run0 += mix_log(lbv[0] + (1.0f - lbv[0]) * sg0); run1 += mix_log(lbv[1] + (1.0f - lbv[1]) * sg1);
                loc[0][i] = run0; loc[1][i] = run1; kk[0][i] = (1.0f - lbv[0]) * sn0; kk[1][i] = (1.0f - lbv[1]) * sn1;
                qq[0][i] = (PASS == 1) ? MIX_GQ(bflo(rawq[i])) : 0.f; qq[1][i] = (PASS == 1) ? MIX_GQ(bfhi(rawq[i])) : 0.f; }
            *(LAS f32x2*)(tab + HT_TOT + r8 * 128 + d) = (f32x2){run0, run1};
        }
        {
            const unsigned w0[4] = {rawv[0].x, rawv[0].y, rawv[0].z, rawv[0].w}, w1[4] = {rawv[1].x, rawv[1].y, rawv[1].z, rawv[1].w};
#pragma unroll
            for (int i = 0; i < 4; ++i) { *(LAS unsigned*)(Vt + o64(8 * cv + 2 * i, 2 * (2 * sr2))) = (w0[i] & 0xffffu) | (w1[i] << 16); *(LAS unsigned*)(Vt + o64(8 * cv + 2 * i + 1, 2 * (2 * sr2))) = (w0[i] >> 16) | (w1[i] & 0xffff0000u); }
        }
#if MIX_WARM
        if (!(DIAG & 64)) { asm volatile("" :: "v"(warm));
            int tu = unit, ts = j + 2; if (ts >= GCH) { tu = next_unit; ts -= GCH; }
            if (tu >= 0) warm = hg_warm(PROJ, tu, ts, lane, w, PASS == 1); }
#endif
        MIX_SYNC();
        {
            const int pd = dpos(d);
            float R[2][5], Rq[2], dl[2];
#pragma unroll
            for (int e = 0; e < 2; ++e) { R[e][0] = 0.f;
#pragma unroll
                for (int q = 0; q < 4; ++q) R[e][q + 1] = R[e][q] + (tab[HT_TOT + (2 * q) * 128 + d + e] + tab[HT_TOT + (2 * q + 1) * 128 + d + e]);
                Rq[e] = 0.f;
#pragma unroll
                for (int q = 0; q < 4; ++q) if (q == tq) Rq[e] = R[e][q];
                const float off = (r8 & 1) ? tab[HT_TOT + (r8 - 1) * 128 + d + e] : 0.f;
#pragma unroll
                for (int i = 0; i < 8; ++i) loc[e][i] += off;
                dl[e] = R[e][4] - Rq[e]; }
            if (r8 == 0) { *(LAS f32x2*)(tab + HT_DEC + d) = (f32x2){__expf(R[0][4]), __expf(R[1][4])}; if (PASS == 0) { tab[HT_BTOT + d] += R[0][4]; tab[HT_BTOT + d + 1] += R[1][4]; } }
            float el[2][8], eli[2][8], Fq[2], Fe[2], Ft[2][4];
#pragma unroll
            for (int e = 0; e < 2; ++e) { Fq[e] = __expf(Rq[e]); Fe[e] = __expf(dl[e]);
#pragma unroll
                for (int ti = 0; ti < 4; ++ti) Ft[e][ti] = __expf(fminf(R[e][ti] - Rq[e], 0.f));
#pragma unroll
                for (int i = 0; i < 8; ++i) { el[e][i] = fmaxf(__expf(loc[e][i]), 1.0e-30f); eli[e][i] = mix_rcp(el[e][i]); } }
            if (PASS == 0 || j + 1 < GCH)
#pragma unroll
            for (int e = 0; e < 2; ++e) { float ke[8];
#pragma unroll
                for (int i = 0; i < 8; ++i) ke[i] = kk[e][i] * eli[e][i] * Fe[e];
                v4u q4; q4.x = mix_cvt_pk(ke[0], ke[1]); q4.y = mix_cvt_pk(ke[2], ke[3]); q4.z = mix_cvt_pk(ke[4], ke[5]); q4.w = mix_cvt_pk(ke[6], ke[7]);
                *(LAS v4u*)(Ke + o64(d + e, 2 * (8 * r8))) = q4; }
            if (PASS == 1) {
#pragma unroll
                for (int i = 0; i < 8; ++i) { const int s = 8 * r8 + i, sl = 8 * (r8 & 1) + i;
                    const float qt0 = qq[0][i] * el[0][i], qt1 = qq[1][i] * el[1][i], kb0 = kk[0][i] * eli[0][i], kb1 = kk[1][i] * eli[1][i];
                    *(LAS unsigned*)(Qt + s * RS128 + 2 * pd) = mix_cvt_pk(qt0, qt1);
                    *(LAS unsigned*)(Qh + s * RS128 + 2 * pd) = mix_cvt_pk(qt0 * Fq[0], qt1 * Fq[1]);
#pragma unroll
                    for (int ti = 0; ti < 4; ++ti) if (ti >= tq) *(LAS unsigned*)(Kti + ((ti * (ti + 1) / 2 + tq) * 16 + sl) * RS128 + 2 * pd) = mix_cvt_pk(kb0 * Ft[0][ti], kb1 * Ft[1][ti]); }
            }
        }
        MIX_SYNC();
        bf16x8 Av[2];
#pragma unroll
        for (int ks = 0; ks < 2; ++ks) Av[ks] = ldfrag(Vt + o64(16 * w + c, (32 * ks + 8 * g) * 2));
        if (PASS == 1) {
            int ce = c, ge = g; MIX_LAUNDER(ce); MIX_LAUNDER(ge);
#pragma unroll 1
            for (int tile = w; tile < 10; tile += 8) {
                const int ti = (tile >= 6) ? 3 : (tile >= 3) ? 2 : (tile >= 1) ? 1 : 0, si = tile - ti * (ti + 1) / 2;
                f32x4 acc = (f32x4){0.f, 0.f, 0.f, 0.f};
#pragma unroll
                for (int ks = 0; ks < 4; ++ks) acc = MFMA16(ldfrag(Qt + (16 * ti + c) * RS128 + (32 * ks + 8 * g) * 2), ldfrag(Kti + (tile * 16 + c) * RS128 + (32 * ks + 8 * g) * 2), acc);
#pragma unroll
                for (int r = 0; r < 4; ++r) { const float v = (ti != si || c <= 4 * g + r) ? acc[r] : 0.f; st_bf16(As + (16 * ti + 4 * g + r) * RS64 + 2 * (16 * si + c), v); }
            }
            MIX_SYNC();
            f32x4 acc[4];
#pragma unroll
            for (int tt = 0; tt < 4; ++tt) acc[tt] = (f32x4){0.f, 0.f, 0.f, 0.f};
#pragma unroll
            for (int tt = 0; tt < 4; ++tt)
#pragma unroll
                for (int ks = 0; ks < 2; ++ks) { if (ks == 1 && tt < 2) continue;
                    acc[tt] = MFMA16(Av[ks], ldfrag(As + (16 * tt + c) * RS64 + (32 * ks + 8 * g) * 2), acc[tt]); }
#pragma unroll
            for (int ks = 0; ks < 4; ++ks) { const bf16x8 A0 = pack_pair(Sst[2 * ks], Sst[2 * ks + 1]);
#pragma unroll
                for (int tt = 0; tt < 4; ++tt) acc[tt] = MFMA16(A0, ldfrag(Qh + (16 * tt + c) * RS128 + (32 * ks + 8 * g) * 2), acc[tt]); }
#pragma unroll
            for (int tt = 0; tt < 4; ++tt) { const int t = 16 * tt + ce; float s2 = 0.f;
#pragma unroll
                for (int r = 0; r < 4; ++r) s2 += acc[tt][r] * acc[tt][r];
                s2 += mix_shfl_xor(s2, 16); s2 += mix_shfl_xor(s2, 32);
                if (ge == 0) tab[HT_HNP + w * 64 + t] = s2; }
            MIX_SYNC();
            float rstd4[4];
#pragma unroll
            for (int tt = 0; tt < 4; ++tt) { float pr[8];
#pragma unroll
                for (int ww = 0; ww < 8; ++ww) pr[ww] = tab[HT_HNP + ww * 64 + 16 * tt + ce];
                float a2 = 0.f;
#pragma unroll
                for (int ww = 0; ww < 8; ++ww) a2 += pr[ww];
                rstd4[tt] = mix_rsq(a2 * (1.f / 128.f) + LN_EPS); MIX_CFENCE(); }
            const f32x4 wn = *(const LAS f32x4*)(tab + HT_NW + 16 * w + 4 * ge);
#pragma unroll
            for (int tt = 0; tt < 4; ++tt) { const int t = 16 * tt + ce; const float rstd = rstd4[tt]; const int v0 = 16 * w + 4 * ge;
                const v2u gg = ggv[tt];
                const f32x4 x = acc[tt];
                v2u o; o.x = mix_cvt_pk(x[0] * rstd * wn[0] * MIX_GQ(bflo(gg.x)), x[1] * rstd * wn[1] * MIX_GQ(bfhi(gg.x))); o.y = mix_cvt_pk(x[2] * rstd * wn[2] * MIX_GQ(bflo(gg.y)), x[3] * rstd * wn[3] * MIX_GQ(bfhi(gg.y)));
                if (!(DIAG & 16)) *(v2u*)(YMIX + (m0 + t) * 2048 + 1024 + h * 128 + v0) = o; else asm volatile("" :: "v"(o)); }
        }
        if (PASS == 0 || j + 1 < GCH)
#pragma unroll
        for (int dt = 0; dt < 8; ++dt) { const f32x4 dc = *(const LAS f32x4*)(tab + HT_DEC + 16 * dt + 4 * g);
            f32x4 a = Sst[dt] * dc;
            a = MFMA16(ldfrag(Ke + o64(16 * dt + c, (8 * g) * 2)), Av[0], a); a = MFMA16(ldfrag(Ke + o64(16 * dt + c, (32 + 8 * g) * 2)), Av[1], a); Sst[dt] = a; }
    }
    if (PASS == 0) {
        MIX_SYNC();
        mst_t* gs = MB.GSH + (size_t)unit * 16384;
#pragma unroll
        for (int dt = 0; dt < 8; ++dt) st_st4(gs + (size_t)(16 * w + c) * 128 + 16 * dt + 4 * g, Sst[dt]);
        if (tid < 128) MB.GHD[(size_t)unit * 128 + tid] = tab[HT_BTOT + tid];
    }
#if MIX_WARM
    asm volatile("" :: "v"(warm));
#endif
#undef HG_LOADS
}
MIXDEV void mix_scan(int gt  , MixBuf MB) {
    constexpr int SB = (NGM % 8 == 0) ? 8 : 1, SBH = (NGH % 8 == 0) ? 8 : 1;
    float z0 = 0.f; MIX_LAUNDER(z0);
    if (gt < 65536) {
        const int seq = gt >> 13, e4 = gt & 8191;
        f32x4 run = (f32x4){z0, z0, z0, z0}, nrun = run; float mrun = 0.f;
        const bool don = e4 < 32;
        for (int g0 = 0; g0 < NGM; g0 += SB) {
            f32x4 tmp[SB], tn[SB]; float mg[SB], bt[SB];
#pragma unroll
            for (int k = 0; k < SB; ++k) { const int unit = seq * NGM + g0 + k; tmp[k] = ld_st4(MB.GSM + (size_t)unit * 32768 + 4 * e4); mg[k] = MB.GSS[unit * 4 + 0]; bt[k] = MB.GSS[unit * 4 + 1];
                tn[k] = don ? *((const f32x4*)(MB.GSN + (size_t)unit * 128) + e4) : (f32x4){z0, z0, z0, z0}; }
#pragma unroll
            for (int k = 0; k < SB; ++k) { const int unit = seq * NGM + g0 + k;
                st_st4(MB.GSM + (size_t)unit * 32768 + 4 * e4, run);
                const float mn = fmaxf(bt[k] + mrun, mg[k]), sa = __expf(bt[k] + mrun - mn), sg = __expf(mg[k] - mn);
                run = run * sa + tmp[k] * sg;
                if (don) { *((f32x4*)(MB.GSN + (size_t)unit * 128) + e4) = nrun; nrun = nrun * sa + tn[k] * sg; }
                if (e4 == 0) MB.GSS[unit * 4 + 2] = mrun;
                mrun = mn; }
        }
    } else {
        const int q = gt - 65536, seq = q >> 12, e4 = q & 4095, d4 = e4 & 31;
        f32x4 run = (f32x4){z0, z0, z0, z0};
        for (int g0 = 0; g0 < NGH; g0 += SBH) {
            f32x4 tmp[SBH], ld[SBH];
#pragma unroll
            for (int k = 0; k < SBH; ++k) { const int unit = seq * NGH + g0 + k; tmp[k] = ld_st4(MB.GSH + (size_t)unit * 16384 + 4 * e4); ld[k] = *((const f32x4*)(MB.GHD + (size_t)unit * 128) + d4); }
#pragma unroll
            for (int k = 0; k < SBH; ++k) { const int unit = seq * NGH + g0 + k;
                st_st4(MB.GSH + (size_t)unit * 16384 + 4 * e4, run);
                run[0] = run[0] * __expf(ld[k][0]) + tmp[k][0]; run[1] = run[1] * __expf(ld[k][1]) + tmp[k][1]; run[2] = run[2] * __expf(ld[k][2]) + tmp[k][2]; run[3] = run[3] * __expf(ld[k][3]) + tmp[k][3]; }
        }
    }
}
constexpr int NPL = 9, NPH = 2 + NPL * DEPTH;
struct Args { const float* in[20]; float* out; unsigned char* ws; int ph_lo, ph_hi; };
__global__ void __launch_bounds__(NTHR, 2) fwd(Args args) {
    extern __shared__ __attribute__((aligned(16))) unsigned char lds_raw[];
    LAS unsigned char* lds = (LAS unsigned char*)lds_raw;
    const int tid0 = threadIdx.x, G = gridDim.x;
#if CODE_SHIFT_NOPS > 0
    asm volatile(".fill " CODE_SHIFT_STR ", 4, 0xBF800000");
#endif
    int wave0 = __builtin_amdgcn_readfirstlane(tid0 >> 6); asm volatile("" : "+s"(wave0));
#define PHASE_IDS() int tid; asm volatile("v_mbcnt_lo_u32_b32 %0, -1, 0\n\tv_mbcnt_hi_u32_b32 %0, -1, %0" : "=v"(tid)); tid |= (wave0 << 6); asm volatile("" : "+v"(tid));     const int lane = tid & 63, wave = __builtin_amdgcn_readfirstlane(tid >> 6); (void)lane; (void)wave
    Ptrs P;
    P.x = args.in[0]; P.c = args.in[1]; P.w_mod = args.in[2]; P.b_mod = args.in[3]; P.w_in = args.in[4]; P.conv_w = args.in[5]; P.conv_b = args.in[6]; P.b_ig = args.in[7]; P.b_fg = args.in[8];
    P.mnorm_w = args.in[9]; P.hnorm_w = args.in[10]; P.lb_logits = args.in[11]; P.w_out = args.in[12]; P.ln1_g = args.in[13]; P.ln1_b = args.in[14]; P.w_gate = args.in[15]; P.w_up = args.in[16];
    P.w_down = args.in[17]; P.ln2_g = args.in[18]; P.ln2_b = args.in[19]; P.out = args.out; P.ws = args.ws;
    volatile LAS unsigned* MISC = (volatile LAS unsigned*)(lds + MISC_OFF);
    if (tid0 < 32) MISC[tid0] = 0u;
    __syncthreads();
#if MK_ONE_LAUNCH
    XcdBarrier bar = xcd_barrier_post((unsigned*)(P.ws + WS_CTL) + CW_BAR, MISC + 8);
#define SEAM() xcd_barrier(bar)
#else
#define SEAM() do { } while (0)
#endif
    const int lo = args.ph_lo, hi = args.ph_hi;
#define IN(k) (lo <= (k) && (k) < hi)
#if XCD_AFFINE
#define MIX_UM(v_) ((G == 256 && NGM == 32) ? ((((v_) & 7) >> 2) * (4 * NGM) + ((v_) >> 6) * NGM + ((v_) & 3) * 8 + (((v_) >> 3) & 7)) : (v_))
#define MIX_UH(v_) ((G == 256 && NGH == 32) ? ((((v_) & 7) >> 2) * (8 * NGH) + ((((v_) >> 6) & 3) + 4 * ((v_) >> 8)) * NGH + ((v_) & 3) * 8 + (((v_) >> 3) & 7)) : (v_))
#else
#define MIX_UM(v_) (v_)
#define MIX_UH(v_) (v_)
#endif
#define GEMM_SKEW() do { if (GEMM_SKEW_TICKS > 0) { const unsigned long long t0_ = __builtin_amdgcn_s_memrealtime(), dl_ = (unsigned long long)(blockIdx.x & 7) * GEMM_SKEW_TICKS; while (__builtin_amdgcn_s_memrealtime() - t0_ < dl_) __builtin_amdgcn_s_sleep(2); } } while (0)
#if PROBE_MASK_A || PROBE_MASK_R
    unsigned* TSW = (unsigned*)(P.ws + WS_CTL) + 2048;
    unsigned long long* TS64 = (unsigned long long*)(TSW + 32);
    if (blockIdx.x == 0 && tid0 == 0) { TS64[0] = __builtin_amdgcn_s_memrealtime(); TS64[1] = __builtin_amdgcn_s_memtime(); TS64[2] = TS64[0]; }
#define PROBE_TICK(k) do { if (blockIdx.x == 0 && tid0 == 0) { const unsigned long long now_ = __builtin_amdgcn_s_memrealtime(); const int ty_ = ((k) == 0) ? 0 : 1 + ((k) - 1) % NPL; \
        __hip_atomic_store(TSW + ty_, __hip_atomic_load(TSW + ty_, __ATOMIC_RELAXED, __HIP_MEMORY_SCOPE_AGENT) + (unsigned)(now_ - TS64[0]), __ATOMIC_RELAXED, __HIP_MEMORY_SCOPE_AGENT); TS64[0] = now_; } } while (0)
#else
#define PROBE_TICK(k) do { } while (0)
#endif
#define SEAM_AFTER(k) do { if ((k) + 1 < hi) { SEAM(); PROBE_TICK(k); } } while (0)
    float* MOD = (float*)(P.ws + WS_MOD); bf16* X = (bf16*)(P.ws + WS_X); bf16* U = (bf16*)(P.ws + WS_U); bf16* YMIX = (bf16*)(P.ws + WS_YMIX); bf16* PROJ = (bf16*)(P.ws + WS_PROJ); bf16* HB = (bf16*)(P.ws + WS_PROJ);
    float* GT = (float*)(P.ws + WS_GATES); bf16* YB = (bf16*)(P.ws + WS_YB);
    MixBuf MB; MB.GSM = (mst_t*)(P.ws + WS_GSM); MB.GSN = (float*)(P.ws + WS_GSN); MB.GSS = (float*)(P.ws + WS_GSS); MB.GSH = (mst_t*)(P.ws + WS_GSH); MB.GHD = (float*)(P.ws + WS_GHD);

#ifndef SKIP_PRO
    if (IN(0)) { PHASE_IDS(); phase_prologue(P, lds, tid, lane, wave, G);
#if DUP_MASK & 1
        __syncthreads(); phase_prologue(P, lds, tid, lane, wave, G);
#endif
        SEAM_AFTER(0); }
#endif

    for (int l = 0; l < DEPTH; ++l) {
        const int base = 1 + NPL * l;
        if (base + NPL <= lo || base >= hi) continue;
#if DUP_MASK & 32768
        for (int xb_ = 0; xb_ < 10; ++xb_) { SEAM(); }
#endif
        const float* modl = MOD + (size_t)l * 2 * NMODC;
#ifndef SKIP_P0
        if (IN(base + 0)) {
            PHASE_IDS();
            const float* gwl = (const float*)(P.ws + WS_GW) + (size_t)l * 8 * D;
            if (l == 0) phase_rows<false, true, true, false, true>(lds, tid, lane, wave, G, P.x, nullptr, X, nullptr, nullptr, U, modl + 1 * D, modl + 0 * D, gwl, P.b_ig + l * 4, P.b_fg + l * 4, GT);
            else        phase_rows<true, true, true, true, true>(lds, tid, lane, wave, G, X, YB, X, P.ln2_g + (l - 1) * D, P.ln2_b + (l - 1) * D, U, modl + 1 * D, modl + 0 * D, gwl, P.b_ig + l * 4, P.b_fg + l * 4, GT);
            SEAM_AFTER(base + 0);
        }
#endif
#ifndef SKIP_P1
        if (IN(base + 1)) {
            PHASE_IDS();
            GEMM_SKEW();
            pg8::Gemm g{U, (const bf16*)(P.ws + WS_WIN) + (size_t)l * NPROJ * D, M, NPROJ, D}; pg8::StaticOrder S; S.init(M, NPROJ, G, (int)blockIdx.x, GIN_CMAP);
            pg8::EpiProj E{PROJ, NPROJ, (size_t)M * 128};
            pg8::gemm_phase<pg8::EpiProj, pg8::StaticOrder, GEMM_ALIGN, GEMM_SP2>(lds, g, S, E, tid);
#if DUP_MASK & 2
            __syncthreads(); pg8::gemm_phase<pg8::EpiProj, pg8::StaticOrder, GEMM_ALIGN, GEMM_SP2>(lds, g, S, E, tid);
#endif
#if DUP_MASK & 256
            { __syncthreads(); struct FixedOrder { int n; __device__ bool next(int i, pg8::Unit& u) const { u.pm = 0; u.pn = 0; return i < n; } __device__ void a_ready(const pg8::Unit&) const {} __device__ void done(const pg8::Unit&) const {} } S0{7};
              pg8::EpiNull E0{(bf16*)(P.ws + WS_HRAW) + (size_t)blockIdx.x * 65536, 0}; pg8::gemm_phase<pg8::EpiNull, FixedOrder, true, true>(lds, g, S0, E0, tid); }
#endif
#if DUP_MASK & 64
            { __syncthreads(); pg8::EpiNull E0{(DUP_MASK & 65536) ? (bf16*)(P.ws + WS_HRAW) : (bf16*)(P.ws + WS_HRAW) + (size_t)blockIdx.x * 65536, (DUP_MASK & 65536) ? 3 : (DUP_MASK & 512) ? 2 : (DUP_MASK & 128) ? 1 : 0}; pg8::gemm_phase<pg8::EpiNull, pg8::StaticOrder, true, true>(lds, g, S, E0, tid); }
#endif
            SEAM_AFTER(base + 1);
        }
#endif
#if DUP_MASK & 4
        for (int rep_ = 0; rep_ < 2; ++rep_) {
        if (rep_ == 1) { SEAM(); }
#endif
#ifndef SKIP_P2
        if (IN(base + 2)) {
            PHASE_IDS();
#if DUP_MASK & 16
            for (int rep2_ = 0; rep2_ < 2; ++rep2_) {
#endif
#if MIX_ORDER
            for (int uh = (int)blockIdx.x; uh < 2 * 8 * NGH; uh += G) hgrn_unit<0>(lds, tid, lane, wave, MIX_UH(uh), PROJ, (const float*)(P.ws + WS_LB) + l * 1024, P.hnorm_w + l * 1024, MB, YMIX, (uh + G < 2 * 8 * NGH) ? MIX_UH(uh + G) : -1);
            for (int um = (int)blockIdx.x; um < 2 * 4 * NGM; um += G) mlstm_unit<0>(lds, tid, lane, wave, MIX_UM(um), PROJ, GT, P.conv_w + (size_t)l * 4 * 1024, P.conv_b + (size_t)l * 1024, P.mnorm_w + l * 1024, MB, YMIX);
#else
            for (int um = (int)blockIdx.x; um < 2 * 4 * NGM; um += G) mlstm_unit<0>(lds, tid, lane, wave, MIX_UM(um), PROJ, GT, P.conv_w + (size_t)l * 4 * 1024, P.conv_b + (size_t)l * 1024, P.mnorm_w + l * 1024, MB, YMIX);
            for (int uh = (int)blockIdx.x; uh < 2 * 8 * NGH; uh += G) hgrn_unit<0>(lds, tid, lane, wave, MIX_UH(uh), PROJ, (const float*)(P.ws + WS_LB) + l * 1024, P.hnorm_w + l * 1024, MB, YMIX, (uh + G < 2 * 8 * NGH) ? MIX_UH(uh + G) : -1);
#endif
#if DUP_MASK & 16
            }
#endif
            SEAM_AFTER(base + 2);
        }
#endif
#ifndef SKIP_P3
        if (IN(base + 3)) {
            PHASE_IDS();
#ifdef MIXH
            for (int uh = (int)blockIdx.x; uh < 2 * 8 * NGH; uh += G) hgrn_unit<1, MIXH>(lds, tid, lane, wave, MIX_UH(uh), PROJ, (const float*)(P.ws + WS_LB) + l * 1024, P.hnorm_w + l * 1024, MB, YMIX);
#endif
            for (int gt = (int)blockIdx.x * NTHR + tid; gt < 131072; gt += G * NTHR) mix_scan(gt, MB);
            SEAM_AFTER(base + 3);
        }
#endif
#ifndef SKIP_PC
        if (IN(base + 4)) {
            PHASE_IDS();
#if DUP_MASK & 32
            for (int rep3_ = 0; rep3_ < 2; ++rep3_) {
#endif
#if DUP_MASK & 1024
            for (int rep4_ = 0; rep4_ < 2; ++rep4_)
#endif
#ifdef MIXD
            for (int um = (int)blockIdx.x; um < 2 * 4 * NGM; um += G) mlstm_unit<1, MIXD>(lds, tid, lane, wave, MIX_UM(um), PROJ, GT, P.conv_w + (size_t)l * 4 * 1024, P.conv_b + (size_t)l * 1024, P.mnorm_w + l * 1024, MB, YMIX);
#endif
#ifndef SKIP_PCM
            for (int um = (int)blockIdx.x; um < 2 * 4 * NGM; um += G) mlstm_unit<1>(lds, tid, lane, wave, MIX_UM(um), PROJ, GT, P.conv_w + (size_t)l * 4 * 1024, P.conv_b + (size_t)l * 1024, P.mnorm_w + l * 1024, MB, YMIX);
#endif
#if DUP_MASK & 2048
            for (int rep5_ = 0; rep5_ < 2; ++rep5_)
#endif
#ifndef SKIP_PCH
#if MIX_ORDER
            for (int uh = (int)blockIdx.x + ((2 * 8 * NGH - 1 - (int)blockIdx.x) / G) * G; uh >= 0; uh -= G) hgrn_unit<1>(lds, tid, lane, wave, MIX_UH(uh), PROJ, (const float*)(P.ws + WS_LB) + l * 1024, P.hnorm_w + l * 1024, MB, YMIX, (uh - G >= 0) ? MIX_UH(uh - G) : -1);
#else
            for (int uh = (int)blockIdx.x; uh < 2 * 8 * NGH; uh += G) hgrn_unit<1>(lds, tid, lane, wave, MIX_UH(uh), PROJ, (const float*)(P.ws + WS_LB) + l * 1024, P.hnorm_w + l * 1024, MB, YMIX, (uh + G < 2 * 8 * NGH) ? MIX_UH(uh + G) : -1);
#endif
#endif
#if DUP_MASK & 32
            }
#endif
            SEAM_AFTER(base + 4);
        }
#endif
#if DUP_MASK & 4
        }
#endif
#ifndef SKIP_P4
        if (IN(base + 5)) {
            PHASE_IDS();
            GEMM_SKEW();
            pg8::Gemm g{YMIX, (const bf16*)(P.ws + WS_WOUT) + (size_t)l * D * D, M, D, D}; pg8::StaticOrder S; S.init(M, D, G, (int)blockIdx.x);
            pg8::EpiYb E{YB, D, modl + 2 * D, modl + NMODC + 2 * D};
            pg8::gemm_phase<pg8::EpiYb, pg8::StaticOrder, GEMM_ALIGN, GEMM_SP2>(lds, g, S, E, tid);
#if DUP_MASK & 8192
            __syncthreads(); pg8::gemm_phase<pg8::EpiYb, pg8::StaticOrder, GEMM_ALIGN, GEMM_SP2>(lds, g, S, E, tid);
#endif
            SEAM_AFTER(base + 5);
        }
#endif
#ifndef SKIP_P5
        if (IN(base + 6)) {
            PHASE_IDS();
            phase_rows<true, true, false, true, true>(lds, tid, lane, wave, G, X, YB, X, P.ln1_g + l * D, P.ln1_b + l * D, U, modl + 4 * D, modl + 3 * D, nullptr, nullptr, nullptr, nullptr);
            SEAM_AFTER(base + 6);
        }
#endif
#ifndef SKIP_P6
        if (IN(base + 7)) {
            PHASE_IDS();
            GEMM_SKEW();
            pg8::Gemm g{U, (const bf16*)(P.ws + WS_WGU) + (size_t)l * NGU * D, M, NGU, D}; pg8::StaticOrder S; S.init(M, NGU, G, (int)blockIdx.x);
            pg8::EpiSwiGLU E{HB, FF};
            pg8::gemm_phase<pg8::EpiSwiGLU, pg8::StaticOrder, GEMM_ALIGN_GU, GEMM_SP2>(lds, g, S, E, tid);
#if DUP_MASK & 8
            __syncthreads(); pg8::gemm_phase<pg8::EpiSwiGLU, pg8::StaticOrder, GEMM_ALIGN, GEMM_SP2>(lds, g, S, E, tid);
#endif
            SEAM_AFTER(base + 7);
        }
#endif
#ifndef SKIP_P7
        if (IN(base + 8)) {
            PHASE_IDS();
            GEMM_SKEW();
            pg8::Gemm g{HB, (const bf16*)(P.ws + WS_WDN) + (size_t)l * D * FF, M, D, FF}; pg8::StaticOrder S; S.init(M, D, G, (int)blockIdx.x);
            pg8::EpiYb E{YB, D, modl + 5 * D, modl + NMODC + 5 * D};
            pg8::gemm_phase<pg8::EpiYb, pg8::StaticOrder, GEMM_ALIGN, GEMM_SP2>(lds, g, S, E, tid);
#if DUP_MASK & 16384
            __syncthreads(); pg8::gemm_phase<pg8::EpiYb, pg8::StaticOrder, GEMM_ALIGN, GEMM_SP2>(lds, g, S, E, tid);
#endif
            SEAM_AFTER(base + 8);
        }
#endif
    }
#if PROBE_MASK_A || PROBE_MASK_R
    float probe_c = 0.f, probe_a = 0.f;
    if (IN(NPH - 1)) { SEAM();
        for (int ty = 0; ty < 1 + NPL; ++ty) { const float tk = (float)__hip_atomic_load(TSW + ty, __ATOMIC_RELAXED, __HIP_MEMORY_SCOPE_AGENT);
            if ((PROBE_MASK_R >> ty) & 1) probe_c += tk * 1e-5f; if ((PROBE_MASK_A >> ty) & 1) probe_a += tk * 1e-3f; } }
#endif
    if (IN(NPH - 1)) { PHASE_IDS(); phase_rows<true, false, false, true, false>(lds, tid, lane, wave, G, X, YB, P.out, P.ln2_g + (DEPTH - 1) * D, P.ln2_b + (DEPTH - 1) * D, nullptr, nullptr, nullptr, nullptr, nullptr, nullptr, nullptr);
#if PROBE_MASK_A || PROBE_MASK_R
        __syncthreads();
        for (int m = (int)blockIdx.x * NWAVES + wave; m < M; m += G * NWAVES) for (int jj = lane; jj < D; jj += 64) P.out[(size_t)m * D + jj] += probe_c;
        __syncthreads();
        if (PROBE_MASK_A & 0x10000) { float ghz = 0.f; if (blockIdx.x == 0 && tid == 0) ghz = (float)(__builtin_amdgcn_s_memtime() - TS64[1]) / (float)(__builtin_amdgcn_s_memrealtime() - TS64[2]) * 0.1f; probe_a = floorf(ghz * 10.f + 0.5f) * 10.f; }
        if (blockIdx.x == 0 && tid == 0 && PROBE_MASK_A) P.out[0] = probe_a;
#endif
    }
#undef IN
#undef SEAM_AFTER
#undef SEAM
}
extern "C" void kernel_launch(void* const* d_in, const int* in_sizes, int n_in, void* d_out, int out_size, void* d_ws, size_t ws_size, hipStream_t stream) {
    static int grid = 0;
    if (grid == 0) {
        if (n_in != 20 || out_size != M * D || ws_size < WS_END) { fprintf(stderr, "kernel_launch: unexpected problem (n_in %d, out %d, ws %zu < %zu)\n", n_in, out_size, ws_size, (size_t)WS_END); grid = -1; return; }
        int dev = 0, cus = 0;
        if (hipGetDevice(&dev) != hipSuccess || hipDeviceGetAttribute(&cus, hipDeviceAttributeMultiprocessorCount, dev) != hipSuccess) { grid = -1; return; }
        if (hipFuncSetAttribute((const void*)fwd, hipFuncAttributeMaxDynamicSharedMemorySize, LDS_BYTES) != hipSuccess) { fprintf(stderr, "kernel_launch: hipFuncSetAttribute failed\n"); grid = -1; return; }
        int per_cu = 0; (void)hipOccupancyMaxActiveBlocksPerMultiprocessor(&per_cu, (const void*)fwd, NTHR, LDS_BYTES); (void)hipGetLastError();
        if (per_cu < 1) fprintf(stderr, "kernel_launch: occupancy query reports %d workgroups per CU\n", per_cu);
        grid = cus;
    }
    if (grid < 0) return;
    (void)hipMemsetAsync((char*)d_ws + WS_CTL, 0, CTL_ZERO_BYTES, stream);
    Args a{};
    for (int i = 0; i < 20; ++i) a.in[i] = (const float*)d_in[i];
    a.out = (float*)d_out; a.ws = (unsigned char*)d_ws;
#if MK_ONE_LAUNCH
    a.ph_lo = 0; a.ph_hi = NPH;
    hipLaunchKernelGGL(fwd, dim3(grid), dim3(NTHR), LDS_BYTES, stream, a);
#else
    for (int p = 0; p < NPH; ++p) { a.ph_lo = p; a.ph_hi = p + 1; hipLaunchKernelGGL(fwd, dim3(grid), dim3(NTHR), LDS_BYTES, stream, a); }
#endif
}
```

```cpp
#include <hip/hip_runtime.h>
#include <cstdio>
#include <cstdint>
#ifndef MK_ONE_LAUNCH
#define MK_ONE_LAUNCH 1
#endif
#ifndef PROBE_MASK_A
#define PROBE_MASK_A 0
#endif
#ifndef PROBE_MASK_R
#define PROBE_MASK_R 0
#endif
#ifndef DUP_MASK
#define DUP_MASK 0
#endif
#ifndef GEMM_ALIGN
#define GEMM_ALIGN true
#endif
#ifndef GEMM_SKEW_TICKS
#define GEMM_SKEW_TICKS 0
#endif
#ifndef XCD_AFFINE
#define XCD_AFFINE 0
#endif
#ifndef PROJ_BLOCKED
#define PROJ_BLOCKED 1
#endif
#ifndef MIX_ORDER
#define MIX_ORDER 1
#endif
#ifndef GIN_CMAP
#define GIN_CMAP 0x5410632u
#endif
#ifndef GEMM_SP2
#define GEMM_SP2 true
#endif
#ifndef GEMM_ALIGN_GU
#define GEMM_ALIGN_GU true
#endif
#ifndef CODE_SHIFT_NOPS
#define CODE_SHIFT_NOPS 0
#endif
#define CODE_SHIFT_STR_(x) #x
#define CODE_SHIFT_STR__(x) CODE_SHIFT_STR_(x)
#define CODE_SHIFT_STR CODE_SHIFT_STR__(CODE_SHIFT_NOPS)
#ifndef KLOOP_P2ALIGN
#define KLOOP_P2ALIGN 0
#endif
#define KLOOP_P2ALIGN_STR CODE_SHIFT_STR__(KLOOP_P2ALIGN)
namespace pg8 {
#define PG8_LAS __attribute__((address_space(3)))
typedef unsigned short bf16_t;
typedef short bf16x8 __attribute__((ext_vector_type(8)));
typedef float f32x4 __attribute__((ext_vector_type(4)));
typedef unsigned u32x4 __attribute__((ext_vector_type(4)));
constexpr int BM = 256, BK = 64, HALF = 128, HTB = HALF * BK * 2  , STAGE_BYTES = 8 * HTB, NXCD = 8, WGM = 8;

__host__ __device__ __forceinline__ int lds_byte(int r, int c) { const int st = (r >> 4) * 2 + (c >> 5), rr = r & 15, cc = c & 31, ob = rr * 64 + cc * 2; return st * 1024 + (ob ^ (((ob >> 9) & 1) << 5)); }
__host__ __device__ __forceinline__ void stage_rc(int b, int& R, int& C) { const int st = b / 1024, sb = b % 1024, swz = sb ^ (((sb >> 9) & 1) << 5); R = (st >> 1) * 16 + swz / 64; C = (st & 1) * 32 + (swz % 64) / 2; }
__host__ __device__ __forceinline__ int perm32(int rho) { const int n = rho >> 4, i = rho & 15; return 8 * (i >> 2) + 4 * n + (i & 3); }

struct Unit { int pm, pn; };
struct Gemm { const bf16_t* A; const bf16_t* Bt; int M, N, K; };

struct StaticOrder {
    int nM, nN, nwg, G, c; unsigned cmap;
    __host__ __device__ void init(int M, int N, int G_, int c_, unsigned cmap_ = 0u) { nM = M / BM; nN = N / BM; nwg = nM * nN; G = G_; c = c_; cmap = cmap_; }
    __host__ __device__ bool next(int i, Unit& u) const {
        const long L = (long)i * G + c; if (L >= nwg) return false;
        int wgid = (int)L; { const int q = nwg / NXCD, r = nwg % NXCD, xcd = wgid % NXCD, off = wgid / NXCD; wgid = (xcd < r ? xcd * (q + 1) : r * (q + 1) + (xcd - r) * q) + off; }
        const int nig = WGM * nN, gid = wgid / nig, fm = gid * WGM, gsz = (nM - fm) < WGM ? (nM - fm) : WGM;
        u.pm = fm + ((wgid % nig) % gsz); u.pn = (wgid % nig) / gsz; if (cmap) u.pn = (int)((cmap >> (4 * (u.pn >> 2))) & 15u) * 4 + (u.pn & 3); return true;
    }
    __device__ __forceinline__ void a_ready(const Unit&) const {}
    __device__ __forceinline__ void done(const Unit&) const {}
};

__device__ __forceinline__ unsigned cvt_pk_bf16(float lo, float hi) { typedef __bf16 b2_t __attribute__((ext_vector_type(2))); typedef float f2_t __attribute__((ext_vector_type(2))); const b2_t r = __builtin_convertvector((f2_t){lo, hi}, b2_t); return __builtin_bit_cast(unsigned, r); }
typedef float f32x2 __attribute__((ext_vector_type(2)));
#ifndef EPI_NT
#define EPI_NT 0
#endif
#ifndef EPI_SC1
#define EPI_SC1 0
#endif
#if EPI_SC1
#define EPI_STORE16(p, v) asm volatile("global_store_dwordx4 %0, %1, off sc1\n\ts_nop 1" :: "v"(p), "v"(v) : "memory")
#elif EPI_NT
#define EPI_STORE16(p, v) __builtin_nontemporal_store((v), (p))
#else
#define EPI_STORE16(p, v) (*(p) = (v))
#endif
__device__ __forceinline__ float fast_silu(float x) { return x * __builtin_amdgcn_rcpf(1.0f + __expf(-x)); }
#ifndef EPI_PREACT
#define EPI_PREACT 1
#endif
struct EpiProj {
    static constexpr bool PERM = true, AFTER_DRAIN = false; static constexpr int NSTORE = 0;
    bf16_t* O; int ldc; size_t blk;
    __device__ __forceinline__ void operator()(const f32x4 (&acc)[2][2][4][2], const Unit& u, int wr, int wc, int fr, int fq) const {
        const int row0 = u.pm * BM + wr * 64 + fr, col0 = u.pn * BM + wc * 32 + 8 * fq;
        const int seg = u.pn >> 2, act = EPI_PREACT ? ((seg == 2) ? 1 : (seg == 3 || seg == 6) ? 2 : 0) : 0;
#pragma unroll
        for (int ai = 0; ai < 2; ++ai)
#pragma unroll
            for (int m = 0; m < 4; ++m) { bf16_t* rowp = PROJ_BLOCKED ? O + (size_t)(2 * u.pn) * blk + (size_t)(row0 + ai * HALF + m * 16) * 128 + (wc * 32 + 8 * fq) : O + (size_t)(row0 + ai * HALF + m * 16) * ldc + col0;
#pragma unroll
                for (int bj = 0; bj < 2; ++bj) { f32x4 v0 = acc[ai][bj][m][0], v1 = acc[ai][bj][m][1];
                    if (act == 1) {
#pragma unroll
                        for (int j = 0; j < 4; ++j) { v0[j] = __builtin_amdgcn_rcpf(1.0f + __expf(-v0[j])); v1[j] = __builtin_amdgcn_rcpf(1.0f + __expf(-v1[j])); } }
                    else if (act == 2) {
#pragma unroll
                        for (int j = 0; j < 4; ++j) { v0[j] = fast_silu(v0[j]); v1[j] = fast_silu(v1[j]); } }
                    u32x4 w; w.x = cvt_pk_bf16(v0[0], v0[1]); w.y = cvt_pk_bf16(v0[2], v0[3]); w.z = cvt_pk_bf16(v1[0], v1[1]); w.w = cvt_pk_bf16(v1[2], v1[3]);
                    EPI_STORE16((u32x4*)(rowp + (PROJ_BLOCKED ? (size_t)bj * blk : (size_t)(bj * HALF))), w); } }
    }
};
struct EpiResid {
    static constexpr bool PERM = false, AFTER_DRAIN = false; static constexpr int NSTORE = 0;
    float* X; int ldc; const float* g0; const float* g1; float alpha; float* Xout;
    __device__ __forceinline__ void operator()(const f32x4 (&acc)[2][2][4][2], const Unit& u, int wr, int wc, int fr, int fq) const {
        const int row0 = u.pm * BM + wr * 64 + fr, col0 = u.pn * BM + wc * 32 + 4 * fq;
        const float* g = (u.pm >= 32) ? g1 : g0;
        f32x4 gv[2][2];
#pragma unroll
        for (int bj = 0; bj < 2; ++bj)
#pragma unroll
            for (int n = 0; n < 2; ++n) gv[bj][n] = *(const f32x4*)(g + col0 + bj * HALF + n * 16) + 1.0f;
#pragma unroll
        for (int ai = 0; ai < 2; ++ai)
#pragma unroll
            for (int m = 0; m < 4; ++m) { const size_t ro = (size_t)(row0 + ai * HALF + m * 16) * ldc + col0; const float* rowp = X + ro; float* rowo = Xout + ro;
#pragma unroll
                for (int bj = 0; bj < 2; ++bj)
#pragma unroll
                    for (int n = 0; n < 2; ++n) { const f32x4 xo = *(const f32x4*)(rowp + bj * HALF + n * 16); *(f32x4*)(rowo + bj * HALF + n * 16) = xo * alpha + gv[bj][n] * acc[ai][bj][m][n]; }
                asm volatile("" ::: "memory"); }
    }
};
struct EpiSwiGLU {
    static constexpr bool PERM = true, AFTER_DRAIN = false; static constexpr int NSTORE = 0;
    bf16_t* O; int ldc;
    __device__ __forceinline__ void operator()(const f32x4 (&acc)[2][2][4][2], const Unit& u, int wr, int wc, int fr, int fq) const {
        const int row0 = u.pm * BM + wr * 64 + fr, col0 = u.pn * HALF + wc * 32 + 8 * fq;
#pragma unroll
        for (int ai = 0; ai < 2; ++ai)
#pragma unroll
            for (int m = 0; m < 4; ++m) { bf16_t* rowp = O + (size_t)(row0 + ai * HALF + m * 16) * ldc + col0;
                const f32x4 g0 = acc[ai][0][m][0], g1 = acc[ai][0][m][1], u0 = acc[ai][1][m][0], u1 = acc[ai][1][m][1];
                f32x4 h0, h1;
#pragma unroll
                for (int j = 0; j < 4; ++j) { h0[j] = fast_silu(g0[j]) * u0[j]; h1[j] = fast_silu(g1[j]) * u1[j]; }
                u32x4 w; w.x = cvt_pk_bf16(h0[0], h0[1]); w.y = cvt_pk_bf16(h0[2], h0[3]); w.z = cvt_pk_bf16(h1[0], h1[1]); w.w = cvt_pk_bf16(h1[2], h1[3]);
                EPI_STORE16((u32x4*)rowp, w); }
    }
};
struct EpiNull {
    static constexpr bool PERM = true, AFTER_DRAIN = false; static constexpr int NSTORE = 0;
    bf16_t* O; int mode;
    __device__ __forceinline__ void operator()(const f32x4 (&acc)[2][2][4][2], const Unit& u, int wr, int wc, int fr, int fq) const {
        const int row0 = wr * 64 + fr, col0 = wc * 32 + 8 * fq;
        bf16_t* Ob = O + ((mode == 3) ? (size_t)(u.pm * 28 + u.pn) * 65536 : (size_t)0);
#pragma unroll
        for (int ai = 0; ai < 2; ++ai)
#pragma unroll
            for (int m = 0; m < 4; ++m) { bf16_t* rowp = Ob + (size_t)((mode == 2) ? (row0 & 15) : (row0 + ai * HALF + m * 16)) * 256 + col0;
#pragma unroll
                for (int bj = 0; bj < 2; ++bj) { const f32x4 v0 = acc[ai][bj][m][0], v1 = acc[ai][bj][m][1];
                    u32x4 w; w.x = cvt_pk_bf16(v0[0], v0[1]); w.y = cvt_pk_bf16(v0[2], v0[3]); w.z = cvt_pk_bf16(v1[0], v1[1]); w.w = cvt_pk_bf16(v1[2], v1[3]);
                    if (mode == 4) *(u32x4*)(O + (size_t)(u.pm * 28 + u.pn) * 65536 + (size_t)((((wr * 4 + wc) * 2 + ai) * 4 + m) * 2 + bj) * 512 + (fr * 4 + fq) * 8) = w;
                    else if (mode) *(u32x4*)(rowp + bj * HALF) = w; else asm volatile("" :: "v"(w)); } }
    }
};
struct EpiYb {
    static constexpr bool PERM = true, AFTER_DRAIN = false; static constexpr int NSTORE = 0;
    bf16_t* O; int ldc; const float* g0; const float* g1;
    __device__ __forceinline__ void operator()(const f32x4 (&acc)[2][2][4][2], const Unit& u, int wr, int wc, int fr, int fq) const {
        const int row0 = u.pm * BM + wr * 64 + fr, col0 = u.pn * BM + wc * 32 + 8 * fq;
        const float* g = (u.pm >= 32) ? g1 : g0;
        f32x4 gv[2][2];
#pragma unroll
        for (int bj = 0; bj < 2; ++bj)
#pragma unroll
            for (int n = 0; n < 2; ++n) gv[bj][n] = *(const f32x4*)(g + col0 + bj * HALF + 4 * n) + 1.0f;
#pragma unroll
        for (int ai = 0; ai < 2; ++ai)
#pragma unroll
            for (int m = 0; m < 4; ++m) { bf16_t* rowp = O + (size_t)(row0 + ai * HALF + m * 16) * ldc + col0;
#pragma unroll
                for (int bj = 0; bj < 2; ++bj) { const f32x4 v0 = acc[ai][bj][m][0] * gv[bj][0], v1 = acc[ai][bj][m][1] * gv[bj][1];
                    u32x4 w; w.x = cvt_pk_bf16(v0[0], v0[1]); w.y = cvt_pk_bf16(v0[2], v0[3]); w.z = cvt_pk_bf16(v1[0], v1[1]); w.w = cvt_pk_bf16(v1[2], v1[3]);
                    EPI_STORE16((u32x4*)(rowp + bj * HALF), w); } }
    }
};
struct EpiLin {
    static constexpr bool PERM = true, AFTER_DRAIN = false; static constexpr int NSTORE = 0;
    bf16_t* O;
    __device__ __forceinline__ void operator()(const f32x4 (&acc)[2][2][4][2], const Unit& u, int wr, int wc, int fr, int fq) const {
        bf16_t* base = O + (size_t)(u.pm * 28 + u.pn) * 65536 + (size_t)(wr * 4 + wc) * 8192 + (fr * 4 + fq) * 8;
#pragma unroll
        for (int ai = 0; ai < 2; ++ai)
#pragma unroll
            for (int m = 0; m < 4; ++m)
#pragma unroll
                for (int bj = 0; bj < 2; ++bj) { const f32x4 v0 = acc[ai][bj][m][0], v1 = acc[ai][bj][m][1];
                    u32x4 w; w.x = cvt_pk_bf16(v0[0], v0[1]); w.y = cvt_pk_bf16(v0[2], v0[3]); w.z = cvt_pk_bf16(v1[0], v1[1]); w.w = cvt_pk_bf16(v1[2], v1[3]);
                    *(u32x4*)(base + ((ai * 4 + m) * 2 + bj) * 512) = w; }
    }
};
template <class Epi, class Sched, bool ALIGN_EPI = false, bool SP2 = false>
__device__ __forceinline__ void gemm_phase(PG8_LAS unsigned char* lds, const Gemm g, const Sched& S, const Epi& E, int tid_arg) {
    int tid_ = tid_arg; asm volatile("" : "+v"(tid_));
    const int tid = tid_, wid = __builtin_amdgcn_readfirstlane(tid >> 6), lane = tid & 63, wr = wid >> 2, wc = wid & 3, fr = lane & 15, fq = lane >> 4;
    const int K = g.K, nt = K / BK;
    unsigned voffA[2], voffB[2];
#pragma unroll
    for (int i = 0; i < 2; ++i) { int R, C; stage_rc(tid * 16 + i * 8192, R, C); const int Rb = Epi::PERM ? ((R & ~31) + perm32(R & 31)) : R;
        voffA[i] = (unsigned)(R * K + C) * 2u; voffB[i] = (unsigned)(Rb * K + C) * 2u; }
    const size_t kstep = (size_t)(BK * 2);
    const size_t hstep = (size_t)HALF * K * 2;
    const size_t tstep = 2 * hstep;
    const unsigned ldsw = (unsigned)wid * 1024u;
    const int aoff = lds_byte(wr * 64 + fr, fq * 8), boff = lds_byte(wc * 32 + fr, fq * 8);
#define PG8_SA(b, h) (((b) * 2 + (h)) * HTB)
#define PG8_SB(b, h) ((4 + (b) * 2 + (h)) * HTB)
#define PG8_STAGE(bufoff, gbase, voff) do { _Pragma("unroll") for (int _i = 0; _i < 2; ++_i) \
        __builtin_amdgcn_global_load_lds((const unsigned*)((const char*)(gbase) + (voff)[_i]), (PG8_LAS unsigned*)(lds + (bufoff) + ldsw + _i * 8192), 16, 0, 0); } while (0)
#define PG8_LDA(dst, b, h) do { _Pragma("unroll") for (int m = 0; m < 4; ++m) _Pragma("unroll") for (int k = 0; k < 2; ++k) dst[m][k] = *(const PG8_LAS bf16x8*)(lds + PG8_SA(b, h) + aoff + m * 2048 + k * 1024); } while (0)
#define PG8_LDB(dst, b, h) do { _Pragma("unroll") for (int n = 0; n < 2; ++n) _Pragma("unroll") for (int k = 0; k < 2; ++k) dst[n][k] = *(const PG8_LAS bf16x8*)(lds + PG8_SB(b, h) + boff + n * 2048 + k * 1024); } while (0)
#define PG8_MMA(ai, bj, At, Bt) do { __builtin_amdgcn_s_setprio(1); _Pragma("unroll") for (int m = 0; m < 4; ++m) _Pragma("unroll") for (int n = 0; n < 2; ++n) _Pragma("unroll") for (int k = 0; k < 2; ++k) \
        acc[ai][bj][m][n] = __builtin_amdgcn_mfma_f32_16x16x32_bf16(Bt[n][k], At[m][k], acc[ai][bj][m][n], 0, 0, 0); __builtin_amdgcn_s_setprio(0); } while (0)
#define PG8_WAIT_V(n) asm volatile("s_waitcnt vmcnt(" #n ")" ::: "memory")
#define PG8_WAIT_L(n) asm volatile("s_waitcnt lgkmcnt(" #n ")" ::: "memory")
#define PG8_BAR __builtin_amdgcn_s_barrier()
#define PG8_SCHED __builtin_amdgcn_sched_barrier(0)
    Unit cur, nxt; int ui = 0;
    if (!S.next(0, cur)) return;
    f32x4 acc[2][2][4][2];
#pragma unroll
    for (int a = 0; a < 2; ++a)
#pragma unroll
        for (int b = 0; b < 2; ++b)
#pragma unroll
            for (int m = 0; m < 4; ++m)
#pragma unroll
                for (int n = 0; n < 2; ++n) acc[a][b][m][n] = (f32x4){0.f, 0.f, 0.f, 0.f};
    bf16x8 At[4][2], B0[2][2], B1[2][2];
    const char* cA = (const char*)g.A + (size_t)cur.pm * tstep; const char* cB = (const char*)g.Bt + (size_t)cur.pn * tstep;
    S.a_ready(cur);
    if constexpr (SP2) {
        PG8_STAGE(PG8_SB(0, 0), cB, voffB); PG8_STAGE(PG8_SB(0, 1), cB + hstep, voffB); PG8_STAGE(PG8_SA(0, 0), cA, voffA); PG8_STAGE(PG8_SA(0, 1), cA + hstep, voffA);
        if (wr == 1) PG8_BAR;
        PG8_WAIT_V(2); PG8_BAR;
        PG8_STAGE(PG8_SB(1, 0), cB + kstep, voffB); PG8_STAGE(PG8_SA(1, 0), cA + kstep, voffA); PG8_STAGE(PG8_SB(1, 1), cB + hstep + kstep, voffB);
        PG8_WAIT_V(6); PG8_BAR;
    } else {
        PG8_STAGE(PG8_SB(0, 0), cB, voffB); PG8_STAGE(PG8_SA(0, 0), cA, voffA); PG8_STAGE(PG8_SB(0, 1), cB + hstep, voffB); PG8_STAGE(PG8_SA(0, 1), cA + hstep, voffA);
        if (wr == 1) PG8_BAR;
        PG8_WAIT_V(4); PG8_BAR;
        PG8_STAGE(PG8_SB(1, 0), cB + kstep, voffB); PG8_STAGE(PG8_SA(1, 0), cA + kstep, voffA); PG8_STAGE(PG8_SB(1, 1), cB + hstep + kstep, voffB);
        PG8_WAIT_V(6); PG8_BAR;
    }
    for (;;) {
        const bool has_next = S.next(ui + 1, nxt);
        const char* nA = has_next ? (const char*)g.A + (size_t)nxt.pm * tstep : cA; const char* nB = has_next ? (const char*)g.Bt + (size_t)nxt.pn * tstep : cB;
        for (int t = 0; t < nt; t += 2) {
#if KLOOP_P2ALIGN > 0
            asm volatile(".p2align " KLOOP_P2ALIGN_STR);
#endif
            const bool last = (t == nt - 2);
            const char* a1 = cA + (size_t)(t + 1) * kstep;
            const char* a2 = last ? nA : cA + (size_t)(t + 2) * kstep; const char* b2 = last ? nB : cB + (size_t)(t + 2) * kstep;
            const char* a3 = a2 + kstep; const char* b3 = b2 + kstep;
            if (last && has_next) S.a_ready(nxt);
            const int freshi = __builtin_amdgcn_readfirstlane(((t == 0) && (ui > 0)) ? 1 : 0);
            if constexpr (SP2) {
#define PG8_SP2_ITER(WV12) \
            PG8_LDB(B0, 0, 0); PG8_LDB(B1, 0, 1); PG8_SCHED; PG8_LDA(At, 0, 0); PG8_STAGE(PG8_SA(1, 1), a1 + hstep, voffA); \
            WV12; PG8_WAIT_L(0); PG8_BAR; PG8_MMA(0, 0, At, B0); PG8_MMA(0, 1, At, B1); PG8_BAR; PG8_SCHED; \
            PG8_LDA(At, 0, 1); PG8_STAGE(PG8_SB(0, 0), b2, voffB); PG8_STAGE(PG8_SB(0, 1), b2 + hstep, voffB); PG8_STAGE(PG8_SA(0, 0), a2, voffA); \
            WV12; PG8_WAIT_L(0); PG8_BAR; PG8_MMA(1, 0, At, B0); PG8_MMA(1, 1, At, B1); PG8_BAR; PG8_SCHED; \
            PG8_LDB(B0, 1, 0); PG8_LDB(B1, 1, 1); PG8_SCHED; PG8_LDA(At, 1, 0); PG8_STAGE(PG8_SA(0, 1), a2 + hstep, voffA); \
            PG8_WAIT_V(8); PG8_WAIT_L(0); PG8_BAR; PG8_MMA(0, 0, At, B0); PG8_MMA(0, 1, At, B1); PG8_BAR; PG8_SCHED; \
            PG8_LDA(At, 1, 1); PG8_STAGE(PG8_SB(1, 0), b3, voffB); PG8_STAGE(PG8_SB(1, 1), b3 + hstep, voffB); PG8_STAGE(PG8_SA(1, 0), a3, voffA); \
            PG8_WAIT_V(8); PG8_WAIT_L(0); PG8_BAR; PG8_MMA(1, 0, At, B0); PG8_MMA(1, 1, At, B1); PG8_BAR; PG8_SCHED;
#define PG8_WAIT_V8F() do { if constexpr (Epi::NSTORE == 16) asm volatile("s_cmp_lg_u32 %0, 0\n\ts_cbranch_scc0 .Lw8_%=\n\ts_waitcnt vmcnt(24)\n\ts_branch .Lwd_%=\n.Lw8_%=:\n\ts_waitcnt vmcnt(8)\n.Lwd_%=:" :: "s"(freshi) : "memory", "scc"); \
        else if constexpr (Epi::NSTORE == 8) asm volatile("s_cmp_lg_u32 %0, 0\n\ts_cbranch_scc0 .Lw8_%=\n\ts_waitcnt vmcnt(16)\n\ts_branch .Lwd_%=\n.Lw8_%=:\n\ts_waitcnt vmcnt(8)\n.Lwd_%=:" :: "s"(freshi) : "memory", "scc"); \
        else PG8_WAIT_V(8); } while (0)
            PG8_SP2_ITER(PG8_WAIT_V8F())
#undef PG8_WAIT_V8F
#undef PG8_SP2_ITER
            } else {
            PG8_LDB(B0, 0, 0); PG8_SCHED; PG8_LDA(At, 0, 0); PG8_STAGE(PG8_SA(1, 1), a1 + hstep, voffA);
            PG8_WAIT_L(8); PG8_BAR; PG8_WAIT_L(0); PG8_MMA(0, 0, At, B0); PG8_BAR; PG8_SCHED;
            PG8_LDB(B1, 0, 1); PG8_STAGE(PG8_SB(0, 0), b2, voffB);
            PG8_BAR; PG8_WAIT_L(0); PG8_MMA(0, 1, At, B1); PG8_BAR;
            PG8_LDA(At, 0, 1); PG8_STAGE(PG8_SA(0, 0), a2, voffA);
            PG8_BAR; PG8_WAIT_L(0); PG8_MMA(1, 0, At, B0); PG8_BAR; PG8_SCHED;
            PG8_STAGE(PG8_SB(0, 1), b2 + hstep, voffB);
            PG8_WAIT_V(6); PG8_BAR; PG8_MMA(1, 1, At, B1); PG8_BAR;
            PG8_LDB(B0, 1, 0); PG8_SCHED; PG8_LDA(At, 1, 0); PG8_STAGE(PG8_SA(0, 1), a2 + hstep, voffA);
            PG8_WAIT_L(8); PG8_BAR; PG8_WAIT_L(0); PG8_MMA(0, 0, At, B0); PG8_BAR; PG8_SCHED;
            PG8_LDB(B1, 1, 1); PG8_STAGE(PG8_SB(1, 0), b3, voffB);
            PG8_BAR; PG8_WAIT_L(0); PG8_MMA(0, 1, At, B1); PG8_BAR;
            PG8_LDA(At, 1, 1); PG8_STAGE(PG8_SA(1, 0), a3, voffA);
            PG8_BAR; PG8_WAIT_L(0); PG8_MMA(1, 0, At, B0); PG8_BAR; PG8_SCHED;
            PG8_STAGE(PG8_SB(1, 1), b3 + hstep, voffB);
            PG8_WAIT_V(6); PG8_BAR; PG8_MMA(1, 1, At, B1); PG8_BAR;
            }
        }
        if constexpr (ALIGN_EPI) { if (wr == 0) PG8_BAR; }
        if constexpr (!Epi::AFTER_DRAIN) { E(acc, cur, wr, wc, fr, fq); S.done(cur); }
        if (!has_next) break;
#pragma unroll
        for (int a = 0; a < 2; ++a)
#pragma unroll
            for (int b = 0; b < 2; ++b)
#pragma unroll
                for (int m = 0; m < 4; ++m)
#pragma unroll
                    for (int n = 0; n < 2; ++n) acc[a][b][m][n] = (f32x4){0.f, 0.f, 0.f, 0.f};
        cur = nxt; cA = nA; cB = nB; ++ui;
        if constexpr (ALIGN_EPI) { if (wr == 1) PG8_BAR; }
    }
    PG8_WAIT_V(0);
    if constexpr (!ALIGN_EPI) { if (wr == 0) PG8_BAR; }
    PG8_BAR;
    if constexpr (Epi::AFTER_DRAIN) { E.fused(acc, cur, wr, wc, fr, fq, lds, wid, lane); S.done(cur); }
#undef PG8_SA
#undef PG8_SB
#undef PG8_STAGE
#undef PG8_LDA
#undef PG8_LDB
#undef PG8_MMA
#undef PG8_WAIT_V
#undef PG8_WAIT_L
#undef PG8_BAR
#undef PG8_SCHED
}
}
constexpr int NWAVES = 8, NTHR = 512;
constexpr int D = 2048, BATCH = 2, T = 8192, DEPTH = 4, M = BATCH * T;
constexpr int NPROJ = 7168, DIN = 7176, FF = 5632, NGU = 2 * FF, NMODC = 6 * D;
constexpr float LN_EPS = 1e-5f, DN_ALPHA = 1.6817928305074292f, QSCALE = 0.08838834764831845f;
constexpr int PC_QK = 0, PC_V = 1024, PC_O = 2048, PC_QH = 3072, PC_FH = 4096, PC_IH = 5120, PC_GH = 6144;
constexpr size_t MiB = 1u << 20;
constexpr size_t WS_CTL = 0, CTL_ZERO_BYTES = 1 * MiB;
constexpr size_t WS_MOD = 1 * MiB;
constexpr size_t WS_LB = WS_MOD + 512 * 1024;
constexpr size_t WS_GW = WS_LB + 64 * 1024;
constexpr size_t WS_GATES = 2 * MiB;
constexpr size_t WS_DEN = 3 * MiB;
constexpr size_t WS_WIN = 4 * MiB;
constexpr size_t WS_WOUT = WS_WIN + 112 * MiB;
constexpr size_t WS_WGU = WS_WOUT + 32 * MiB;
constexpr size_t WS_WDN = WS_WGU + 176 * MiB;
constexpr size_t WS_X = WS_WDN + 88 * MiB;
constexpr size_t WS_U = WS_X + 128 * MiB;
constexpr size_t WS_YMIX = WS_U + 64 * MiB;
constexpr size_t WS_PROJ = WS_YMIX + 64 * MiB;
constexpr size_t WS_HRAW = WS_PROJ + 224 * MiB;
constexpr size_t WS_GSM = WS_HRAW + 128 * MiB;
constexpr size_t WS_GSH = WS_GSM + 32 * MiB;
constexpr size_t WS_GSN = WS_GSH + 32 * MiB;
constexpr size_t WS_GSS = WS_GSN + 128 * 1024;
constexpr size_t WS_GHD = WS_GSS + 4 * 1024;
constexpr size_t WS_YB = WS_GHD + 256 * 1024 + 124 * 1024;
constexpr size_t WS_END = WS_YB + 64 * MiB;
constexpr int CW_BAR = 4096;
constexpr int RING_BYTES = 131072, MISC_OFF = 150528, LDS_BYTES = 151552;
#define GAS __attribute__((address_space(1)))
#define LAS __attribute__((address_space(3)))
typedef unsigned short bf16;
typedef unsigned v4u __attribute__((ext_vector_type(4)));
typedef unsigned v2u __attribute__((ext_vector_type(2)));
typedef float f32x4 __attribute__((ext_vector_type(4)));
typedef float f32x2 __attribute__((ext_vector_type(2)));
#define LDS_WAIT() asm volatile("s_waitcnt lgkmcnt(0)" ::: "memory")
#define VM_WAIT() asm volatile("s_waitcnt vmcnt(0)" ::: "memory")
__device__ __forceinline__ unsigned f2bf(float f) { unsigned u = __builtin_bit_cast(unsigned, f); return (u + 0x7fffu + ((u >> 16) & 1u)) >> 16; }
__device__ __forceinline__ unsigned pk2(float lo, float hi) { return f2bf(lo) | (f2bf(hi) << 16); }
__device__ __forceinline__ float bf2f(unsigned short b) { return __builtin_bit_cast(float, (unsigned)b << 16); }
__device__ __forceinline__ float bflo(unsigned w) { return __builtin_bit_cast(float, w << 16); }
__device__ __forceinline__ float bfhi(unsigned w) { return __builtin_bit_cast(float, w & 0xffff0000u); }
__device__ __forceinline__ float sigmoid_f(float x) { return 1.0f / (1.0f + __expf(-x)); }
__device__ __forceinline__ float silu_f(float x) { return x / (1.0f + __expf(-x)); }
__device__ __forceinline__ float logsigmoid_f(float x) { return x < 0.f ? x - log1pf(expf(x)) : -log1pf(expf(-x)); }
__device__ __forceinline__ float wave_sum(float v) {
#pragma unroll
    for (int o = 1; o < 64; o <<= 1) v += __shfl_xor(v, o);
    return v;
}
#define XB_TMO      128
#define XB_XCNT(j)  (256  + 64 * (j))
#define XB_XSUB(j)  (1280 + 64 * (j))
#define XB_XGEN(j)  (2304 + 64 * (j))
#define XB_TOP      3328
#define XB_TOPGEN   3392
#define XCD_BAR_WORDS 3456
#define XB_SPIN_CAP (1u << 18)

__device__ __forceinline__ unsigned xb_ld(unsigned* p)              { return __hip_atomic_load(p, __ATOMIC_RELAXED, __HIP_MEMORY_SCOPE_AGENT); }
__device__ __forceinline__ unsigned xb_add(unsigned* p, unsigned v) { return __hip_atomic_fetch_add(p, v, __ATOMIC_RELAXED, __HIP_MEMORY_SCOPE_AGENT); }
__device__ __forceinline__ unsigned xb_xcc_id() { return (unsigned)__builtin_amdgcn_s_getreg((3 << 11) | 20) & 0xFu; }
#define XB_SPIN(cond, bar) do { unsigned _sp = 0; while (cond) { __builtin_amdgcn_s_sleep(1); \
    if ((++_sp & 255u) == 0u) { if (xb_ld(&(bar)[XB_TMO])) break; if (_sp > XB_SPIN_CAP) { atomicAdd(&(bar)[XB_TMO], 1u); break; } } } } while (0)

struct XcdBarrier {
    unsigned* bar; unsigned x;
    volatile LAS unsigned* st;
};

__device__ __forceinline__ XcdBarrier xcd_barrier_post(unsigned* bar, volatile LAS unsigned* st) {
    XcdBarrier b; b.bar = bar; b.x = xb_xcc_id(); b.st = st;
    if (threadIdx.x == 0) (void)xb_add(&bar[XB_XCNT(b.x)], 1u);
    return b;
}
__device__ __forceinline__ void xcd_barrier_complete(unsigned* bar, unsigned x, unsigned& nloc, unsigned& nx) {
    const unsigned G = gridDim.x * gridDim.y * gridDim.z;
    unsigned sum, cnt, mine, sp = 0u;
    for (;;) {
        sum = 0u; cnt = 0u; mine = 0u;
#pragma unroll
        for (unsigned j = 0; j < 16; ++j) { const unsigned c = xb_ld(&bar[XB_XCNT(j)]); sum += c; cnt += (c > 0u) ? 1u : 0u; mine = (j == x) ? c : mine; }
        if (sum == G) break;
        __builtin_amdgcn_s_sleep(1);
        if ((++sp & 255u) == 0u) { if (xb_ld(&bar[XB_TMO])) break; if (sp > XB_SPIN_CAP) { atomicAdd(&bar[XB_TMO], 1u); break; } }
    }
    nloc = mine > 0u ? mine : 1u; nx = cnt > 0u ? cnt : 1u;
}

__device__ __forceinline__ void xcd_barrier(const XcdBarrier& b) {
    asm volatile("s_waitcnt vmcnt(0)" ::: "memory");
    __syncthreads();
    if (threadIdx.x == 0) {
        unsigned* bar = b.bar;
        __builtin_amdgcn_s_waitcnt(0);
        unsigned nloc = b.st[0], nx = b.st[1];
        if (nloc == 0u) { xcd_barrier_complete(bar, b.x, nloc, nx); b.st[0] = nloc; b.st[1] = nx; }
        const unsigned old = xb_add(&bar[XB_XSUB(b.x)], 1u);
        const unsigned gen = old / nloc;
        if (old + 1u == (gen + 1u) * nloc) {
            __builtin_amdgcn_fence(__ATOMIC_RELEASE, "agent");
            asm volatile("s_waitcnt vmcnt(0)" ::: "memory");
            const unsigned og = xb_add(&bar[XB_TOP], 1u);
            const unsigned tg = og / nx;
            if (og + 1u == (tg + 1u) * nx) xb_add(&bar[XB_TOPGEN], 1u);
            else XB_SPIN(xb_ld(&bar[XB_TOPGEN]) == tg, bar);
            __builtin_amdgcn_fence(__ATOMIC_ACQUIRE, "agent");
            xb_add(&bar[XB_XGEN(b.x)], 1u);
            asm volatile("s_waitcnt vmcnt(0)" ::: "memory");
        } else {
            XB_SPIN(xb_ld(&bar[XB_XGEN(b.x)]) == gen, bar);
            __builtin_amdgcn_fence(__ATOMIC_ACQUIRE, "agent");
            asm volatile("s_waitcnt vmcnt(0)" ::: "memory");
        }
    }
    __syncthreads();
}
__device__ __forceinline__ void transpose_item(const float* W, int Nsrc, int ns0, int k0, bf16* WT, int Kdim, int nd0, LAS float* scr, int lane) {
#pragma unroll 8
    for (int i = 0; i < 32; ++i) { const int kk = 2 * i + (lane >> 5); scr[kk * 33 + (lane & 31)] = W[(size_t)(k0 + kk) * Nsrc + ns0 + (lane & 31)]; }
    LDS_WAIT(); asm volatile("" ::: "memory");
    const int c = lane & 7;
#pragma unroll
    for (int j = 0; j < 4; ++j) { const int n = (lane >> 3) + 8 * j; const LAS float* s = scr + (8 * c) * 33 + n;
        v4u o; o.x = pk2(s[0 * 33], s[1 * 33]); o.y = pk2(s[2 * 33], s[3 * 33]); o.z = pk2(s[4 * 33], s[5 * 33]); o.w = pk2(s[6 * 33], s[7 * 33]);
        *(GAS v4u*)(WT + (size_t)(nd0 + n) * Kdim + k0 + 8 * c) = o; }
    LDS_WAIT(); asm volatile("" ::: "memory");
}
struct Ptrs {
    const float *x, *c, *w_mod, *b_mod, *w_in, *conv_w, *conv_b, *b_ig, *b_fg, *mnorm_w, *hnorm_w, *lb_logits, *w_out, *ln1_g, *ln1_b, *w_gate, *w_up, *w_down, *ln2_g, *ln2_b;
    float* out; unsigned char* ws;
};
constexpr int IT_IN = 32 * 224, IT_OUT = 32 * 64, IT_GU = 32 * 352, IT_DN = 88 * 64, IT_LAYER = IT_IN + IT_OUT + IT_GU + IT_DN, IT_ALL = DEPTH * IT_LAYER;
__device__ __forceinline__ void do_transpose(const Ptrs& P, int it, LAS float* scr, int lane) {
    const int l = it / IT_LAYER; int r = it % IT_LAYER;
    if (r < IT_IN) { const int kb = r / 224, nb = r % 224, n0 = 32 * nb;
        transpose_item(P.w_in + (size_t)l * D * DIN, DIN, n0 + (n0 >= 3072 ? 8 : 0), 64 * kb, (bf16*)(P.ws + WS_WIN) + (size_t)l * NPROJ * D, D, n0, scr, lane); return; }
    r -= IT_IN;
    if (r < IT_OUT) { const int kb = r / 64, nb = r % 64, n0 = 32 * nb;
        transpose_item(P.w_out + (size_t)l * D * D, D, n0, 64 * kb, (bf16*)(P.ws + WS_WOUT) + (size_t)l * D * D, D, n0, scr, lane); return; }
    r -= IT_OUT;
    if (r < IT_GU) { const int kb = r / 352, nb = r % 352, n0 = 32 * nb, pn = n0 >> 8, wi = n0 & 255, bj = wi >> 7, jc = wi & 127;
        transpose_item((bj ? P.w_up : P.w_gate) + (size_t)l * D * FF, FF, 128 * pn + jc, 64 * kb, (bf16*)(P.ws + WS_WGU) + (size_t)l * NGU * D, D, n0, scr, lane); return; }
    r -= IT_GU;
    { const int kb = r / 64, nb = r % 64, n0 = 32 * nb;
        transpose_item(P.w_down + (size_t)l * FF * D, D, n0, 64 * kb, (bf16*)(P.ws + WS_WDN) + (size_t)l * D * FF, FF, n0, scr, lane); }
}
__device__ __forceinline__ void phase_prologue(const Ptrs& P, LAS unsigned char* lds, int tid, int lane, int wave, int G) {
    LAS float* ca = (LAS float*)(lds + 8 * 8704);
    for (int i = tid; i < 2 * D; i += NTHR) ca[i] = silu_f(P.c[i]);
    __syncthreads();
    const int gw = wave * G + (int)blockIdx.x, NGW = G * NWAVES;
    float* MOD = (float*)(P.ws + WS_MOD);
    for (int item = gw; item < DEPTH * 192; item += NGW) {
        const int l = item / 192, j = (item % 192) * 64 + lane;
        const float* w = P.w_mod + (size_t)l * D * NMODC + j;
        float a0 = 0.f, a1 = 0.f;
        for (int k = 0; k < D; k += 16) { float wv[16];
#pragma unroll
            for (int i = 0; i < 16; ++i) wv[i] = w[(size_t)(k + i) * NMODC];
#pragma unroll
            for (int i = 0; i < 16; ++i) { a0 += ca[k + i] * wv[i]; a1 += ca[D + k + i] * wv[i]; } }
        const float bm = P.b_mod[l * NMODC + j];
        MOD[(l * 2 + 0) * NMODC + j] = a0 + bm; MOD[(l * 2 + 1) * NMODC + j] = a1 + bm;
    }
    const int gid = (int)blockIdx.x * NTHR + tid;
    if (gid < DEPTH * 8 * D) { const int l = gid >> 14, jg = (gid >> 11) & 7, k = gid & 2047; ((float*)(P.ws + WS_GW))[gid] = P.w_in[((size_t)l * D + k) * DIN + 3072 + jg]; }
    if (gid < 1024) { const float g0 = P.lb_logits[gid], g1 = P.lb_logits[1024 + gid], g2 = P.lb_logits[2048 + gid], g3 = P.lb_logits[3072 + gid];
        const float mx = fmaxf(fmaxf(g0, g1), fmaxf(g2, g3)), e0 = expf(g0 - mx), e1 = expf(g1 - mx), e2 = expf(g2 - mx), e3 = expf(g3 - mx), inv = 1.0f / (e0 + e1 + e2 + e3);
        float* LB = (float*)(P.ws + WS_LB); LB[gid] = 0.f; LB[1024 + gid] = e1 * inv; LB[2048 + gid] = (e1 + e2) * inv; LB[3072 + gid] = (e1 + e2 + e3) * inv; }
    LAS float* scr = (LAS float*)(lds + wave * 8704);
    const int nmodw = DEPTH * 192 < NGW ? DEPTH * 192 : NGW;
    const int rest = NGW - nmodw;
    int r1, r2;
    if (rest > 0) { r2 = (IT_ALL + 50 * nmodw + NGW - 1) / NGW; r1 = r2 - 50; if (r1 < 0) r1 = 0; while ((long)r1 * nmodw + (long)r2 * rest < IT_ALL) ++r2; } else { r1 = (IT_ALL + NGW - 1) / NGW; r2 = r1; }
    int lo, hi;
    if (gw < nmodw) { lo = gw * r1; hi = lo + r1; } else { lo = nmodw * r1 + (gw - nmodw) * r2; hi = lo + r2; }
    if (hi > IT_ALL) hi = IT_ALL;
    for (int it = lo; it < hi; ++it) do_transpose(P, it, scr, lane);
}
template <int CTRL> __device__ __forceinline__ float dpp_add(float v) { return v + __builtin_bit_cast(float, __builtin_amdgcn_update_dpp(0, __builtin_bit_cast(int, v), CTRL, 0xF, 0xF, false)); }
__device__ __forceinline__ float wave_sum_fast(float v) {
    v = dpp_add<0xB1>(v); v = dpp_add<0x4E>(v); v = dpp_add<0x141>(v); v = dpp_add<0x140>(v);
    v += __shfl_xor(v, 16); v += __shfl_xor(v, 32); return v;
}
template <bool DO_LN, bool MAKE_U, bool GATES, bool SRC_BF16, bool DST_BF16>
__device__ __forceinline__ void phase_rows(LAS unsigned char* lds, int tid, int lane, int wave, int G, const void* srcv, const bf16* ysrc  , void* dstv, const float* lng, const float* lnb,
                                           bf16* U, const float* sc, const float* sh, const float* gwl, const float* b_ig, const float* b_fg, float* GT) {
    LAS float* wg = (LAS float*)lds;
    LAS float* tg = wg + 8 * D;
    if (GATES) for (int i = tid; i < 8 * D; i += NTHR) wg[i] = gwl[i];
    if (DO_LN) for (int i = tid; i < D; i += NTHR) { tg[i] = lng[i]; tg[D + i] = lnb[i]; }
    if (MAKE_U) for (int i = tid; i < 2 * D; i += NTHR) { const int bb = i >> 11, cc = i & 2047; tg[2 * D + i] = 1.0f + sc[(size_t)bb * NMODC + cc]; tg[4 * D + i] = sh[(size_t)bb * NMODC + cc]; }
    __syncthreads();
#if XCD_AFFINE
    const bool aff = (G == 256);
    const int gw = aff ? (((int)blockIdx.x & 7) * 2048 + ((int)blockIdx.x >> 3) * NWAVES + wave) : ((int)blockIdx.x * NWAVES + wave), NGW = aff ? 256 : G * NWAVES, MEND = aff ? (((int)blockIdx.x & 7) + 1) * 2048 : M;
#else
    const int gw = (int)blockIdx.x * NWAVES + wave, NGW = G * NWAVES, MEND = M;
#endif
    const float* src = (const float*)srcv; const bf16* srcb = (const bf16*)srcv; float* dst = (float*)dstv; bf16* dstb = (bf16*)dstv;
    f32x4 v[8], vn[8]; v2u xn[8], yv[8], yn[8];
#define ROW_LOAD(mm_) do { _Pragma("unroll") for (int j = 0; j < 8; ++j) { if (SRC_BF16) xn[j] = *(const v2u*)(srcb + (size_t)(mm_) * D + 4 * lane + 256 * j); else vn[j] = *(const f32x4*)(src + (size_t)(mm_) * D + 4 * lane + 256 * j); \
        if (DO_LN) yn[j] = *(const v2u*)(ysrc + (size_t)(mm_) * D + 4 * lane + 256 * j); } } while (0)
    if (gw < MEND) ROW_LOAD(gw);
    for (int m = gw; m < MEND; m += NGW) {
        const int b = m >> 13;
#pragma unroll
        for (int j = 0; j < 8; ++j) { if (SRC_BF16) v[j] = (f32x4){bflo(xn[j].x), bfhi(xn[j].x), bflo(xn[j].y), bfhi(xn[j].y)}; else v[j] = vn[j]; if (DO_LN) yv[j] = yn[j]; }
        { const int ml = (m + NGW < MEND) ? m + NGW : m;
          ROW_LOAD(ml); }
        if (DO_LN) {
            float s = 0.f;
#pragma unroll
            for (int j = 0; j < 8; ++j) { v[j] = v[j] * DN_ALPHA + (f32x4){bflo(yv[j].x), bfhi(yv[j].x), bflo(yv[j].y), bfhi(yv[j].y)}; s += (v[j].x + v[j].y) + (v[j].z + v[j].w); }
            const float mean = wave_sum_fast(s) * (1.f / D); float s2 = 0.f;
#pragma unroll
            for (int j = 0; j < 8; ++j) { v[j] = v[j] - mean; s2 += (v[j].x * v[j].x + v[j].y * v[j].y) + (v[j].z * v[j].z + v[j].w * v[j].w); }
            const float rstd = 1.f / sqrtf(wave_sum_fast(s2) * (1.f / D) + LN_EPS);
#pragma unroll
            for (int j = 0; j < 8; ++j) { const f32x4 g = *(const LAS f32x4*)(tg + 4 * lane + 256 * j), bb = *(const LAS f32x4*)(tg + D + 4 * lane + 256 * j); v[j] = v[j] * rstd * g + bb; }
        }
        if (dstv) {
#pragma unroll
            for (int j = 0; j < 8; ++j) { if (DST_BF16) { v2u w; w.x = pg8::cvt_pk_bf16(v[j].x, v[j].y); w.y = pg8::cvt_pk_bf16(v[j].z, v[j].w); *(v2u*)(dstb + (size_t)m * D + 4 * lane + 256 * j) = w; }
                else *(f32x4*)(dst + (size_t)m * D + 4 * lane + 256 * j) = v[j]; }
        }
        if (MAKE_U) {
            bf16* uo = U + (size_t)m * D + 4 * lane;
#pragma unroll
            for (int j = 0; j < 8; ++j) { const f32x4 a = *(const LAS f32x4*)(tg + 2 * D + b * D + 4 * lane + 256 * j), c = *(const LAS f32x4*)(tg + 4 * D + b * D + 4 * lane + 256 * j); v[j] = v[j] * a + c;
                v2u w; w.x = pg8::cvt_pk_bf16(v[j].x, v[j].y); w.y = pg8::cvt_pk_bf16(v[j].z, v[j].w); *(v2u*)(uo + 256 * j) = w; }
            if (GATES) {
                float p[8];
#pragma unroll
                for (int jg = 0; jg < 8; ++jg) { float a = 0.f;
#pragma unroll
                    for (int j = 0; j < 8; ++j) { const f32x4 w = *(const LAS f32x4*)(wg + jg * D + 4 * lane + 256 * j); a += (v[j].x * w.x + v[j].y * w.y) + (v[j].z * w.z + v[j].w * w.w); }
                    p[jg] = a; asm volatile("" ::: "memory"); }
                float q[4], r[2], t1;
                { const bool hi = lane & 1;
#pragma unroll
                  for (int i = 0; i < 4; ++i) { const float mine = hi ? p[4 + i] : p[i], oth = hi ? p[i] : p[4 + i]; q[i] = mine + __shfl_xor(oth, 1); } }
                { const bool hi = lane & 2;
#pragma unroll
                  for (int i = 0; i < 2; ++i) { const float mine = hi ? q[2 + i] : q[i], oth = hi ? q[i] : q[2 + i]; r[i] = mine + __shfl_xor(oth, 2); } }
                { const bool hi = lane & 4; const float mine = hi ? r[1] : r[0], oth = hi ? r[0] : r[1]; t1 = mine + __shfl_xor(oth, 4); }
                t1 += __shfl_xor(t1, 8); t1 += __shfl_xor(t1, 16); t1 += __shfl_xor(t1, 32);
                if (lane < 8) { const int jg = 4 * (lane & 1) + 2 * ((lane >> 1) & 1) + ((lane >> 2) & 1); GT[(size_t)m * 8 + jg] = t1 + (jg < 4 ? b_ig[jg] : b_fg[jg - 4]); }
            }
        }
    }
}
#undef ROW_LOAD
constexpr int TS = 16;
__device__ __forceinline__ void naive_mlstm(LAS unsigned char* lds, int bh, int tid, const bf16* PROJ, const float* GT, const float* convw, const float* convb, float* HRAW, float* DEN) {
    const int b = bh >> 2, h = bh & 3;
    LAS float* qs = (LAS float*)lds; LAS float* ks = qs + TS * 128; LAS float* vs = ks + TS * 128; LAS float* gs = vs + TS * 256;
    float C[128];
#pragma unroll
    for (int d = 0; d < 128; ++d) C[d] = 0.f;
    float mrun = 0.f;
    const bool isv = tid < 256, isn = tid == 256;
    for (int t0 = 0; t0 < T; t0 += TS) {
        __syncthreads();
        for (int i = tid; i < TS * 256; i += NTHR) {
            const int tt = i >> 8, c = i & 255, ch = (c < 128) ? (h * 128 + c) : (512 + h * 128 + (c - 128)), t = t0 + tt;
            float a = convb[ch];
#pragma unroll
            for (int j = 0; j < 4; ++j) { const int ts = t - 3 + j; if (ts >= 0) a += convw[j * 1024 + ch] * bf2f(PROJ[(size_t)(b * T + ts) * NPROJ + PC_QK + ch]); }
            a = silu_f(a);
            if (c < 128) qs[tt * 128 + c] = a * QSCALE; else ks[tt * 128 + (c - 128)] = a;
        }
        for (int i = tid; i < TS * 256; i += NTHR) { const int tt = i >> 8, v = i & 255; vs[i] = bf2f(PROJ[(size_t)(b * T + t0 + tt) * NPROJ + PC_V + h * 256 + v]); }
        if (tid < TS) { const float* g = GT + (size_t)(b * T + t0 + tid) * 8; gs[tid * 2] = logsigmoid_f(g[4 + h]); gs[tid * 2 + 1] = g[h]; }
        __syncthreads();
        if (isv || isn) {
            for (int tt = 0; tt < TS; ++tt) {
                const float lf = gs[tt * 2], ig = gs[tt * 2 + 1];
                const float mnew = fmaxf(lf + mrun, ig), fdec = __expf(lf + mrun - mnew), iw = __expf(ig - mnew);
                mrun = mnew;
                const float a = iw * (isn ? 1.0f : vs[tt * 256 + (tid & 255)]);
                float n0 = 0.f, n1 = 0.f, n2 = 0.f, n3 = 0.f;
#pragma unroll
                for (int d = 0; d < 128; d += 4) {
                    const f32x4 kv = *(const LAS f32x4*)(ks + tt * 128 + d), qv = *(const LAS f32x4*)(qs + tt * 128 + d);
                    C[d] = fdec * C[d] + a * kv.x; n0 += qv.x * C[d];
                    C[d + 1] = fdec * C[d + 1] + a * kv.y; n1 += qv.y * C[d + 1];
                    C[d + 2] = fdec * C[d + 2] + a * kv.z; n2 += qv.z * C[d + 2];
                    C[d + 3] = fdec * C[d + 3] + a * kv.w; n3 += qv.w * C[d + 3];
                }
                const float num = (n0 + n1) + (n2 + n3);
                const size_t m = (size_t)(b * T + t0 + tt);
                if (isn) DEN[m * 4 + h] = fmaxf(fabsf(num), __expf(-mnew)); else HRAW[m * 2048 + h * 256 + tid] = num;
            }
        }
    }
}
__device__ __forceinline__ void naive_hgrn(LAS unsigned char* lds, int bh, int tid, const bf16* PROJ, const float* lbl, float* HRAW) {
    const int b = bh >> 3, h = bh & 7;
    LAS float* qs = (LAS float*)lds; LAS float* fs = qs + TS * 128; LAS float* ks = fs + TS * 128; LAS float* vs = ks + TS * 128;
    float S[128];
#pragma unroll
    for (int d = 0; d < 128; ++d) S[d] = 0.f;
    for (int t0 = 0; t0 < T; t0 += TS) {
        __syncthreads();
        for (int i = tid; i < TS * 128; i += NTHR) {
            const int tt = i >> 7, d = i & 127; const bf16* pr = PROJ + (size_t)(b * T + t0 + tt) * NPROJ + h * 128 + d;
            const float qr = bf2f(pr[PC_QH]), fp = bf2f(pr[PC_FH]), iv = bf2f(pr[PC_IH]), lbv = lbl[h * 128 + d];
            const float sg = 1.0f / (1.0f + __expf(-fp)), sn = 1.0f / (1.0f + __expf(fp));
            qs[i] = silu_f(qr); fs[i] = lbv + (1.0f - lbv) * sg; ks[i] = (1.0f - lbv) * sn; vs[i] = iv;
        }
        __syncthreads();
        if (tid < 128) {
            for (int tt = 0; tt < TS; ++tt) {
                const float vt = vs[tt * 128 + tid];
                float n0 = 0.f, n1 = 0.f, n2 = 0.f, n3 = 0.f;
#pragma unroll
                for (int d = 0; d < 128; d += 4) {
                    const f32x4 fv = *(const LAS f32x4*)(fs + tt * 128 + d), kv = *(const LAS f32x4*)(ks + tt * 128 + d), qv = *(const LAS f32x4*)(qs + tt * 128 + d);
                    S[d] = fv.x * S[d] + kv.x * vt; n0 += qv.x * S[d];
                    S[d + 1] = fv.y * S[d + 1] + kv.y * vt; n1 += qv.y * S[d + 1];
                    S[d + 2] = fv.z * S[d + 2] + kv.z * vt; n2 += qv.z * S[d + 2];
                    S[d + 3] = fv.w * S[d + 3] + kv.w * vt; n3 += qv.w * S[d + 3];
                }
                HRAW[(size_t)(b * T + t0 + tt) * 2048 + 1024 + h * 128 + tid] = (n0 + n1) + (n2 + n3);
            }
        }
    }
}
__device__ __forceinline__ void phase_fin(int lane, int wave, int G, const float* HRAW, const float* DEN, const bf16* PROJ, const float* mnw, const float* hnw, bf16* YMIX) {
    const int gw = (int)blockIdx.x * NWAVES + wave, NGW = G * NWAVES;
    for (int m = gw; m < M; m += NGW) {
        const float* hr = HRAW + (size_t)m * 2048; const bf16* pr = PROJ + (size_t)m * NPROJ; bf16* y = YMIX + (size_t)m * 2048;
#pragma unroll
        for (int h = 0; h < 4; ++h) {
            f32x4 v = *(const f32x4*)(hr + h * 256 + 4 * lane); const float dn = DEN[(size_t)m * 4 + h];
            v = v / dn;
            const float mean = wave_sum((v.x + v.y) + (v.z + v.w)) * (1.f / 256.f); v = v - mean;
            const float var = wave_sum((v.x * v.x + v.y * v.y) + (v.z * v.z + v.w * v.w)) * (1.f / 256.f), r = 1.f / sqrtf(var + LN_EPS);
            const f32x4 w = *(const f32x4*)(mnw + h * 256 + 4 * lane); const v2u o = *(const v2u*)(pr + PC_O + h * 256 + 4 * lane);
            const float o0 = v.x * r * w.x * sigmoid_f(bflo(o.x)), o1 = v.y * r * w.y * sigmoid_f(bfhi(o.x)), o2 = v.z * r * w.z * sigmoid_f(bflo(o.y)), o3 = v.w * r * w.w * sigmoid_f(bfhi(o.y));
            v2u q; q.x = pk2(o0, o1); q.y = pk2(o2, o3); *(v2u*)(y + h * 256 + 4 * lane) = q;
        }
#pragma unroll
        for (int h = 0; h < 8; ++h) {
            const f32x2 v = *(const f32x2*)(hr + 1024 + h * 128 + 2 * lane);
            const float ms = wave_sum(v.x * v.x + v.y * v.y) * (1.f / 128.f), r = 1.f / sqrtf(ms + LN_EPS);
            const f32x2 w = *(const f32x2*)(hnw + h * 128 + 2 * lane); const unsigned g = *(const unsigned*)(pr + PC_GH + h * 128 + 2 * lane);
            *(unsigned*)(y + 1024 + h * 128 + 2 * lane) = pk2(v.x * r * w.x * silu_f(bflo(g)), v.y * r * w.y * silu_f(bfhi(g)));
        }
    }
}
#define MIXDEV __device__ __forceinline__
#define MIX_STR2(x) #x
#define MIX_STR(x) MIX_STR2(x)
#ifdef MIX_MARKS
#define MIX_SYNC() do { asm volatile("s_waitcnt lgkmcnt(0) ; MARK line " MIX_STR(__LINE__) ::: "memory"); __builtin_amdgcn_s_barrier(); asm volatile("" ::: "memory"); } while (0)
#else
#define MIX_SYNC() do { asm volatile("s_waitcnt lgkmcnt(0)" ::: "memory"); __builtin_amdgcn_s_barrier(); asm volatile("" ::: "memory"); } while (0)
#endif
#define MFMA16(a, b, c) __builtin_amdgcn_mfma_f32_16x16x32_bf16((a), (b), (c), 0, 0, 0)
#define mix_shfl_up(v, o) __shfl_up((v), (o))
#define mix_shfl_xor(v, o) __shfl_xor((v), (o))
#define mix_shfl(v, l) __shfl((v), (l))
#define mix_cvt_pk(lo, hi) pg8::cvt_pk_bf16((lo), (hi))
#define MIX_CFENCE() asm volatile("" ::: "memory")
#define MIX_LAUNDER(x) asm volatile("" : "+v"(x))
#define mix_rcp(x) __builtin_amdgcn_rcpf(x)
#define mix_rsq(x) __builtin_amdgcn_rsqf(x)
#define mix_log(x) __logf(x)
__device__ __forceinline__ float mix_sigmoid(float x) { return __builtin_amdgcn_rcpf(1.0f + __expf(-x)); }
__device__ __forceinline__ float mix_silu(float x) { return x * __builtin_amdgcn_rcpf(1.0f + __expf(-x)); }
__device__ __forceinline__ float mix_logsig(float x) { return x < 0.f ? x - __logf(1.0f + __expf(x)) : -__logf(1.0f + __expf(-x)); }
#ifndef MIX_GCH
#define MIX_GCH 4
#endif
constexpr int GCM = 4, NGM = T / (64 * GCM), GCH = MIX_GCH, NGH = T / (64 * GCH);
constexpr int RS128 = 288, RS64 = 160;
constexpr float NEG_BIG = -1.0e30f;
#ifndef MIX_PREACT
#define MIX_PREACT 1
#endif
#if MIX_PREACT
#define MIX_OG(x) (x)
#define MIX_GQ(x) (x)
#else
#define MIX_OG(x) mix_sigmoid(x)
#define MIX_GQ(x) mix_silu(x)
#endif
#ifndef ML_PREFETCH
#define ML_PREFETCH 1
#endif
#ifndef PROJ_BLOCKED
#define PROJ_BLOCKED 1
#endif
MIXDEV size_t proj_off(size_t row, int col) { return PROJ_BLOCKED ? ((size_t)(col >> 7) * M + row) * 128 + (col & 127) : row * NPROJ + col; }
typedef short bf16x8 __attribute__((ext_vector_type(8)));
#ifndef MIX_ST16
#define MIX_ST16 1
#endif
#if MIX_ST16
typedef unsigned short mst_t;
#else
typedef float mst_t;
#endif
struct MixBuf { mst_t* GSM; float* GSN; float* GSS; mst_t* GSH; float* GHD; };
MIXDEV int dpos(int d) { return (d & ~31) | ((d & 12) << 1) | ((d & 16) >> 2) | (d & 3); }
MIXDEV int o64(int row, int colbyte) { return row * RS64 + (colbyte ^ (((row >> 4) & 7) << 4)); }
MIXDEV bf16x8 ldfrag(const LAS unsigned char* p) { return *(const LAS bf16x8*)p; }
MIXDEV bf16x8 pack_pair(const f32x4& x, const f32x4& y) { v4u p; p.x = mix_cvt_pk(x[0], x[1]); p.y = mix_cvt_pk(x[2], x[3]); p.z = mix_cvt_pk(y[0], y[1]); p.w = mix_cvt_pk(y[2], y[3]); return __builtin_bit_cast(bf16x8, p); }
#if MIX_ST16
MIXDEV f32x4 ld_st4(const mst_t* p) { const v2u q = *(const v2u*)p; return (f32x4){bflo(q.x), bfhi(q.x), bflo(q.y), bfhi(q.y)}; }
MIXDEV void st_st4(mst_t* p, const f32x4& v) { v2u q; q.x = mix_cvt_pk(v[0], v[1]); q.y = mix_cvt_pk(v[2], v[3]); *(v2u*)p = q; }
#else
MIXDEV f32x4 ld_st4(const mst_t* p) { return *(const f32x4*)p; }
MIXDEV void st_st4(mst_t* p, const f32x4& v) { *(f32x4*)p = v; }
#endif
MIXDEV void st_bf16(LAS unsigned char* p, float v) { *(LAS unsigned short*)p = (unsigned short)mix_cvt_pk(v, 0.f); }
MIXDEV float ld_bf16(const LAS unsigned char* p) { return bf2f(*(const LAS unsigned short*)p); }

constexpr int ML_Q = 0, ML_K = 18432, ML_KT = 36864, ML_VT = 57344, ML_SS = 98304, ML_TAB = 108544;
constexpr int MT_BCUM = 0, MT_GSV = 64, MT_MROW = 128, MT_WINT = 192, MT_WEND = 256, MT_RDEN = 320, MT_NP = 384, MT_SCAL = 512, MT_CW = 528, MT_HNP = 1808, MT_NW = 2832, MT_END = 3088;
template <int PASS, int DIAG = 0>
MIXDEV void mlstm_unit(LAS unsigned char* lds, int tid, int lane, int w, int unit, const bf16* PROJ, const float* GT, const float* convw, const float* convb, const float* mnw, MixBuf MB, bf16* YMIX) {
    const int b = unit / (4 * NGM), h = (unit / NGM) & 3, grp = unit % NGM;
    const int c = lane & 15, g = lane >> 4;
    LAS unsigned char* Qs = lds + ML_Q; LAS unsigned char* Ks = lds + ML_K; LAS unsigned char* Kwt = lds + ML_KT; LAS unsigned char* Vt = lds + ML_VT; LAS unsigned char* Ss = lds + ML_SS;
    LAS float* tab = (LAS float*)(lds + ML_TAB);
    f32x4 Cst[2][8];
    float m_run, btot = 0.f;
    MIX_SYNC();
    if (PASS == 1 && tid < 256) tab[MT_NW + tid] = mnw[h * 256 + tid];
    for (int i = tid; i < 5 * 256; i += NTHR) { const int j = i >> 8, cc = i & 255, ch = (cc < 128) ? (h * 128 + cc) : (512 + h * 128 + (cc - 128)); tab[MT_CW + i] = (j < 4) ? convw[j * 1024 + ch] : convb[ch]; }
    if (PASS == 0) {
#pragma unroll
        for (int vt = 0; vt < 2; ++vt)
#pragma unroll
            for (int dt = 0; dt < 8; ++dt) Cst[vt][dt] = (f32x4){0.f, 0.f, 0.f, 0.f};
        if (tid < 128) tab[MT_NP + tid] = 0.f;
        m_run = NEG_BIG;
    } else {
        const mst_t* gs = MB.GSM + (size_t)unit * 32768;
#pragma unroll
        for (int vt = 0; vt < 2; ++vt)
#pragma unroll
            for (int dt = 0; dt < 8; ++dt) Cst[vt][dt] = ld_st4(gs + (size_t)(32 * w + 16 * vt + c) * 128 + 16 * dt + 4 * g);
        if (tid < 128) tab[MT_NP + dpos(tid)] = MB.GSN[(size_t)unit * 128 + tid];
        m_run = MB.GSS[unit * 4 + 2];
    }
    float g_f = 0.f, g_i = 0.f; v4u rawc[7], rawv[4];
#define ML_LOADS(nn_) do { if (DIAG & 64) { unsigned z_ = 0x3f003f00u; MIX_LAUNDER(z_); g_f = 1.f; g_i = 0.5f; _Pragma("unroll") for (int i = 0; i < 7; ++i) rawc[i] = (v4u){z_, z_, z_, z_}; _Pragma("unroll") for (int i = 0; i < 4; ++i) rawv[i] = (v4u){z_, z_, z_, z_}; break; } int t_ = tid; MIX_LAUNDER(t_); const int sr_ = t_ >> 5, c8_ = t_ & 31; const bool isk_ = c8_ >= 16; const int ch0_ = isk_ ? (512 + h * 128 + 8 * (c8_ - 16)) : (h * 128 + 8 * c8_); \
        const size_t mm_ = (size_t)b * T + 64 * (nn_); \
        if (w == 0) { g_f = GT[(mm_ + (t_ & 63)) * 8 + 4 + h]; g_i = GT[(mm_ + (t_ & 63)) * 8 + h]; } \
        _Pragma("unroll") for (int i = 0; i < 7; ++i) { const int tg = 64 * (nn_) + 4 * sr_ - 3 + i; rawc[i] = (v4u){0u, 0u, 0u, 0u}; \
            if (((PASS == 1) || isk_) && tg >= 0) rawc[i] = *(const v4u*)(PROJ + proj_off((size_t)b * T + tg, PC_QK + ch0_)); } \
        _Pragma("unroll") for (int i = 0; i < 4; ++i) rawv[i] = *(const v4u*)(PROJ + proj_off(mm_ + 4 * sr_ + i, PC_V + h * 256 + 8 * c8_)); } while (0)
    ML_LOADS(grp * GCM);
    MIX_LAUNDER(g_f); MIX_LAUNDER(g_i);
#pragma unroll
    for (int i = 0; i < 7; ++i) { MIX_LAUNDER(rawc[i].x); MIX_LAUNDER(rawc[i].y); MIX_LAUNDER(rawc[i].z); MIX_LAUNDER(rawc[i].w); }
#pragma unroll
    for (int i = 0; i < 4; ++i) { MIX_LAUNDER(rawv[i].x); MIX_LAUNDER(rawv[i].y); MIX_LAUNDER(rawv[i].z); MIX_LAUNDER(rawv[i].w); }
    for (int j = 0; j < GCM; ++j) {
        const int n = grp * GCM + j; const size_t m0 = (size_t)b * T + 64 * n;
        if (PASS == 0 || j == 0) MIX_SYNC();
#if !ML_PREFETCH
        if (j > 0) ML_LOADS(n);
#endif
        int tid_s = tid; MIX_LAUNDER(tid_s);
        const int sr = tid_s >> 5, c8 = tid_s & 31;
        const bool isk = c8 >= 16; const bool do_conv = (PASS == 1) || isk;
        const int cc0 = 8 * c8, d0 = cc0 & 127;
        float kv[4][8];
        if (!(DIAG & 8)) {
        if (w == 0) {
            const float lf = mix_logsig(g_f), ig = g_i;
            float bc = lf;
#pragma unroll
            for (int o = 1; o < 64; o <<= 1) { const float y = mix_shfl_up(bc, o); if (lane >= o) bc += y; }
            const float gsx = ig - bc; float pm = gsx;
#pragma unroll
            for (int o = 1; o < 64; o <<= 1) { const float y = mix_shfl_up(pm, o); if (lane >= o) pm = fmaxf(pm, y); }
            const float mr = fmaxf(m_run, pm);
            tab[MT_BCUM + lane] = bc; tab[MT_GSV + lane] = gsx; tab[MT_MROW + lane] = mr; tab[MT_WINT + lane] = __expf(m_run - mr);
            const float mr63 = mix_shfl(mr, 63), bc63 = mix_shfl(bc, 63);
            tab[MT_WEND + lane] = __expf(gsx - mr63);
            if (lane == 0) { tab[MT_SCAL + 0] = __expf(m_run - mr63); tab[MT_SCAL + 1] = bc63 + mr63; tab[MT_SCAL + 2] = bc63; }
        }
        {
            const unsigned wv[4][4] = {{rawv[0].x, rawv[0].y, rawv[0].z, rawv[0].w}, {rawv[1].x, rawv[1].y, rawv[1].z, rawv[1].w}, {rawv[2].x, rawv[2].y, rawv[2].z, rawv[2].w}, {rawv[3].x, rawv[3].y, rawv[3].z, rawv[3].w}};
#pragma unroll
            for (int i = 0; i < 4; ++i) { v2u e, o2;
                e.x = (wv[0][i] & 0xffffu) | (wv[1][i] << 16); e.y = (wv[2][i] & 0xffffu) | (wv[3][i] << 16);
                o2.x = (wv[0][i] >> 16) | (wv[1][i] & 0xffff0000u); o2.y = (wv[2][i] >> 16) | (wv[3][i] & 0xffff0000u);
                *(LAS v2u*)(Vt + o64(8 * c8 + 2 * i, 2 * (4 * sr))) = e; *(LAS v2u*)(Vt + o64(8 * c8 + 2 * i + 1, 2 * (4 * sr))) = o2; }
        }
        MIX_CFENCE();
        unsigned kq[4][4];
        if (do_conv) {
            const unsigned rw[7][4] = {{rawc[0].x, rawc[0].y, rawc[0].z, rawc[0].w}, {rawc[1].x, rawc[1].y, rawc[1].z, rawc[1].w}, {rawc[2].x, rawc[2].y, rawc[2].z, rawc[2].w}, {rawc[3].x, rawc[3].y, rawc[3].z, rawc[3].w},
                                       {rawc[4].x, rawc[4].y, rawc[4].z, rawc[4].w}, {rawc[5].x, rawc[5].y, rawc[5].z, rawc[5].w}, {rawc[6].x, rawc[6].y, rawc[6].z, rawc[6].w}};
            const float sc = isk ? 1.0f : QSCALE;
#pragma unroll
            for (int p = 0; p < 4; ++p) {
                float w0[5], w1[5];
#pragma unroll
                for (int jt = 0; jt < 5; ++jt) { const f32x2 ww = *(const LAS f32x2*)(tab + MT_CW + jt * 256 + cc0 + 2 * p); w0[jt] = ww[0]; w1[jt] = ww[1]; }
#pragma unroll
                for (int o = 0; o < 4; ++o) { float a0 = w0[4], a1 = w1[4];
#pragma unroll
                    for (int jt = 0; jt < 4; ++jt) { a0 += w0[jt] * bflo(rw[o + jt][p]); a1 += w1[jt] * bfhi(rw[o + jt][p]); }
                    a0 = mix_silu(a0); a1 = mix_silu(a1); kv[o][2 * p] = a0; kv[o][2 * p + 1] = a1; kq[o][p] = mix_cvt_pk(a0 * sc, a1 * sc); }
                MIX_CFENCE();
            }
            if (PASS == 1) { LAS unsigned char* dst = isk ? Ks : Qs;
#pragma unroll
                for (int o = 0; o < 4; ++o) { const int s = 4 * sr + o; v2u lo, hi; lo.x = kq[o][0]; lo.y = kq[o][1]; hi.x = kq[o][2]; hi.y = kq[o][3];
                    *(LAS v2u*)(dst + s * RS128 + 2 * dpos(d0)) = lo; *(LAS v2u*)(dst + s * RS128 + 2 * dpos(d0 + 4)) = hi; } }
        }
        }
        MIX_SYNC();
#if ML_PREFETCH
        if (j + 1 < GCM) ML_LOADS(n + 1);
#endif
        const float decay = tab[MT_SCAL + 0], m_new = tab[MT_SCAL + 1]; btot += tab[MT_SCAL + 2];
        const bool upd = (PASS == 0) || (j + 1 < GCM);
        if (isk && upd && !(DIAG & 8)) { const f32x4 we = *(const LAS f32x4*)(tab + MT_WEND + 4 * sr);
#pragma unroll
            for (int i = 0; i < 8; ++i) { v2u q; q.x = mix_cvt_pk(kv[0][i] * we[0], kv[1][i] * we[1]); q.y = mix_cvt_pk(kv[2][i] * we[2], kv[3][i] * we[3]); *(LAS v2u*)(Kwt + o64(d0 + i, 2 * (4 * sr))) = q; } }
        if (PASS == 0) MIX_SYNC();
        int cm = c, gm = g; MIX_LAUNDER(cm); MIX_LAUNDER(gm);
        bf16x8 Av[2][2];
#pragma unroll
        for (int vt = 0; vt < 2; ++vt)
#pragma unroll
            for (int ks = 0; ks < 2; ++ks) Av[vt][ks] = ldfrag(Vt + o64(32 * w + 16 * vt + cm, (32 * ks + 8 * gm) * 2));
        if (PASS == 1 && !(DIAG & 2)) {
            const int ce = cm, ge = gm;
            {
                const int ti = w >> 1;
#pragma unroll
                for (int q2 = 0; q2 < 2; ++q2) { const int sj = 2 * (w & 1) + q2; f32x4 acc = (f32x4){0.f, 0.f, 0.f, 0.f};
                    if (sj <= ti) {
#pragma unroll
                        for (int ks = 0; ks < 4; ++ks) acc = MFMA16(ldfrag(Qs + (16 * ti + cm) * RS128 + (32 * ks + 8 * gm) * 2), ldfrag(Ks + (16 * sj + cm) * RS128 + (32 * ks + 8 * gm) * 2), acc);
                    }
                    const int s = 16 * sj + cm; const float gsx = tab[MT_GSV + s];
#pragma unroll
                    for (int r = 0; r < 4; ++r) { const int t = 16 * ti + 4 * gm + r; const float v = (s <= t) ? acc[r] * __expf(gsx - tab[MT_MROW + t]) : 0.f; st_bf16(Ss + t * RS64 + 2 * s, v); } }
            }
            f32x4 acc1[2][4];
#pragma unroll
            for (int vt = 0; vt < 2; ++vt)
#pragma unroll
                for (int tt = 0; tt < 4; ++tt) acc1[vt][tt] = (f32x4){0.f, 0.f, 0.f, 0.f};
#pragma unroll
            for (int ks = 0; ks < 4; ++ks) { const bf16x8 A0 = pack_pair(Cst[0][2 * ks], Cst[0][2 * ks + 1]), A1 = pack_pair(Cst[1][2 * ks], Cst[1][2 * ks + 1]);
#pragma unroll
                for (int tt = 0; tt < 4; ++tt) { const bf16x8 Bq = ldfrag(Qs + (16 * tt + cm) * RS128 + (32 * ks + 8 * gm) * 2);
                    acc1[0][tt] = MFMA16(A0, Bq, acc1[0][tt]); acc1[1][tt] = MFMA16(A1, Bq, acc1[1][tt]); } MIX_CFENCE(); }
            MIX_SYNC();
            {
                const int t = tid >> 3, part = tid & 7; float p1 = 0.f, p2 = 0.f;
#pragma unroll
                for (int i = 0; i < 8; ++i) p1 += ld_bf16(Ss + t * RS64 + 2 * (8 * part + i));
#pragma unroll
                for (int i = 0; i < 16; ++i) p2 += ld_bf16(Qs + t * RS128 + 2 * (16 * part + i)) * tab[MT_NP + 16 * part + i];
                float den = p1 + tab[MT_WINT + t] * p2;
                den += mix_shfl_xor(den, 1); den += mix_shfl_xor(den, 2); den += mix_shfl_xor(den, 4);
                if (part == 0) tab[MT_RDEN + t] = mix_rcp(fmaxf(fabsf(den), __expf(-(tab[MT_BCUM + t] + tab[MT_MROW + t]))));
            }
#pragma unroll
            for (int tt = 0; tt < 4; ++tt) { const float wi = tab[MT_WINT + 16 * tt + cm]; acc1[0][tt] = acc1[0][tt] * wi; acc1[1][tt] = acc1[1][tt] * wi; }
#pragma unroll
            for (int tt = 0; tt < 4; ++tt)
#pragma unroll
                for (int ks = 0; ks < 2; ++ks) { if (ks == 1 && tt < 2) continue;
                    const bf16x8 Bs = ldfrag(Ss + (16 * tt + cm) * RS64 + (32 * ks + 8 * gm) * 2);
                    acc1[0][tt] = MFMA16(Av[0][ks], Bs, acc1[0][tt]); acc1[1][tt] = MFMA16(Av[1][ks], Bs, acc1[1][tt]); MIX_CFENCE(); }
            if (!(DIAG & 1)) {
            v2u ogv[4][2];
#pragma unroll
            for (int tt = 0; tt < 4; ++tt)
#pragma unroll
                for (int vt = 0; vt < 2; ++vt) ogv[tt][vt] = (DIAG & 32) ? (v2u){0x3f803f80u, 0x3f803f80u} : *(const v2u*)(PROJ + proj_off(m0 + 16 * tt + ce, PC_O + h * 256 + 32 * w + 16 * vt + 4 * ge));
            MIX_SYNC();
            float s1[4], s2[4];
#pragma unroll
            for (int tt = 0; tt < 4; ++tt) { const int t = 16 * tt + ce; const float rd = tab[MT_RDEN + t]; s1[tt] = 0.f; s2[tt] = 0.f;
#pragma unroll
                for (int vt = 0; vt < 2; ++vt) { acc1[vt][tt] = acc1[vt][tt] * rd;
#pragma unroll
                    for (int r = 0; r < 4; ++r) { const float x = acc1[vt][tt][r]; s1[tt] += x; s2[tt] += x * x; } }
                s1[tt] += mix_shfl_xor(s1[tt], 16); s1[tt] += mix_shfl_xor(s1[tt], 32); s2[tt] += mix_shfl_xor(s2[tt], 16); s2[tt] += mix_shfl_xor(s2[tt], 32);
                if (ge == 0) { tab[MT_HNP + (w * 64 + t) * 2] = s1[tt]; tab[MT_HNP + (w * 64 + t) * 2 + 1] = s2[tt]; } }
            MIX_SYNC();
            float mean4[4], rstd4[4];
#pragma unroll
            for (int tt = 0; tt < 4; ++tt) { f32x2 pr[8];
#pragma unroll
                for (int ww = 0; ww < 8; ++ww) pr[ww] = *(const LAS f32x2*)(tab + MT_HNP + (ww * 64 + 16 * tt + ce) * 2);
                float a1 = 0.f, a2 = 0.f;
#pragma unroll
                for (int ww = 0; ww < 8; ++ww) { a1 += pr[ww][0]; a2 += pr[ww][1]; }
                mean4[tt] = a1 * (1.f / 256.f); rstd4[tt] = mix_rsq(fmaxf(a2 * (1.f / 256.f) - mean4[tt] * mean4[tt], 0.f) + LN_EPS); MIX_CFENCE(); }
            f32x4 wn2[2];
#pragma unroll
            for (int vt = 0; vt < 2; ++vt) wn2[vt] = *(const LAS f32x4*)(tab + MT_NW + 32 * w + 16 * vt + 4 * ge);
#pragma unroll
            for (int tt = 0; tt < 4; ++tt) { const int t = 16 * tt + ce; const float mean = mean4[tt], rstd = rstd4[tt];
#pragma unroll
                for (int vt = 0; vt < 2; ++vt) { const int v0 = 32 * w + 16 * vt + 4 * ge;
                    const v2u og = ogv[tt][vt]; const f32x4 wn = wn2[vt];
                    const f32x4 x = acc1[vt][tt];
                    v2u o; o.x = mix_cvt_pk((x[0] - mean) * rstd * wn[0] * MIX_OG(bflo(og.x)), (x[1] - mean) * rstd * wn[1] * MIX_OG(bfhi(og.x)));
                    o.y = mix_cvt_pk((x[2] - mean) * rstd * wn[2] * MIX_OG(bflo(og.y)), (x[3] - mean) * rstd * wn[3] * MIX_OG(bfhi(og.y)));
                    if (!(DIAG & 16)) *(v2u*)(YMIX + (m0 + t) * 2048 + h * 256 + v0) = o; else asm volatile("" :: "v"(o)); } MIX_CFENCE(); }
        }
        }
        if (upd && !(DIAG & 4)) {
#pragma unroll
        for (int dt = 0; dt < 8; ++dt) {
            const bf16x8 K0 = ldfrag(Kwt + o64(16 * dt + cm, (8 * gm) * 2)), K1 = ldfrag(Kwt + o64(16 * dt + cm, (32 + 8 * gm) * 2));
#pragma unroll
            for (int vt = 0; vt < 2; ++vt) { f32x4 a = Cst[vt][dt] * decay; a = MFMA16(K0, Av[vt][0], a); a = MFMA16(K1, Av[vt][1], a); Cst[vt][dt] = a; }
            if (dt & 1) MIX_CFENCE();
        }
        if (tid < 128) { float sum = 0.f;
#pragma unroll
            for (int i = 0; i < 64; ++i) sum += ld_bf16(Kwt + tid * RS64 + 2 * i);
            tab[MT_NP + dpos(tid)] = decay * tab[MT_NP + dpos(tid)] + sum; }
        }
        m_run = m_new;
    }
    if (PASS == 0) {
        MIX_SYNC();
        mst_t* gs = MB.GSM + (size_t)unit * 32768;
#pragma unroll
        for (int vt = 0; vt < 2; ++vt)
#pragma unroll
            for (int dt = 0; dt < 8; ++dt) st_st4(gs + (size_t)(32 * w + 16 * vt + c) * 128 + 16 * dt + 4 * g, Cst[vt][dt]);
        if (tid < 128) MB.GSN[(size_t)unit * 128 + tid] = tab[MT_NP + dpos(tid)];
        if (tid == 0) { MB.GSS[unit * 4 + 0] = m_run; MB.GSS[unit * 4 + 1] = btot; }
    }
#undef ML_LOADS
}

constexpr int HG_QT = 0, HG_QH = 18432, HG_KTI = 36864, HG_KE = 82944, HG_VT = 103424, HG_AS = 123904, HG_TAB = 134144;
constexpr int HT_TOT = 0, HT_DEC = 1024, HT_BTOT = 1152, HT_HNP = 1280, HT_LB = 1792, HT_NW = 1920, HT_END = 2048;
constexpr int HG_LDS_END = HG_TAB + HT_END * 4;
#ifndef MIX_WARM
#define MIX_WARM 0
#endif
MIXDEV unsigned hg_warm(const bf16* PROJ, int unit, int step, int lane, int w, bool pass_c) {
    const int b = unit / (8 * NGH), h = (unit / NGH) & 7, grp = unit % NGH, tsel = w >> 1;
    const int col = ((tsel == 0) ? PC_FH : (tsel == 1) ? PC_QH : (tsel == 2) ? PC_IH : PC_GH) + h * 128 + (w & 1) * 64;
    unsigned v = 0;
    if (pass_c || !(tsel & 1)) v = *(const unsigned*)(PROJ + proj_off((size_t)b * T + 64 * (grp * GCH + step) + lane, col));
    return v;
}
template <int PASS, int DIAG = 0>
MIXDEV void hgrn_unit(LAS unsigned char* lds, int tid, int lane, int w, int unit, const bf16* PROJ, const float* lbl, const float* hnw, MixBuf MB, bf16* YMIX, int next_unit = -1) {
    const int b = unit / (8 * NGH), h = (unit / NGH) & 7, grp = unit % NGH;
    const int c = lane & 15, g = lane >> 4;
    LAS unsigned char* Qt = lds + HG_QT; LAS unsigned char* Qh = lds + HG_QH; LAS unsigned char* Kti = lds + HG_KTI; LAS unsigned char* Ke = lds + HG_KE; LAS unsigned char* Vt = lds + HG_VT; LAS unsigned char* As = lds + HG_AS;
    LAS float* tab = (LAS float*)(lds + HG_TAB);
    f32x4 Sst[8];
    MIX_SYNC();
    if (tid < 128) { tab[HT_LB + tid] = lbl[h * 128 + tid]; tab[HT_NW + tid] = hnw[h * 128 + tid]; }
    if (PASS == 0) {
#pragma unroll
        for (int dt = 0; dt < 8; ++dt) Sst[dt] = (f32x4){0.f, 0.f, 0.f, 0.f};
        if (tid < 128) tab[HT_BTOT + tid] = 0.f;
    } else {
        const mst_t* gs = MB.GSH + (size_t)unit * 16384;
#pragma unroll
        for (int dt = 0; dt < 8; ++dt) Sst[dt] = ld_st4(gs + (size_t)(16 * w + c) * 128 + 16 * dt + 4 * g);
        for (int i = tid; i < 2 * 16 * 16; i += NTHR) { const int which = i >> 8, r = (i >> 4) & 15, cc = i & 15; *(LAS unsigned short*)(As + (32 * which + r) * RS64 + 2 * (32 * which + 16 + cc)) = 0; }
    }
    unsigned rawf[8], rawq[8]; v4u rawv[2];
#define HG_LOADS(mrow_) do { if (DIAG & 64) { unsigned z_ = 0x3f003f00u; MIX_LAUNDER(z_); _Pragma("unroll") for (int i = 0; i < 8; ++i) { rawf[i] = z_; rawq[i] = z_; } rawv[0] = (v4u){z_, z_, z_, z_}; rawv[1] = rawv[0]; break; } int t_ = tid; MIX_LAUNDER(t_); const int r8_ = t_ >> 6, d_ = 2 * (t_ & 63), sr2_ = t_ >> 4, cv_ = t_ & 15; \
        _Pragma("unroll") for (int i = 0; i < 8; ++i) { const size_t ro_ = (mrow_) + 8 * r8_ + i; rawf[i] = *(const unsigned*)(PROJ + proj_off(ro_, PC_FH + h * 128 + d_)); rawq[i] = (PASS == 1) ? *(const unsigned*)(PROJ + proj_off(ro_, PC_QH + h * 128 + d_)) : 0u; } \
        _Pragma("unroll") for (int i = 0; i < 2; ++i) rawv[i] = *(const v4u*)(PROJ + proj_off((mrow_) + 2 * sr2_ + i, PC_IH + h * 128 + 8 * cv_)); } while (0)
    HG_LOADS((size_t)b * T + 64 * (grp * GCH));
#pragma unroll
    for (int i = 0; i < 8; ++i) { MIX_LAUNDER(rawf[i]); MIX_LAUNDER(rawq[i]); }
    MIX_LAUNDER(rawv[0].x); MIX_LAUNDER(rawv[0].y); MIX_LAUNDER(rawv[0].z); MIX_LAUNDER(rawv[0].w); MIX_LAUNDER(rawv[1].x); MIX_LAUNDER(rawv[1].y); MIX_LAUNDER(rawv[1].z); MIX_LAUNDER(rawv[1].w);
    unsigned warm = 0;
    for (int j = 0; j < GCH; ++j) {
        const int n = grp * GCH + j; const size_t m0 = (size_t)b * T + 64 * n;
        if (PASS == 0 || j == 0) MIX_SYNC();
        int tid_s = tid; MIX_LAUNDER(tid_s);
        const int r8 = tid_s >> 6, dp = tid_s & 63, d = 2 * dp, tq = r8 >> 1, sr2 = tid_s >> 4, cv = tid_s & 15;
        const f32x2 lbv = *(const LAS f32x2*)(tab + HT_LB + d);
        float loc[2][8], kk[2][8], qq[2][8];
        {
            float run0 = 0.f, run1 = 0.f;
#pragma unroll
            for (int i = 0; i < 8; ++i) {
                const float fp0 = fmaxf(bflo(rawf[i]), -80.f), fp1 = fmaxf(bfhi(rawf[i]), -80.f);
                const float ef0 = __expf(-fp0), ef1 = __expf(-fp1), sg0 = mix_rcp(1.0f + ef0), sg1 = mix_rcp(1.0f + ef1), sn0 = ef0 * sg0, sn1 = ef1 * sg1;
                run0 += mix_log(lbv[0] + (1.0f - lbv[0]) * sg0); run1 += mix_log(lbv[1] + (1.0f - lbv[1]) * sg1);
                loc[0][i] = run0; loc[1][i] = run1; kk[0][i] = (1.0f - lbv[0]) * sn0; kk[1][i] = (1.0f - lbv[1]) * sn1;
                qq[0][i] = (PASS == 1) ? MIX_GQ(bflo(rawq[i])) : 0.f; qq[1][i] = (PASS == 1) ? MIX_GQ(bfhi(rawq[i])) : 0.f; }
            *(LAS f32x2*)(tab + HT_TOT + r8 * 128 + d) = (f32x2){run0, run1};
        }
        {
            const unsigned w0[4] = {rawv[0].x, rawv[0].y, rawv[0].z, rawv[0].w}, w1[4] = {rawv[1].x, rawv[1].y, rawv[1].z, rawv[1].w};
#pragma unroll
            for (int i = 0; i < 4; ++i) { *(LAS unsigned*)(Vt + o64(8 * cv + 2 * i, 2 * (2 * sr2))) = (w0[i] & 0xffffu) | (w1[i] << 16); *(LAS unsigned*)(Vt + o64(8 * cv + 2 * i + 1, 2 * (2 * sr2))) = (w0[i] >> 16) | (w1[i] & 0xffff0000u); }
        }
        if (j + 1 < GCH) HG_LOADS(m0 + 64);
#if MIX_WARM
        if (!(DIAG & 64)) { asm volatile("" :: "v"(warm));
            int tu = unit, ts = j + 2; if (ts >= GCH) { tu = next_unit; ts -= GCH; }
            if (tu >= 0) warm = hg_warm(PROJ, tu, ts, lane, w, PASS == 1); }
#endif
        MIX_SYNC();
        {
            const int pd = dpos(d);
            float R[2][5], Rq[2], dl[2];
#pragma unroll
            for (int e = 0; e < 2; ++e) { R[e][0] = 0.f;
#pragma unroll
                for (int q = 0; q < 4; ++q) R[e][q + 1] = R[e][q] + (tab[HT_TOT + (2 * q) * 128 + d + e] + tab[HT_TOT + (2 * q + 1) * 128 + d + e]);
                Rq[e] = 0.f;
#pragma unroll
                for (int q = 0; q < 4; ++q) if (q == tq) Rq[e] = R[e][q];
                const float off = (r8 & 1) ? tab[HT_TOT + (r8 - 1) * 128 + d + e] : 0.f;
#pragma unroll
                for (int i = 0; i < 8; ++i) loc[e][i] += off;
                dl[e] = R[e][4] - Rq[e]; }
            if (r8 == 0) { *(LAS f32x2*)(tab + HT_DEC + d) = (f32x2){__expf(R[0][4]), __expf(R[1][4])}; if (PASS == 0) { tab[HT_BTOT + d] += R[0][4]; tab[HT_BTOT + d + 1] += R[1][4]; } }
            float el[2][8], eli[2][8], Fq[2], Fe[2], Ft[2][4];
#pragma unroll
            for (int e = 0; e < 2; ++e) { Fq[e] = __expf(Rq[e]); Fe[e] = __expf(dl[e]);
#pragma unroll
                for (int ti = 0; ti < 4; ++ti) Ft[e][ti] = __expf(fminf(R[e][ti] - Rq[e], 0.f));
#pragma unroll
                for (int i = 0; i < 8; ++i) { el[e][i] = fmaxf(__expf(loc[e][i]), 1.0e-30f); eli[e][i] = mix_rcp(el[e][i]); } }
            if (PASS == 0 || j + 1 < GCH)
#pragma unroll
            for (int e = 0; e < 2; ++e) { float ke[8];
#pragma unroll
                for (int i = 0; i < 8; ++i) ke[i] = kk[e][i] * eli[e][i] * Fe[e];
                v4u q4; q4.x = mix_cvt_pk(ke[0], ke[1]); q4.y = mix_cvt_pk(ke[2], ke[3]); q4.z = mix_cvt_pk(ke[4], ke[5]); q4.w = mix_cvt_pk(ke[6], ke[7]);
                *(LAS v4u*)(Ke + o64(d + e, 2 * (8 * r8))) = q4; }
            if (PASS == 1) {
#pragma unroll
                for (int i = 0; i < 8; ++i) { const int s = 8 * r8 + i, sl = 8 * (r8 & 1) + i;
                    const float qt0 = qq[0][i] * el[0][i], qt1 = qq[1][i] * el[1][i], kb0 = kk[0][i] * eli[0][i], kb1 = kk[1][i] * eli[1][i];
                    *(LAS unsigned*)(Qt + s * RS128 + 2 * pd) = mix_cvt_pk(qt0, qt1);
                    *(LAS unsigned*)(Qh + s * RS128 + 2 * pd) = mix_cvt_pk(qt0 * Fq[0], qt1 * Fq[1]);
#pragma unroll
                    for (int ti = 0; ti < 4; ++ti) if (ti >= tq) *(LAS unsigned*)(Kti + ((ti * (ti + 1) / 2 + tq) * 16 + sl) * RS128 + 2 * pd) = mix_cvt_pk(kb0 * Ft[0][ti], kb1 * Ft[1][ti]); }
            }
        }
        MIX_SYNC();
        bf16x8 Av[2];
#pragma unroll
        for (int ks = 0; ks < 2; ++ks) Av[ks] = ldfrag(Vt + o64(16 * w + c, (32 * ks + 8 * g) * 2));
        if (PASS == 1) {
            int ce = c, ge = g; MIX_LAUNDER(ce); MIX_LAUNDER(ge);
            v2u ggv[4];
#pragma unroll
            for (int tt = 0; tt < 4; ++tt) ggv[tt] = (DIAG & 32) ? (v2u){0x3f803f80u, 0x3f803f80u} : *(const v2u*)(PROJ + proj_off(m0 + 16 * tt + ce, PC_GH + h * 128 + 16 * w + 4 * ge));
#pragma unroll 1
            for (int tile = w; tile < 10; tile += 8) {
                const int ti = (tile >= 6) ? 3 : (tile >= 3) ? 2 : (tile >= 1) ? 1 : 0, si = tile - ti * (ti + 1) / 2;
                f32x4 acc = (f32x4){0.f, 0.f, 0.f, 0.f};
#pragma unroll
                for (int ks = 0; ks < 4; ++ks) acc = MFMA16(ldfrag(Qt + (16 * ti + c) * RS128 + (32 * ks + 8 * g) * 2), ldfrag(Kti + (tile * 16 + c) * RS128 + (32 * ks + 8 * g) * 2), acc);
#pragma unroll
                for (int r = 0; r < 4; ++r) { const float v = (ti != si || c <= 4 * g + r) ? acc[r] : 0.f; st_bf16(As + (16 * ti + 4 * g + r) * RS64 + 2 * (16 * si + c), v); }
            }
            MIX_SYNC();
            f32x4 acc[4];
#pragma unroll
            for (int tt = 0; tt < 4; ++tt) acc[tt] = (f32x4){0.f, 0.f, 0.f, 0.f};
#pragma unroll
            for (int tt = 0; tt < 4; ++tt)
#pragma unroll
                for (int ks = 0; ks < 2; ++ks) { if (ks == 1 && tt < 2) continue;
                    acc[tt] = MFMA16(Av[ks], ldfrag(As + (16 * tt + c) * RS64 + (32 * ks + 8 * g) * 2), acc[tt]); }
#pragma unroll
            for (int ks = 0; ks < 4; ++ks) { const bf16x8 A0 = pack_pair(Sst[2 * ks], Sst[2 * ks + 1]);
#pragma unroll
                for (int tt = 0; tt < 4; ++tt) acc[tt] = MFMA16(A0, ldfrag(Qh + (16 * tt + c) * RS128 + (32 * ks + 8 * g) * 2), acc[tt]); }
#pragma unroll
            for (int tt = 0; tt < 4; ++tt) { const int t = 16 * tt + ce; float s2 = 0.f;
#pragma unroll
                for (int r = 0; r < 4; ++r) s2 += acc[tt][r] * acc[tt][r];
                s2 += mix_shfl_xor(s2, 16); s2 += mix_shfl_xor(s2, 32);
                if (ge == 0) tab[HT_HNP + w * 64 + t] = s2; }
            MIX_SYNC();
            float rstd4[4];
#pragma unroll
            for (int tt = 0; tt < 4; ++tt) { float pr[8];
#pragma unroll
                for (int ww = 0; ww < 8; ++ww) pr[ww] = tab[HT_HNP + ww * 64 + 16 * tt + ce];
                float a2 = 0.f;
#pragma unroll
                for (int ww = 0; ww < 8; ++ww) a2 += pr[ww];
                rstd4[tt] = mix_rsq(a2 * (1.f / 128.f) + LN_EPS); MIX_CFENCE(); }
            const f32x4 wn = *(const LAS f32x4*)(tab + HT_NW + 16 * w + 4 * ge);
#pragma unroll
            for (int tt = 0; tt < 4; ++tt) { const int t = 16 * tt + ce; const float rstd = rstd4[tt]; const int v0 = 16 * w + 4 * ge;
                const v2u gg = ggv[tt];
                const f32x4 x = acc[tt];
                v2u o; o.x = mix_cvt_pk(x[0] * rstd * wn[0] * MIX_GQ(bflo(gg.x)), x[1] * rstd * wn[1] * MIX_GQ(bfhi(gg.x))); o.y = mix_cvt_pk(x[2] * rstd * wn[2] * MIX_GQ(bflo(gg.y)), x[3] * rstd * wn[3] * MIX_GQ(bfhi(gg.y)));
                if (!(DIAG & 16)) *(v2u*)(YMIX + (m0 + t) * 2048 + 1024 + h * 128 + v0) = o; else asm volatile("" :: "v"(o)); }
        }
        if (PASS == 0 || j + 1 < GCH)
#pragma unroll
        for (int dt = 0; dt < 8; ++dt) { const f32x4 dc = *(const LAS f32x4*)(tab + HT_DEC + 16 * dt + 4 * g);
            f32x4 a = Sst[dt] * dc;
            a = MFMA16(ldfrag(Ke + o64(16 * dt + c, (8 * g) * 2)), Av[0], a); a = MFMA16(ldfrag(Ke + o64(16 * dt + c, (32 + 8 * g) * 2)), Av[1], a); Sst[dt] = a; }
    }
    if (PASS == 0) {
        MIX_SYNC();
        mst_t* gs = MB.GSH + (size_t)unit * 16384;
#pragma unroll
        for (int dt = 0; dt < 8; ++dt) st_st4(gs + (size_t)(16 * w + c) * 128 + 16 * dt + 4 * g, Sst[dt]);
        if (tid < 128) MB.GHD[(size_t)unit * 128 + tid] = tab[HT_BTOT + tid];
    }
#if MIX_WARM
    asm volatile("" :: "v"(warm));
#endif
#undef HG_LOADS
}
MIXDEV void mix_scan(int gt  , MixBuf MB) {
    constexpr int SB = (NGM % 8 == 0) ? 8 : 1, SBH = (NGH % 8 == 0) ? 8 : 1;
    float z0 = 0.f; MIX_LAUNDER(z0);
    if (gt < 65536) {
        const int seq = gt >> 13, e4 = gt & 8191;
        f32x4 run = (f32x4){z0, z0, z0, z0}, nrun = run; float mrun = 0.f;
        const bool don = e4 < 32;
        for (int g0 = 0; g0 < NGM; g0 += SB) {
            f32x4 tmp[SB], tn[SB]; float mg[SB], bt[SB];
#pragma unroll
            for (int k = 0; k < SB; ++k) { const int unit = seq * NGM + g0 + k; tmp[k] = ld_st4(MB.GSM + (size_t)unit * 32768 + 4 * e4); mg[k] = MB.GSS[unit * 4 + 0]; bt[k] = MB.GSS[unit * 4 + 1];
                tn[k] = don ? *((const f32x4*)(MB.GSN + (size_t)unit * 128) + e4) : (f32x4){z0, z0, z0, z0}; }
#pragma unroll
            for (int k = 0; k < SB; ++k) { const int unit = seq * NGM + g0 + k;
                st_st4(MB.GSM + (size_t)unit * 32768 + 4 * e4, run);
                const float mn = fmaxf(bt[k] + mrun, mg[k]), sa = __expf(bt[k] + mrun - mn), sg = __expf(mg[k] - mn);
                run = run * sa + tmp[k] * sg;
                if (don) { *((f32x4*)(MB.GSN + (size_t)unit * 128) + e4) = nrun; nrun = nrun * sa + tn[k] * sg; }
                if (e4 == 0) MB.GSS[unit * 4 + 2] = mrun;
                mrun = mn; }
        }
    } else {
        const int q = gt - 65536, seq = q >> 12, e4 = q & 4095, d4 = e4 & 31;
        f32x4 run = (f32x4){z0, z0, z0, z0};
        for (int g0 = 0; g0 < NGH; g0 += SBH) {
            f32x4 tmp[SBH], ld[SBH];
#pragma unroll
            for (int k = 0; k < SBH; ++k) { const int unit = seq * NGH + g0 + k; tmp[k] = ld_st4(MB.GSH + (size_t)unit * 16384 + 4 * e4); ld[k] = *((const f32x4*)(MB.GHD + (size_t)unit * 128) + d4); }
#pragma unroll
            for (int k = 0; k < SBH; ++k) { const int unit = seq * NGH + g0 + k;
                st_st4(MB.GSH + (size_t)unit * 16384 + 4 * e4, run);
                run[0] = run[0] * __expf(ld[k][0]) + tmp[k][0]; run[1] = run[1] * __expf(ld[k][1]) + tmp[k][1]; run[2] = run[2] * __expf(ld[k][2]) + tmp[k][2]; run[3] = run[3] * __expf(ld[k][3]) + tmp[k][3]; }
        }
    }
}
constexpr int NPL = 9, NPH = 2 + NPL * DEPTH;
struct Args { const float* in[20]; float* out; unsigned char* ws; int ph_lo, ph_hi; };
__global__ void __launch_bounds__(NTHR, 2) fwd(Args args) {
    extern __shared__ __attribute__((aligned(16))) unsigned char lds_raw[];
    LAS unsigned char* lds = (LAS unsigned char*)lds_raw;
    const int tid0 = threadIdx.x, G = gridDim.x;
#if CODE_SHIFT_NOPS > 0
    asm volatile(".fill " CODE_SHIFT_STR ", 4, 0xBF800000");
#endif
    int wave0 = __builtin_amdgcn_readfirstlane(tid0 >> 6); asm volatile("" : "+s"(wave0));
#define PHASE_IDS() int tid; asm volatile("v_mbcnt_lo_u32_b32 %0, -1, 0\n\tv_mbcnt_hi_u32_b32 %0, -1, %0" : "=v"(tid)); tid |= (wave0 << 6); asm volatile("" : "+v"(tid));     const int lane = tid & 63, wave = __builtin_amdgcn_readfirstlane(tid >> 6); (void)lane; (void)wave
    Ptrs P;
    P.x = args.in[0]; P.c = args.in[1]; P.w_mod = args.in[2]; P.b_mod = args.in[3]; P.w_in = args.in[4]; P.conv_w = args.in[5]; P.conv_b = args.in[6]; P.b_ig = args.in[7]; P.b_fg = args.in[8];
    P.mnorm_w = args.in[9]; P.hnorm_w = args.in[10]; P.lb_logits = args.in[11]; P.w_out = args.in[12]; P.ln1_g = args.in[13]; P.ln1_b = args.in[14]; P.w_gate = args.in[15]; P.w_up = args.in[16];
    P.w_down = args.in[17]; P.ln2_g = args.in[18]; P.ln2_b = args.in[19]; P.out = args.out; P.ws = args.ws;
    volatile LAS unsigned* MISC = (volatile LAS unsigned*)(lds + MISC_OFF);
    if (tid0 < 32) MISC[tid0] = 0u;
    __syncthreads();
#if MK_ONE_LAUNCH
    XcdBarrier bar = xcd_barrier_post((unsigned*)(P.ws + WS_CTL) + CW_BAR, MISC + 8);
#define SEAM() xcd_barrier(bar)
#else
#define SEAM() do { } while (0)
#endif
    const int lo = args.ph_lo, hi = args.ph_hi;
#define IN(k) (lo <= (k) && (k) < hi)
#if XCD_AFFINE
#define MIX_UM(v_) ((G == 256 && NGM == 32) ? ((((v_) & 7) >> 2) * (4 * NGM) + ((v_) >> 6) * NGM + ((v_) & 3) * 8 + (((v_) >> 3) & 7)) : (v_))
#define MIX_UH(v_) ((G == 256 && NGH == 32) ? ((((v_) & 7) >> 2) * (8 * NGH) + ((((v_) >> 6) & 3) + 4 * ((v_) >> 8)) * NGH + ((v_) & 3) * 8 + (((v_) >> 3) & 7)) : (v_))
#else
#define MIX_UM(v_) (v_)
#define MIX_UH(v_) (v_)
#endif
#define GEMM_SKEW() do { if (GEMM_SKEW_TICKS > 0) { const unsigned long long t0_ = __builtin_amdgcn_s_memrealtime(), dl_ = (unsigned long long)(blockIdx.x & 7) * GEMM_SKEW_TICKS; while (__builtin_amdgcn_s_memrealtime() - t0_ < dl_) __builtin_amdgcn_s_sleep(2); } } while (0)
#if PROBE_MASK_A || PROBE_MASK_R
    unsigned* TSW = (unsigned*)(P.ws + WS_CTL) + 2048;
    unsigned long long* TS64 = (unsigned long long*)(TSW + 32);
    if (blockIdx.x == 0 && tid0 == 0) { TS64[0] = __builtin_amdgcn_s_memrealtime(); TS64[1] = __builtin_amdgcn_s_memtime(); TS64[2] = TS64[0]; }
#define PROBE_TICK(k) do { if (blockIdx.x == 0 && tid0 == 0) { const unsigned long long now_ = __builtin_amdgcn_s_memrealtime(); const int ty_ = ((k) == 0) ? 0 : 1 + ((k) - 1) % NPL; \
        __hip_atomic_store(TSW + ty_, __hip_atomic_load(TSW + ty_, __ATOMIC_RELAXED, __HIP_MEMORY_SCOPE_AGENT) + (unsigned)(now_ - TS64[0]), __ATOMIC_RELAXED, __HIP_MEMORY_SCOPE_AGENT); TS64[0] = now_; } } while (0)
#else
#define PROBE_TICK(k) do { } while (0)
#endif
#define SEAM_AFTER(k) do { if ((k) + 1 < hi) { SEAM(); PROBE_TICK(k); } } while (0)
    float* MOD = (float*)(P.ws + WS_MOD); bf16* X = (bf16*)(P.ws + WS_X); bf16* U = (bf16*)(P.ws + WS_U); bf16* YMIX = (bf16*)(P.ws + WS_YMIX); bf16* PROJ = (bf16*)(P.ws + WS_PROJ); bf16* HB = (bf16*)(P.ws + WS_PROJ);
    float* GT = (float*)(P.ws + WS_GATES); bf16* YB = (bf16*)(P.ws + WS_YB);
    MixBuf MB; MB.GSM = (mst_t*)(P.ws + WS_GSM); MB.GSN = (float*)(P.ws + WS_GSN); MB.GSS = (float*)(P.ws + WS_GSS); MB.GSH = (mst_t*)(P.ws + WS_GSH); MB.GHD = (float*)(P.ws + WS_GHD);

#ifndef SKIP_PRO
    if (IN(0)) { PHASE_IDS(); phase_prologue(P, lds, tid, lane, wave, G);
#if DUP_MASK & 1
        __syncthreads(); phase_prologue(P, lds, tid, lane, wave, G);
#endif
        SEAM_AFTER(0); }
#endif

    for (int l = 0; l < DEPTH; ++l) {
        const int base = 1 + NPL * l;
        if (base + NPL <= lo || base >= hi) continue;
#if DUP_MASK & 32768
        for (int xb_ = 0; xb_ < 10; ++xb_) { SEAM(); }
#endif
        const float* modl = MOD + (size_t)l * 2 * NMODC;
#ifndef SKIP_P0
        if (IN(base + 0)) {
            PHASE_IDS();
            const float* gwl = (const float*)(P.ws + WS_GW) + (size_t)l * 8 * D;
            if (l == 0) phase_rows<false, true, true, false, true>(lds, tid, lane, wave, G, P.x, nullptr, X, nullptr, nullptr, U, modl + 1 * D, modl + 0 * D, gwl, P.b_ig + l * 4, P.b_fg + l * 4, GT);
            else        phase_rows<true, true, true, true, true>(lds, tid, lane, wave, G, X, YB, X, P.ln2_g + (l - 1) * D, P.ln2_b + (l - 1) * D, U, modl + 1 * D, modl + 0 * D, gwl, P.b_ig + l * 4, P.b_fg + l * 4, GT);
            SEAM_AFTER(base + 0);
        }
#endif
#ifndef SKIP_P1
        if (IN(base + 1)) {
            PHASE_IDS();
            GEMM_SKEW();
            pg8::Gemm g{U, (const bf16*)(P.ws + WS_WIN) + (size_t)l * NPROJ * D, M, NPROJ, D}; pg8::StaticOrder S; S.init(M, NPROJ, G, (int)blockIdx.x, GIN_CMAP);
            pg8::EpiProj E{PROJ, NPROJ, (size_t)M * 128};
            pg8::gemm_phase<pg8::EpiProj, pg8::StaticOrder, GEMM_ALIGN, GEMM_SP2>(lds, g, S, E, tid);
#if DUP_MASK & 2
            __syncthreads(); pg8::gemm_phase<pg8::EpiProj, pg8::StaticOrder, GEMM_ALIGN, GEMM_SP2>(lds, g, S, E, tid);
#endif
#if DUP_MASK & 256
            { __syncthreads(); struct FixedOrder { int n; __device__ bool next(int i, pg8::Unit& u) const { u.pm = 0; u.pn = 0; return i < n; } __device__ void a_ready(const pg8::Unit&) const {} __device__ void done(const pg8::Unit&) const {} } S0{7};
              pg8::EpiNull E0{(bf16*)(P.ws + WS_HRAW) + (size_t)blockIdx.x * 65536, 0}; pg8::gemm_phase<pg8::EpiNull, FixedOrder, true, true>(lds, g, S0, E0, tid); }
#endif
#if DUP_MASK & 64
            { __syncthreads(); pg8::EpiNull E0{(DUP_MASK & 65536) ? (bf16*)(P.ws + WS_HRAW) : (bf16*)(P.ws + WS_HRAW) + (size_t)blockIdx.x * 65536, (DUP_MASK & 65536) ? 3 : (DUP_MASK & 512) ? 2 : (DUP_MASK & 128) ? 1 : 0}; pg8::gemm_phase<pg8::EpiNull, pg8::StaticOrder, true, true>(lds, g, S, E0, tid); }
#endif
            SEAM_AFTER(base + 1);
        }
#endif
#if DUP_MASK & 4
        for (int rep_ = 0; rep_ < 2; ++rep_) {
        if (rep_ == 1) { SEAM(); }
#endif
#ifndef SKIP_P2
        if (IN(base + 2)) {
            PHASE_IDS();
#if DUP_MASK & 16
            for (int rep2_ = 0; rep2_ < 2; ++rep2_) {
#endif
#if MIX_ORDER
            for (int uh = (int)blockIdx.x; uh < 2 * 8 * NGH; uh += G) hgrn_unit<0>(lds, tid, lane, wave, MIX_UH(uh), PROJ, (const float*)(P.ws + WS_LB) + l * 1024, P.hnorm_w + l * 1024, MB, YMIX, (uh + G < 2 * 8 * NGH) ? MIX_UH(uh + G) : -1);
            for (int um = (int)blockIdx.x; um < 2 * 4 * NGM; um += G) mlstm_unit<0>(lds, tid, lane, wave, MIX_UM(um), PROJ, GT, P.conv_w + (size_t)l * 4 * 1024, P.conv_b + (size_t)l * 1024, P.mnorm_w + l * 1024, MB, YMIX);
#else
            for (int um = (int)blockIdx.x; um < 2 * 4 * NGM; um += G) mlstm_unit<0>(lds, tid, lane, wave, MIX_UM(um), PROJ, GT, P.conv_w + (size_t)l * 4 * 1024, P.conv_b + (size_t)l * 1024, P.mnorm_w + l * 1024, MB, YMIX);
            for (int uh = (int)blockIdx.x; uh < 2 * 8 * NGH; uh += G) hgrn_unit<0>(lds, tid, lane, wave, MIX_UH(uh), PROJ, (const float*)(P.ws + WS_LB) + l * 1024, P.hnorm_w + l * 1024, MB, YMIX, (uh + G < 2 * 8 * NGH) ? MIX_UH(uh + G) : -1);
#endif
#if DUP_MASK & 16
            }
#endif
            SEAM_AFTER(base + 2);
        }
#endif
#ifndef SKIP_P3
        if (IN(base + 3)) {
            PHASE_IDS();
#ifdef MIXH
            for (int uh = (int)blockIdx.x; uh < 2 * 8 * NGH; uh += G) hgrn_unit<1, MIXH>(lds, tid, lane, wave, MIX_UH(uh), PROJ, (const float*)(P.ws + WS_LB) + l * 1024, P.hnorm_w + l * 1024, MB, YMIX);
#endif
            for (int gt = (int)blockIdx.x * NTHR + tid; gt < 131072; gt += G * NTHR) mix_scan(gt, MB);
            SEAM_AFTER(base + 3);
        }
#endif
#ifndef SKIP_PC
        if (IN(base + 4)) {
            PHASE_IDS();
#if DUP_MASK & 32
            for (int rep3_ = 0; rep3_ < 2; ++rep3_) {
#endif
#if DUP_MASK & 1024
            for (int rep4_ = 0; rep4_ < 2; ++rep4_)
#endif
#ifdef MIXD
            for (int um = (int)blockIdx.x; um < 2 * 4 * NGM; um += G) mlstm_unit<1, MIXD>(lds, tid, lane, wave, MIX_UM(um), PROJ, GT, P.conv_w + (size_t)l * 4 * 1024, P.conv_b + (size_t)l * 1024, P.mnorm_w + l * 1024, MB, YMIX);
#endif
#ifndef SKIP_PCM
            for (int um = (int)blockIdx.x; um < 2 * 4 * NGM; um += G) mlstm_unit<1>(lds, tid, lane, wave, MIX_UM(um), PROJ, GT, P.conv_w + (size_t)l * 4 * 1024, P.conv_b + (size_t)l * 1024, P.mnorm_w + l * 1024, MB, YMIX);
#endif
#if DUP_MASK & 2048
            for (int rep5_ = 0; rep5_ < 2; ++rep5_)
#endif
#ifndef SKIP_PCH
#if MIX_ORDER
            for (int uh = (int)blockIdx.x + ((2 * 8 * NGH - 1 - (int)blockIdx.x) / G) * G; uh >= 0; uh -= G) hgrn_unit<1>(lds, tid, lane, wave, MIX_UH(uh), PROJ, (const float*)(P.ws + WS_LB) + l * 1024, P.hnorm_w + l * 1024, MB, YMIX, (uh - G >= 0) ? MIX_UH(uh - G) : -1);
#else
            for (int uh = (int)blockIdx.x; uh < 2 * 8 * NGH; uh += G) hgrn_unit<1>(lds, tid, lane, wave, MIX_UH(uh), PROJ, (const float*)(P.ws + WS_LB) + l * 1024, P.hnorm_w + l * 1024, MB, YMIX, (uh + G < 2 * 8 * NGH) ? MIX_UH(uh + G) : -1);
#endif
#endif
#if DUP_MASK & 32
            }
#endif
            SEAM_AFTER(base + 4);
        }
#endif
#if DUP_MASK & 4
        }
#endif
#ifndef SKIP_P4
        if (IN(base + 5)) {
            PHASE_IDS();
            GEMM_SKEW();
            pg8::Gemm g{YMIX, (const bf16*)(P.ws + WS_WOUT) + (size_t)l * D * D, M, D, D}; pg8::StaticOrder S; S.init(M, D, G, (int)blockIdx.x);
            pg8::EpiYb E{YB, D, modl + 2 * D, modl + NMODC + 2 * D};
            pg8::gemm_phase<pg8::EpiYb, pg8::StaticOrder, GEMM_ALIGN, GEMM_SP2>(lds, g, S, E, tid);
#if DUP_MASK & 8192
            __syncthreads(); pg8::gemm_phase<pg8::EpiYb, pg8::StaticOrder, GEMM_ALIGN, GEMM_SP2>(lds, g, S, E, tid);
#endif
            SEAM_AFTER(base + 5);
        }
#endif
#ifndef SKIP_P5
        if (IN(base + 6)) {
            PHASE_IDS();
            phase_rows<true, true, false, true, true>(lds, tid, lane, wave, G, X, YB, X, P.ln1_g + l * D, P.ln1_b + l * D, U, modl + 4 * D, modl + 3 * D, nullptr, nullptr, nullptr, nullptr);
            SEAM_AFTER(base + 6);
        }
#endif
#ifndef SKIP_P6
        if (IN(base + 7)) {
            PHASE_IDS();
            GEMM_SKEW();
            pg8::Gemm g{U, (const bf16*)(P.ws + WS_WGU) + (size_t)l * NGU * D, M, NGU, D}; pg8::StaticOrder S; S.init(M, NGU, G, (int)blockIdx.x);
            pg8::EpiSwiGLU E{HB, FF};
            pg8::gemm_phase<pg8::EpiSwiGLU, pg8::StaticOrder, GEMM_ALIGN_GU, GEMM_SP2>(lds, g, S, E, tid);
#if DUP_MASK & 8
            __syncthreads(); pg8::gemm_phase<pg8::EpiSwiGLU, pg8::StaticOrder, GEMM_ALIGN, GEMM_SP2>(lds, g, S, E, tid);
#endif
            SEAM_AFTER(base + 7);
        }
#endif
#ifndef SKIP_P7
        if (IN(base + 8)) {
            PHASE_IDS();
            GEMM_SKEW();
            pg8::Gemm g{HB, (const bf16*)(P.ws + WS_WDN) + (size_t)l * D * FF, M, D, FF}; pg8::StaticOrder S; S.init(M, D, G, (int)blockIdx.x);
            pg8::EpiYb E{YB, D, modl + 5 * D, modl + NMODC + 5 * D};
            pg8::gemm_phase<pg8::EpiYb, pg8::StaticOrder, GEMM_ALIGN, GEMM_SP2>(lds, g, S, E, tid);
#if DUP_MASK & 16384
            __syncthreads(); pg8::gemm_phase<pg8::EpiYb, pg8::StaticOrder, GEMM_ALIGN, GEMM_SP2>(lds, g, S, E, tid);
#endif
            SEAM_AFTER(base + 8);
        }
#endif
    }
#if PROBE_MASK_A || PROBE_MASK_R
    float probe_c = 0.f, probe_a = 0.f;
    if (IN(NPH - 1)) { SEAM();
        for (int ty = 0; ty < 1 + NPL; ++ty) { const float tk = (float)__hip_atomic_load(TSW + ty, __ATOMIC_RELAXED, __HIP_MEMORY_SCOPE_AGENT);
            if ((PROBE_MASK_R >> ty) & 1) probe_c += tk * 1e-5f; if ((PROBE_MASK_A >> ty) & 1) probe_a += tk * 1e-3f; } }
#endif
    if (IN(NPH - 1)) { PHASE_IDS(); phase_rows<true, false, false, true, false>(lds, tid, lane, wave, G, X, YB, P.out, P.ln2_g + (DEPTH - 1) * D, P.ln2_b + (DEPTH - 1) * D, nullptr, nullptr, nullptr, nullptr, nullptr, nullptr, nullptr);
#if PROBE_MASK_A || PROBE_MASK_R
        __syncthreads();
        for (int m = (int)blockIdx.x * NWAVES + wave; m < M; m += G * NWAVES) for (int jj = lane; jj < D; jj += 64) P.out[(size_t)m * D + jj] += probe_c;
        __syncthreads();
        if (PROBE_MASK_A & 0x10000) { float ghz = 0.f; if (blockIdx.x == 0 && tid == 0) ghz = (float)(__builtin_amdgcn_s_memtime() - TS64[1]) / (float)(__builtin_amdgcn_s_memrealtime() - TS64[2]) * 0.1f; probe_a = floorf(ghz * 10.f + 0.5f) * 10.f; }
        if (blockIdx.x == 0 && tid == 0 && PROBE_MASK_A) P.out[0] = probe_a;
#endif
    }
#undef IN
#undef SEAM_AFTER
#undef SEAM
}
extern "C" void kernel_launch(void* const* d_in, const int* in_sizes, int n_in, void* d_out, int out_size, void* d_ws, size_t ws_size, hipStream_t stream) {
    static int grid = 0;
    if (grid == 0) {
        if (n_in != 20 || out_size != M * D || ws_size < WS_END) { fprintf(stderr, "kernel_launch: unexpected problem (n_in %d, out %d, ws %zu < %zu)\n", n_in, out_size, ws_size, (size_t)WS_END); grid = -1; return; }
        int dev = 0, cus = 0;
        if (hipGetDevice(&dev) != hipSuccess || hipDeviceGetAttribute(&cus, hipDeviceAttributeMultiprocessorCount, dev) != hipSuccess) { grid = -1; return; }
        if (hipFuncSetAttribute((const void*)fwd, hipFuncAttributeMaxDynamicSharedMemorySize, LDS_BYTES) != hipSuccess) { fprintf(stderr, "kernel_launch: hipFuncSetAttribute failed\n"); grid = -1; return; }
        int per_cu = 0; (void)hipOccupancyMaxActiveBlocksPerMultiprocessor(&per_cu, (const void*)fwd, NTHR, LDS_BYTES); (void)hipGetLastError();
        if (per_cu < 1) fprintf(stderr, "kernel_launch: occupancy query reports %d workgroups per CU\n", per_cu);
        grid = cus;
    }
    if (grid < 0) return;
    (void)hipMemsetAsync((char*)d_ws + WS_CTL, 0, CTL_ZERO_BYTES, stream);
    Args a{};
    for (int i = 0; i < 20; ++i) a.in[i] = (const float*)d_in[i];
    a.out = (float*)d_out; a.ws = (unsigned char*)d_ws;
#if MK_ONE_LAUNCH
    a.ph_lo = 0; a.ph_hi = NPH;
    hipLaunchKernelGGL(fwd, dim3(grid), dim3(NTHR), LDS_BYTES, stream, a);
#else
    for (int p = 0; p < NPH; ++p) { a.ph_lo = p; a.ph_hi = p + 1; hipLaunchKernelGGL(fwd, dim3(grid), dim3(NTHR), LDS_BYTES, stream, a); }
#endif
}
```
